# Optimizing an MI355X kernel written in HIP

```python
import jax, jax.numpy as jnp
from jax import lax
import numpy as np

D_MODEL = 1024
BATCH = 1
SEQ = 16384
DEPTH = 1
DEC_BATCH = 32
DEC_SEQ = 64
PAST_LEN = 2048

CHUNK = 64
RET_HEADS = 4
RET_DK = 128
RET_DV = 128
ATTN_HEADS = 8
ATTN_DH = 64
BAND_PAST_CHUNKS = 8
BAND_PAST = BAND_PAST_CHUNKS * CHUNK
REL_CLIP = 256
D_FF = -(-8 * D_MODEL // (3 * 256)) * 256
PLE_DIM = 256
ROPE_THETA = 10000.0
EPS = 1e-6
COL_SIZES = (RET_HEADS * RET_DK, RET_HEADS * RET_DK, RET_HEADS * RET_DV, RET_HEADS * RET_DV,
             ATTN_HEADS * ATTN_DH, ATTN_HEADS * ATTN_DH, ATTN_HEADS * ATTN_DH)
IN_COLS = sum(COL_SIZES)

kernel_name = "hybrid_retention_chunkband_stream_step"


def rmsnorm(x, g):
    xf = x.astype(jnp.float32)
    y = xf * lax.rsqrt(jnp.mean(xf * xf, axis=-1, keepdims=True) + EPS) * g.astype(jnp.float32)
    return y.astype(x.dtype)


def rope(x, pos):
    half = x.shape[-1] // 2
    inv = ROPE_THETA ** (-jnp.arange(half, dtype=jnp.float32) / half)
    ang = pos[:, None] * inv[None, :]
    cos = jnp.cos(ang)[None, :, None, :]
    sin = jnp.sin(ang)[None, :, None, :]
    x1, x2 = x[..., :half], x[..., half:]
    return jnp.concatenate([x1 * cos - x2 * sin, x1 * sin + x2 * cos], axis=-1).astype(x.dtype)


def retention_log_decay():
    return jnp.log1p(-jnp.exp2(-5.0 - jnp.arange(RET_HEADS, dtype=jnp.float32)))


def retention_chunk(R, q, k, v, lg):
    T = q.shape[1]
    n = jnp.arange(T, dtype=jnp.float32)
    diff = n[:, None] - n[None, :]
    D = jnp.where(diff[None] >= 0, jnp.exp(jnp.maximum(diff, 0.0)[None] * lg[:, None, None]), 0.0)
    s = jnp.einsum('bnhd,bmhd->bhnm', q, k) * D[None]
    inner = jnp.einsum('bhnm,bmhe->bnhe', s, v)
    xi = jnp.exp((n + 1.0)[:, None] * lg[None, :])
    cross = jnp.einsum('bnhd,bhde->bnhe', q, R) * xi[None, :, :, None]
    zeta = jnp.exp((T - 1.0 - n)[:, None] * lg[None, :])
    R_new = jnp.exp(T * lg)[None, :, None, None] * R + jnp.einsum(
        'bmhd,bmhe->bhde', k * zeta[None, :, :, None], v)
    return R_new, inner + cross


def rel_bias_lookup(rel_bias, qpos, kpos):
    rel = qpos[:, None] - kpos[None, :]
    idx = jnp.clip(rel, -REL_CLIP, REL_CLIP) + REL_CLIP
    return rel_bias[:, idx].astype(jnp.float32)


def band_attention(q, k, v, valid, bias):
    s = jnp.einsum('bnthd,bnlhd->bnhtl', q, k).astype(jnp.float32) * (ATTN_DH ** -0.5) + bias[None, None]
    s = jnp.where(valid[None, :, None, None, :], s, jnp.finfo(jnp.float32).min)
    p = jax.nn.softmax(s, axis=-1)
    return jnp.einsum('bnhtl,bnlhd->bnthd', p.astype(v.dtype), v)


def project(u, w_in, g_q, g_k, pos):
    B, S, _ = u.shape
    z = u @ w_in
    splits = list(np.cumsum(COL_SIZES)[:-1])
    q_r, k_r, v_r, g_r, q_a, k_a, v_a = jnp.split(z, splits, axis=-1)
    q_r = rope(q_r.reshape(B, S, RET_HEADS, RET_DK), pos)
    k_r = rope(k_r.reshape(B, S, RET_HEADS, RET_DK), pos) * (RET_DK ** -0.5)
    v_r = v_r.reshape(B, S, RET_HEADS, RET_DV)
    q_a = rmsnorm(q_a.reshape(B, S, ATTN_HEADS, ATTN_DH), g_q)
    k_a = rmsnorm(k_a.reshape(B, S, ATTN_HEADS, ATTN_DH), g_k)
    v_a = v_a.reshape(B, S, ATTN_HEADS, ATTN_DH)
    return q_r, k_r, v_r, g_r, q_a, k_a, v_a


def merge_and_tail(x, p, o_r, g_r, o_a, g_ret_out, w_out, g_ffn, w_ffn_gate, w_ffn_up, w_ffn_down,
                   g_ple, w_ple_gate, w_ple_proj):
    B, S, _ = x.shape
    ret = jax.nn.silu(g_r) * rmsnorm(o_r, g_ret_out).reshape(B, S, RET_HEADS * RET_DV)
    mixed = jnp.concatenate([ret.astype(x.dtype), o_a.astype(x.dtype)], axis=-1)
    h = x + mixed @ w_out
    u = rmsnorm(h, g_ffn)
    h = h + (jax.nn.silu(u @ w_ffn_gate) * (u @ w_ffn_up)) @ w_ffn_down
    gate = jax.nn.sigmoid(rmsnorm(h, g_ple) @ w_ple_gate)
    return h + (p @ w_ple_proj) * gate


def mixers_prompt(u, w_in, g_q, g_k, rel_bias):
    B, S, _ = u.shape
    nC = S // CHUNK
    pos = jnp.arange(S, dtype=jnp.float32)
    q_r, k_r, v_r, g_r, q_a, k_a, v_a = project(u, w_in, g_q, g_k, pos)
    lg = retention_log_decay()

    def to_chunks(t):
        return jnp.moveaxis(t.reshape(B, nC, CHUNK, *t.shape[2:]), 1, 0)

    R0 = jnp.zeros((B, RET_HEADS, RET_DK, RET_DV), jnp.float32)
    R_fin, o_chunks = lax.scan(lambda R, xs: retention_chunk(R, xs[0], xs[1], xs[2], lg), R0,
                               (to_chunks(q_r), to_chunks(k_r), to_chunks(v_r)))
    o_r = jnp.moveaxis(o_chunks, 0, 1).reshape(B, S, RET_HEADS, RET_DV)

    pad = ((0, 0), (BAND_PAST_CHUNKS, 0), (0, 0), (0, 0), (0, 0))
    kp = jnp.pad(k_a.reshape(B, nC, CHUNK, ATTN_HEADS, ATTN_DH), pad)
    vp = jnp.pad(v_a.reshape(B, nC, CHUNK, ATTN_HEADS, ATTN_DH), pad)
    idx = jnp.arange(nC)[:, None] + jnp.arange(BAND_PAST_CHUNKS + 1)[None, :]
    L = (BAND_PAST_CHUNKS + 1) * CHUNK
    kb = kp[:, idx].reshape(B, nC, L, ATTN_HEADS, ATTN_DH)
    vb = vp[:, idx].reshape(B, nC, L, ATTN_HEADS, ATTN_DH)
    valid = jnp.repeat((idx - BAND_PAST_CHUNKS) >= 0, CHUNK, axis=1)
    bias = rel_bias_lookup(rel_bias, BAND_PAST + jnp.arange(CHUNK), jnp.arange(L))
    o_a = band_attention(q_a.reshape(B, nC, CHUNK, ATTN_HEADS, ATTN_DH), kb, vb, valid, bias)
    o_a = o_a.reshape(B, S, ATTN_HEADS * ATTN_DH)
    tail = min(BAND_PAST, S)
    return o_r, g_r, o_a, R_fin, k_a[:, S - tail:], v_a[:, S - tail:]


def mixers_sample(u, R0, ck, cv, w_in, g_q, g_k, rel_bias):
    B, T, _ = u.shape
    pos = PAST_LEN + jnp.arange(T, dtype=jnp.float32)
    q_r, k_r, v_r, g_r, q_a, k_a, v_a = project(u, w_in, g_q, g_k, pos)
    R_new, o_r = retention_chunk(R0.astype(jnp.float32), q_r, k_r, v_r, retention_log_decay())
    W = ck.shape[1]
    kb = jnp.concatenate([ck.astype(k_a.dtype), k_a], axis=1)[:, None]
    vb = jnp.concatenate([cv.astype(v_a.dtype), v_a], axis=1)[:, None]
    valid = jnp.ones((1, W + T), dtype=bool)
    bias = rel_bias_lookup(rel_bias, jnp.arange(T), jnp.arange(W + T) - W)
    o_a = band_attention(q_a[:, None], kb, vb, valid, bias)[:, 0].reshape(B, T, ATTN_HEADS * ATTN_DH)
    return o_r, g_r, o_a, R_new, k_a, v_a


def setup_inputs(seed: int = 0) -> dict:
    key = jax.random.key(seed)
    ks = jax.random.split(key, 24)
    nrm = jax.random.normal
    W = min(BAND_PAST, PAST_LEN)
    f = jnp.float32
    return {
        "x_prompt": nrm(ks[0], (BATCH, SEQ, D_MODEL), f),
        "x_sample": nrm(ks[1], (DEC_BATCH, DEC_SEQ, D_MODEL), f),
        "cache_attn_k": nrm(ks[2], (DEPTH, DEC_BATCH, W, ATTN_HEADS, ATTN_DH), f),
        "cache_attn_v": nrm(ks[3], (DEPTH, DEC_BATCH, W, ATTN_HEADS, ATTN_DH), f),
        "state_ret": 0.1 * nrm(ks[4], (DEPTH, DEC_BATCH, RET_HEADS, RET_DK, RET_DV), f),
        "p_prompt": nrm(ks[5], (DEPTH, BATCH, SEQ, PLE_DIM), f),
        "p_sample": nrm(ks[6], (DEPTH, DEC_BATCH, DEC_SEQ, PLE_DIM), f),
        "g_mix": 1.0 + 0.05 * nrm(ks[7], (DEPTH, D_MODEL), f),
        "w_in": nrm(ks[8], (DEPTH, D_MODEL, IN_COLS), f) * D_MODEL ** -0.5,
        "g_ret_out": 1.0 + 0.05 * nrm(ks[9], (DEPTH, RET_HEADS, RET_DV), f),
        "g_q_attn": 1.0 + 0.05 * nrm(ks[10], (DEPTH, ATTN_DH), f),
        "g_k_attn": 1.0 + 0.05 * nrm(ks[11], (DEPTH, ATTN_DH), f),
        "rel_bias": 0.1 * nrm(ks[12], (DEPTH, ATTN_HEADS, 2 * REL_CLIP + 1), f),
        "w_out": nrm(ks[13], (DEPTH, D_MODEL, D_MODEL), f) * D_MODEL ** -0.5,
        "g_ffn": 1.0 + 0.05 * nrm(ks[14], (DEPTH, D_MODEL), f),
        "w_ffn_gate": nrm(ks[15], (DEPTH, D_MODEL, D_FF), f) * D_MODEL ** -0.5,
        "w_ffn_up": nrm(ks[16], (DEPTH, D_MODEL, D_FF), f) * D_MODEL ** -0.5,
        "w_ffn_down": nrm(ks[17], (DEPTH, D_FF, D_MODEL), f) * D_FF ** -0.5,
        "g_ple": 1.0 + 0.05 * nrm(ks[18], (DEPTH, D_MODEL), f),
        "w_ple_gate": nrm(ks[19], (DEPTH, D_MODEL, D_MODEL), f) * D_MODEL ** -0.5,
        "w_ple_proj": nrm(ks[20], (DEPTH, PLE_DIM, D_MODEL), f) * PLE_DIM ** -0.5,
    }


def reference(x_prompt, x_sample, cache_attn_k, cache_attn_v, state_ret, p_prompt, p_sample,
              g_mix, w_in, g_ret_out, g_q_attn, g_k_attn, rel_bias, w_out, g_ffn,
              w_ffn_gate, w_ffn_up, w_ffn_down, g_ple, w_ple_gate, w_ple_proj):
    hp, hs = x_prompt, x_sample
    ret_p, kp_l, vp_l, ret_s, ks_l, vs_l = [], [], [], [], [], []
    for i in range(DEPTH):
        tail_w = (g_ret_out[i], w_out[i], g_ffn[i], w_ffn_gate[i], w_ffn_up[i], w_ffn_down[i],
                  g_ple[i], w_ple_gate[i], w_ple_proj[i])
        o_r, g_r, o_a, R_fin, k_tail, v_tail = mixers_prompt(
            rmsnorm(hp, g_mix[i]), w_in[i], g_q_attn[i], g_k_attn[i], rel_bias[i])
        hp = merge_and_tail(hp, p_prompt[i], o_r, g_r, o_a, *tail_w)
        o_r_s, g_r_s, o_a_s, R_new, k_new, v_new = mixers_sample(
            rmsnorm(hs, g_mix[i]), state_ret[i], cache_attn_k[i], cache_attn_v[i],
            w_in[i], g_q_attn[i], g_k_attn[i], rel_bias[i])
        hs = merge_and_tail(hs, p_sample[i], o_r_s, g_r_s, o_a_s, *tail_w)
        ret_p.append(R_fin); kp_l.append(k_tail); vp_l.append(v_tail)
        ret_s.append(R_new); ks_l.append(k_new); vs_l.append(v_new)
    new_ret_prompt = jnp.stack(ret_p)
    new_k_prompt = jnp.stack(kp_l)
    new_v_prompt = jnp.stack(vp_l)
    new_ret_sample = jnp.stack(ret_s)
    new_k_sample = jnp.stack(ks_l)
    new_v_sample = jnp.stack(vs_l)
    return (hp, hs, new_ret_prompt, new_k_prompt, new_v_prompt, new_ret_sample, new_k_sample, new_v_sample)
```

```cpp
#include <hip/hip_runtime.h>
#include <cstdio>
#include <cstdint>
namespace pg8 {
#define PG8_LAS __attribute__((address_space(3)))
typedef unsigned short bf16_t;
typedef short bf16x8 __attribute__((ext_vector_type(8)));
typedef float f32x4 __attribute__((ext_vector_type(4)));
typedef unsigned u32x4 __attribute__((ext_vector_type(4)));
constexpr int BM = 256, BK = 64, HALF = 128, HTB = HALF * BK * 2  , STAGE_BYTES = 8 * HTB, NXCD = 8, WGM = 8;

__host__ __device__ __forceinline__ int lds_byte(int r, int c) { const int st = (r >> 4) * 2 + (c >> 5), rr = r & 15, cc = c & 31, ob = rr * 64 + cc * 2; return st * 1024 + (ob ^ (((ob >> 9) & 1) << 5)); }
__host__ __device__ __forceinline__ void stage_rc(int b, int& R, int& C) { const int st = b / 1024, sb = b % 1024, swz = sb ^ (((sb >> 9) & 1) << 5); R = (st >> 1) * 16 + swz / 64; C = (st & 1) * 32 + (swz % 64) / 2; }
__host__ __device__ __forceinline__ int perm32(int rho) { const int n = rho >> 4, i = rho & 15; return 8 * (i >> 2) + 4 * n + (i & 3); }

struct Unit { int pm, pn; };
struct Gemm { const bf16_t* A; const bf16_t* Bt; int M, N, K; };

struct StaticOrder {
    int nM, nN, nwg, G, c;
    __host__ __device__ void init(int M, int N, int G_, int c_) { nM = M / BM; nN = N / BM; nwg = nM * nN; G = G_; c = c_; }
    __host__ __device__ bool next(int i, Unit& u) const {
        const long L = (long)i * G + c; if (L >= nwg) return false;
        int wgid = (int)L; { const int q = nwg / NXCD, r = nwg % NXCD, xcd = wgid % NXCD, off = wgid / NXCD; wgid = (xcd < r ? xcd * (q + 1) : r * (q + 1) + (xcd - r) * q) + off; }
        const int nig = WGM * nN, gid = wgid / nig, fm = gid * WGM, gsz = (nM - fm) < WGM ? (nM - fm) : WGM;
        u.pm = fm + ((wgid % nig) % gsz); u.pn = (wgid % nig) / gsz; return true;
    }
    __device__ __forceinline__ void a_ready(const Unit&) const {}
    __device__ __forceinline__ void done(const Unit&) const {}
};

__device__ __forceinline__ unsigned cvt_pk_bf16(float lo, float hi) { unsigned r; asm volatile("v_cvt_pk_bf16_f32 %0, %1, %2" : "=v"(r) : "v"(lo), "v"(hi)); return r; }
typedef float f32x2 __attribute__((ext_vector_type(2)));
template <class Epi, class Sched, bool ALIGN_EPI = false, bool SP2 = false>
__device__ __forceinline__ void gemm_phase(PG8_LAS unsigned char* lds, const Gemm g, const Sched& S, const Epi& E) {
    int tid_ = threadIdx.x; asm volatile("" : "+v"(tid_));
    const int tid = tid_, wid = __builtin_amdgcn_readfirstlane(tid >> 6), lane = tid & 63, wr = wid >> 2, wc = wid & 3, fr = lane & 15, fq = lane >> 4;
    const int K = g.K, nt = K / BK;
    unsigned voffA[2], voffB[2];
#pragma unroll
    for (int i = 0; i < 2; ++i) { int R, C; stage_rc(tid * 16 + i * 8192, R, C); const int Rb = Epi::PERM ? ((R & ~31) + perm32(R & 31)) : R;
        voffA[i] = (unsigned)(R * K + C) * 2u; voffB[i] = (unsigned)(Rb * K + C) * 2u; }
    const size_t kstep = (size_t)(BK * 2);
    const size_t hstep = (size_t)HALF * K * 2;
    const size_t tstep = 2 * hstep;
    const unsigned ldsw = (unsigned)wid * 1024u;
    const int aoff = lds_byte(wr * 64 + fr, fq * 8), boff = lds_byte(wc * 32 + fr, fq * 8);
#define PG8_SA(b, h) (((b) * 2 + (h)) * HTB)
#define PG8_SB(b, h) ((4 + (b) * 2 + (h)) * HTB)
#define PG8_STAGE(bufoff, gbase, voff) do { _Pragma("unroll") for (int _i = 0; _i < 2; ++_i) \
        __builtin_amdgcn_global_load_lds((const unsigned*)((const char*)(gbase) + (voff)[_i]), (PG8_LAS unsigned*)(lds + (bufoff) + ldsw + _i * 8192), 16, 0, 0); } while (0)
#define PG8_LDA(dst, b, h) do { _Pragma("unroll") for (int m = 0; m < 4; ++m) _Pragma("unroll") for (int k = 0; k < 2; ++k) dst[m][k] = *(const PG8_LAS bf16x8*)(lds + PG8_SA(b, h) + aoff + m * 2048 + k * 1024); } while (0)
#define PG8_LDB(dst, b, h) do { _Pragma("unroll") for (int n = 0; n < 2; ++n) _Pragma("unroll") for (int k = 0; k < 2; ++k) dst[n][k] = *(const PG8_LAS bf16x8*)(lds + PG8_SB(b, h) + boff + n * 2048 + k * 1024); } while (0)
#define PG8_MMA(ai, bj, At, Bt) do { __builtin_amdgcn_s_setprio(1); _Pragma("unroll") for (int m = 0; m < 4; ++m) _Pragma("unroll") for (int n = 0; n < 2; ++n) _Pragma("unroll") for (int k = 0; k < 2; ++k) \
        acc[ai][bj][m][n] = __builtin_amdgcn_mfma_f32_16x16x32_bf16(Bt[n][k], At[m][k], acc[ai][bj][m][n], 0, 0, 0); __builtin_amdgcn_s_setprio(0); } while (0)
#define PG8_WAIT_V(n) asm volatile("s_waitcnt vmcnt(" #n ")" ::: "memory")
#define PG8_WAIT_L(n) asm volatile("s_waitcnt lgkmcnt(" #n ")" ::: "memory")
#define PG8_BAR __builtin_amdgcn_s_barrier()
#define PG8_SCHED __builtin_amdgcn_sched_barrier(0)
    Unit cur, nxt; int ui = 0;
    if (!S.next(0, cur)) return;
    f32x4 acc[2][2][4][2];
#pragma unroll
    for (int a = 0; a < 2; ++a)
#pragma unroll
        for (int b = 0; b < 2; ++b)
#pragma unroll
            for (int m = 0; m < 4; ++m)
#pragma unroll
                for (int n = 0; n < 2; ++n) acc[a][b][m][n] = (f32x4){0.f, 0.f, 0.f, 0.f};
    bf16x8 At[4][2], B0[2][2], B1[2][2];
    const char* cA = (const char*)g.A + (size_t)cur.pm * tstep; const char* cB = (const char*)g.Bt + (size_t)cur.pn * tstep;
    S.a_ready(cur);
    if constexpr (SP2) {
        PG8_STAGE(PG8_SB(0, 0), cB, voffB); PG8_STAGE(PG8_SB(0, 1), cB + hstep, voffB); PG8_STAGE(PG8_SA(0, 0), cA, voffA); PG8_STAGE(PG8_SA(0, 1), cA + hstep, voffA);
        if (wr == 1) PG8_BAR;
        PG8_WAIT_V(2); PG8_BAR;
        PG8_STAGE(PG8_SB(1, 0), cB + kstep, voffB); PG8_STAGE(PG8_SA(1, 0), cA + kstep, voffA); PG8_STAGE(PG8_SB(1, 1), cB + hstep + kstep, voffB);
        PG8_WAIT_V(6); PG8_BAR;
    } else {
        PG8_STAGE(PG8_SB(0, 0), cB, voffB); PG8_STAGE(PG8_SA(0, 0), cA, voffA); PG8_STAGE(PG8_SB(0, 1), cB + hstep, voffB); PG8_STAGE(PG8_SA(0, 1), cA + hstep, voffA);
        if (wr == 1) PG8_BAR;
        PG8_WAIT_V(4); PG8_BAR;
        PG8_STAGE(PG8_SB(1, 0), cB + kstep, voffB); PG8_STAGE(PG8_SA(1, 0), cA + kstep, voffA); PG8_STAGE(PG8_SB(1, 1), cB + hstep + kstep, voffB);
        PG8_WAIT_V(6); PG8_BAR;
    }
    for (;;) {
        const bool has_next = S.next(ui + 1, nxt);
        const char* nA = has_next ? (const char*)g.A + (size_t)nxt.pm * tstep : cA; const char* nB = has_next ? (const char*)g.Bt + (size_t)nxt.pn * tstep : cB;
        for (int t = 0; t < nt; t += 2) {
            const bool last = (t == nt - 2);
            const char* a1 = cA + (size_t)(t + 1) * kstep;
            const char* a2 = last ? nA : cA + (size_t)(t + 2) * kstep; const char* b2 = last ? nB : cB + (size_t)(t + 2) * kstep;
            const char* a3 = a2 + kstep; const char* b3 = b2 + kstep;
            if (last && has_next) S.a_ready(nxt);
            if constexpr (SP2) {
            PG8_LDB(B0, 0, 0); PG8_LDB(B1, 0, 1); PG8_SCHED; PG8_LDA(At, 0, 0); PG8_STAGE(PG8_SA(1, 1), a1 + hstep, voffA);
            PG8_WAIT_V(8); PG8_WAIT_L(0); PG8_BAR; PG8_MMA(0, 0, At, B0); PG8_MMA(0, 1, At, B1); PG8_BAR; PG8_SCHED;
            PG8_LDA(At, 0, 1); PG8_STAGE(PG8_SB(0, 0), b2, voffB); PG8_STAGE(PG8_SB(0, 1), b2 + hstep, voffB); PG8_STAGE(PG8_SA(0, 0), a2, voffA);
            PG8_WAIT_V(8); PG8_WAIT_L(0); PG8_BAR; PG8_MMA(1, 0, At, B0); PG8_MMA(1, 1, At, B1); PG8_BAR; PG8_SCHED;
            PG8_LDB(B0, 1, 0); PG8_LDB(B1, 1, 1); PG8_SCHED; PG8_LDA(At, 1, 0); PG8_STAGE(PG8_SA(0, 1), a2 + hstep, voffA);
            PG8_WAIT_V(8); PG8_WAIT_L(0); PG8_BAR; PG8_MMA(0, 0, At, B0); PG8_MMA(0, 1, At, B1); PG8_BAR; PG8_SCHED;
            PG8_LDA(At, 1, 1); PG8_STAGE(PG8_SB(1, 0), b3, voffB); PG8_STAGE(PG8_SB(1, 1), b3 + hstep, voffB); PG8_STAGE(PG8_SA(1, 0), a3, voffA);
            PG8_WAIT_V(8); PG8_WAIT_L(0); PG8_BAR; PG8_MMA(1, 0, At, B0); PG8_MMA(1, 1, At, B1); PG8_BAR; PG8_SCHED;
            } else {
            PG8_LDB(B0, 0, 0); PG8_SCHED; PG8_LDA(At, 0, 0); PG8_STAGE(PG8_SA(1, 1), a1 + hstep, voffA);
            PG8_WAIT_L(8); PG8_BAR; PG8_WAIT_L(0); PG8_MMA(0, 0, At, B0); PG8_BAR; PG8_SCHED;
            PG8_LDB(B1, 0, 1); PG8_STAGE(PG8_SB(0, 0), b2, voffB);
            PG8_BAR; PG8_WAIT_L(0); PG8_MMA(0, 1, At, B1); PG8_BAR;
            PG8_LDA(At, 0, 1); PG8_STAGE(PG8_SA(0, 0), a2, voffA);
            PG8_BAR; PG8_WAIT_L(0); PG8_MMA(1, 0, At, B0); PG8_BAR; PG8_SCHED;
            PG8_STAGE(PG8_SB(0, 1), b2 + hstep, voffB);
            PG8_WAIT_V(6); PG8_BAR; PG8_MMA(1, 1, At, B1); PG8_BAR;
            PG8_LDB(B0, 1, 0); PG8_SCHED; PG8_LDA(At, 1, 0); PG8_STAGE(PG8_SA(0, 1), a2 + hstep, voffA);
            PG8_WAIT_L(8); PG8_BAR; PG8_WAIT_L(0); PG8_MMA(0, 0, At, B0); PG8_BAR; PG8_SCHED;
            PG8_LDB(B1, 1, 1); PG8_STAGE(PG8_SB(1, 0), b3, voffB);
            PG8_BAR; PG8_WAIT_L(0); PG8_MMA(0, 1, At, B1); PG8_BAR;
            PG8_LDA(At, 1, 1); PG8_STAGE(PG8_SA(1, 0), a3, voffA);
            PG8_BAR; PG8_WAIT_L(0); PG8_MMA(1, 0, At, B0); PG8_BAR; PG8_SCHED;
            PG8_STAGE(PG8_SB(1, 1), b3 + hstep, voffB);
            PG8_WAIT_V(6); PG8_BAR; PG8_MMA(1, 1, At, B1); PG8_BAR;
            }
        }
        if constexpr (ALIGN_EPI) { if (wr == 0) PG8_BAR; }
        if constexpr (!Epi::AFTER_DRAIN) { E(acc, cur, wr, wc, fr, fq); S.done(cur); }
        if (!has_next) break;
#pragma unroll
        for (int a = 0; a < 2; ++a)
#pragma unroll
            for (int b = 0; b < 2; ++b)
#pragma unroll
                for (int m = 0; m < 4; ++m)
#pragma unroll
                    for (int n = 0; n < 2; ++n) acc[a][b][m][n] = (f32x4){0.f, 0.f, 0.f, 0.f};
        cur = nxt; cA = nA; cB = nB; ++ui;
        if constexpr (ALIGN_EPI) { if (wr == 1) PG8_BAR; }
    }
    PG8_WAIT_V(0);
    if constexpr (!ALIGN_EPI) { if (wr == 0) PG8_BAR; }
    PG8_BAR;
    if constexpr (Epi::AFTER_DRAIN) { E.fused(acc, cur, wr, wc, fr, fq, lds, wid, lane); S.done(cur); }
#undef PG8_SA
#undef PG8_SB
#undef PG8_STAGE
#undef PG8_LDA
#undef PG8_LDB
#undef PG8_MMA
#undef PG8_WAIT_V
#undef PG8_WAIT_L
#undef PG8_BAR
#undef PG8_SCHED
}
}
#define GAS __attribute__((address_space(1)))
#define LAS __attribute__((address_space(3)))
typedef unsigned short bf16;
typedef unsigned v4u __attribute__((ext_vector_type(4)));
typedef float f32x4 __attribute__((ext_vector_type(4)));
typedef short bf16x8 __attribute__((ext_vector_type(8)));
typedef GAS unsigned gu32;
typedef GAS unsigned long long gu64;
#define RLX_AGENT __ATOMIC_RELAXED, __HIP_MEMORY_SCOPE_AGENT
#define LDS_WAIT() asm volatile("s_waitcnt lgkmcnt(0)" ::: "memory")
#define VM_WAIT() asm volatile("s_waitcnt vmcnt(0)" ::: "memory")
__device__ __forceinline__ unsigned long long rt() { return __builtin_amdgcn_s_memrealtime(); }
__device__ __forceinline__ unsigned f2bf(float f) { unsigned u = __builtin_bit_cast(unsigned, f); return (u + 0x7fffu + ((u >> 16) & 1u)) >> 16; }
__device__ __forceinline__ unsigned pk2(float lo, float hi) { return f2bf(lo) | (f2bf(hi) << 16); }

#define XB_TMO      128
#define XB_XCNT(j)  (256  + 64 * (j))
#define XB_XSUB(j)  (1280 + 64 * (j))
#define XB_XGEN(j)  (2304 + 64 * (j))
#define XB_TOP      3328
#define XB_TOPGEN   3392
#define XCD_BAR_WORDS 3456
#define XB_SPIN_CAP (1u << 18)

__device__ __forceinline__ unsigned xb_ld(unsigned* p)              { return __hip_atomic_load(p, __ATOMIC_RELAXED, __HIP_MEMORY_SCOPE_AGENT); }
__device__ __forceinline__ unsigned xb_add(unsigned* p, unsigned v) { return __hip_atomic_fetch_add(p, v, __ATOMIC_RELAXED, __HIP_MEMORY_SCOPE_AGENT); }
__device__ __forceinline__ unsigned xb_xcc_id() { return (unsigned)__builtin_amdgcn_s_getreg((3 << 11) | 20) & 0xFu; }
#define XB_SPIN(cond, bar) do { unsigned _sp = 0; while (cond) { __builtin_amdgcn_s_sleep(1); \
    if ((++_sp & 255u) == 0u) { if (xb_ld(&(bar)[XB_TMO])) break; if (_sp > XB_SPIN_CAP) { atomicAdd(&(bar)[XB_TMO], 1u); break; } } } } while (0)

struct XcdBarrier {
    unsigned* bar; unsigned x;
    volatile LAS unsigned* st;
};

__device__ __forceinline__ XcdBarrier xcd_barrier_post(unsigned* bar, volatile LAS unsigned* st) {
    XcdBarrier b; b.bar = bar; b.x = xb_xcc_id(); b.st = st;
    if (threadIdx.x == 0) (void)xb_add(&bar[XB_XCNT(b.x)], 1u);
    return b;
}
__device__ __forceinline__ void xcd_barrier_complete(unsigned* bar, unsigned x, unsigned& nloc, unsigned& nx) {
    const unsigned G = gridDim.x * gridDim.y * gridDim.z;
    unsigned sum, cnt, mine, sp = 0u;
    for (;;) {
        sum = 0u; cnt = 0u; mine = 0u;
#pragma unroll
        for (unsigned j = 0; j < 16; ++j) { const unsigned c = xb_ld(&bar[XB_XCNT(j)]); sum += c; cnt += (c > 0u) ? 1u : 0u; mine = (j == x) ? c : mine; }
        if (sum == G) break;
        __builtin_amdgcn_s_sleep(1);
        if ((++sp & 255u) == 0u) { if (xb_ld(&bar[XB_TMO])) break; if (sp > XB_SPIN_CAP) { atomicAdd(&bar[XB_TMO], 1u); break; } }
    }
    nloc = mine > 0u ? mine : 1u; nx = cnt > 0u ? cnt : 1u;
}

__device__ __forceinline__ void xcd_barrier(const XcdBarrier& b) {
    asm volatile("s_waitcnt vmcnt(0)" ::: "memory");
    __syncthreads();
    if (threadIdx.x == 0) {
        unsigned* bar = b.bar;
        __builtin_amdgcn_s_waitcnt(0);
        unsigned nloc = b.st[0], nx = b.st[1];
        if (nloc == 0u) { xcd_barrier_complete(bar, b.x, nloc, nx); b.st[0] = nloc; b.st[1] = nx; }
        const unsigned old = xb_add(&bar[XB_XSUB(b.x)], 1u);
        const unsigned gen = old / nloc;
        if (old + 1u == (gen + 1u) * nloc) {
            __builtin_amdgcn_fence(__ATOMIC_RELEASE, "agent");
            asm volatile("s_waitcnt vmcnt(0)" ::: "memory");
            const unsigned og = xb_add(&bar[XB_TOP], 1u);
            const unsigned tg = og / nx;
            if (og + 1u == (tg + 1u) * nx) xb_add(&bar[XB_TOPGEN], 1u);
            else XB_SPIN(xb_ld(&bar[XB_TOPGEN]) == tg, bar);
            __builtin_amdgcn_fence(__ATOMIC_ACQUIRE, "agent");
            xb_add(&bar[XB_XGEN(b.x)], 1u);
            asm volatile("s_waitcnt vmcnt(0)" ::: "memory");
        } else {
            XB_SPIN(xb_ld(&bar[XB_XGEN(b.x)]) == gen, bar);
            __builtin_amdgcn_fence(__ATOMIC_ACQUIRE, "agent");
            asm volatile("s_waitcnt vmcnt(0)" ::: "memory");
        }
    }
    __syncthreads();
}

constexpr int DM = 1024, MP = 16384, MS = 2048, M = MP + MS;
constexpr int NIN = 3584, FF = 2816, NGU = 2 * FF, PLE = 256, PAST = 2048;
constexpr int NCP = 256, NCS = 32, NCH = NCP + NCS;
constexpr int RH = 4, RD = 128, AH = 8, AD = 64;
constexpr float EPS = 1e-6f, LOG2E = 1.4426950408889634f;
constexpr int ZQ = 0, ZK = 512, ZV = 1024, ZG = 1536, ZQA = 2048, ZKA = 2560, ZVA = 3072;
constexpr size_t OFF_Y = 0, OFF_RP = (size_t)M * DM, OFF_KP = OFF_RP + 65536, OFF_VP = OFF_KP + 262144, OFF_RS = OFF_VP + 262144,
                 OFF_KS = OFF_RS + 2097152, OFF_VS = OFF_KS + 1048576, OUT_TOTAL = OFF_VS + 1048576;
static_assert(OUT_TOTAL == 23658496, "output size");

constexpr size_t MiB = 1u << 20;
constexpr size_t WS_CTL = 0, CTL_ZERO_BYTES = 1 * MiB;
constexpr size_t WS_RSTDX = 1 * MiB, WS_ST1 = 2 * MiB, WS_ST2 = 4 * MiB;
constexpr size_t WS_WIN = 6 * MiB, WS_WOUT = 13 * MiB, WS_WGU = 15 * MiB, WS_WDN = 26 * MiB, WS_WPG = 32 * MiB, WS_WPP = 34 * MiB;
constexpr size_t WS_COS = 35 * MiB, WS_SIN = 39 * MiB, WS_PB = 43 * MiB;
constexpr size_t WS_A = 52 * MiB;
constexpr size_t WS_Z = 88 * MiB;
constexpr size_t WS_UR = 214 * MiB;
constexpr size_t WS_HB = 88 * MiB;
constexpr size_t WS_T = 124 * MiB;
constexpr size_t WS_END = 246 * MiB;
static_assert(WS_T + (size_t)M * FF * 2 <= WS_END && WS_Z + (size_t)M * NIN * 2 <= WS_UR && WS_HB + (size_t)M * DM * 2 <= WS_T, "ws map");

constexpr int CW_TMO = 0, CW_CODE = 1, CW_BAR = 4096;

using pg8::u32x4; using pg8::bf16_t; using pg8::Unit;
__device__ __forceinline__ u32x4 pack8(f32x4 a, f32x4 b) { u32x4 w; w.x = pg8::cvt_pk_bf16(a[0], a[1]); w.y = pg8::cvt_pk_bf16(a[2], a[3]); w.z = pg8::cvt_pk_bf16(b[0], b[1]); w.w = pg8::cvt_pk_bf16(b[2], b[3]); return w; }
__device__ __forceinline__ float bf2f(unsigned short b) { return __uint_as_float((unsigned)b << 16); }
__device__ __forceinline__ float sum4(f32x4 a) { return (a[0] + a[1]) + (a[2] + a[3]); }
__device__ __forceinline__ float rstd16(const float* st, int r) {
    const f32x4* p = (const f32x4*)(st + (size_t)r * 16); const f32x4 a = p[0], b = p[1], c = p[2], d = p[3];
    return rsqrtf(((sum4(a) + sum4(b)) + (sum4(c) + sum4(d))) * (1.0f / DM) + EPS);
}
__device__ __forceinline__ f32x4 sigmoid4(f32x4 g) { f32x4 o;
#pragma unroll
    for (int i = 0; i < 4; ++i) o[i] = __builtin_amdgcn_rcpf(1.0f + __builtin_amdgcn_exp2f(-g[i] * LOG2E));
    return o; }

struct EpiIn {
    static constexpr bool PERM = true, AFTER_DRAIN = false;
    bf16_t* Z; const float* rstd; const float* cosT; const float* sinT; const float* gq; const float* gk; float* dout;
    __device__ __forceinline__ void operator()(const f32x4 (&acc)[2][2][4][2], const Unit& u, int wr, int wc, int fr, int fq) const {
        const int pn = u.pn; const int rbase = u.pm * 256 + wr * 64 + fr;
        if (pn < 4) {
            const int sec = (pn >> 1) * 512, head = 2 * (pn & 1) + (wc >> 1), j0 = (wc & 1) * 32 + fq * 8;
            const float osc = (pn >= 2) ? 0.08838834764831845f : 1.0f;
#pragma unroll
            for (int ai = 0; ai < 2; ++ai)
#pragma unroll
                for (int m = 0; m < 4; ++m) {
                    const int r = rbase + ai * 128 + m * 16; const float rs = rstd[r] * osc; const int pos = r < MP ? r : PAST + ((r - MP) & 63);
                    const f32x4 c0 = *(const f32x4*)(cosT + (size_t)pos * 64 + j0), c1 = *(const f32x4*)(cosT + (size_t)pos * 64 + j0 + 4);
                    const f32x4 s0 = *(const f32x4*)(sinT + (size_t)pos * 64 + j0), s1 = *(const f32x4*)(sinT + (size_t)pos * 64 + j0 + 4);
                    const f32x4 x1a = acc[ai][0][m][0] * rs, x1b = acc[ai][0][m][1] * rs, x2a = acc[ai][1][m][0] * rs, x2b = acc[ai][1][m][1] * rs;
                    const f32x4 o1a = x1a * c0 - x2a * s0, o1b = x1b * c1 - x2b * s1, o2a = x1a * s0 + x2a * c0, o2b = x1b * s1 + x2b * c1;
                    bf16_t* dst = Z + (size_t)r * NIN + sec + head * 128 + j0;
                    *(u32x4*)dst = pack8(o1a, o1b); *(u32x4*)(dst + 64) = pack8(o2a, o2b);
                }
        } else if (pn < 8 || pn >= 12) {
#pragma unroll
            for (int ai = 0; ai < 2; ++ai)
#pragma unroll
                for (int m = 0; m < 4; ++m) {
                    const int r = rbase + ai * 128 + m * 16; const float rs = rstd[r];
#pragma unroll
                    for (int bj = 0; bj < 2; ++bj) {
                        const f32x4 v0 = acc[ai][bj][m][0] * rs, v1 = acc[ai][bj][m][1] * rs; const int t = bj * 128 + wc * 32 + fq * 8;
                        *(u32x4*)(Z + (size_t)r * NIN + pn * 256 + t) = pack8(v0, v1);
                        if (pn >= 12) { const int c5 = (pn - 12) * 256 + t;
                            if (r >= MP) { float* o = dout + OFF_VS + (size_t)(r - MP) * 512 + c5; *(f32x4*)o = v0; *(f32x4*)(o + 4) = v1; }
                            else if (r >= MP - 512) { float* o = dout + OFF_VP + (size_t)(r - (MP - 512)) * 512 + c5; *(f32x4*)o = v0; *(f32x4*)(o + 4) = v1; } }
                    }
                }
        } else {
            const float* g = pn < 10 ? gq : gk; f32x4 gv[2][2];
#pragma unroll
            for (int bj = 0; bj < 2; ++bj)
#pragma unroll
                for (int n = 0; n < 2; ++n) gv[bj][n] = *(const f32x4*)(g + bj * 32 + fq * 8 + 4 * n);
#pragma unroll
            for (int ai = 0; ai < 2; ++ai)
#pragma unroll
                for (int m = 0; m < 4; ++m) {
                    const int r = rbase + ai * 128 + m * 16; const float rs = rstd[r]; f32x4 v[2][2]; float ss = 0.f;
#pragma unroll
                    for (int bj = 0; bj < 2; ++bj)
#pragma unroll
                        for (int n = 0; n < 2; ++n) { v[bj][n] = acc[ai][bj][m][n] * rs; ss += sum4(v[bj][n] * v[bj][n]); }
                    ss += __shfl_xor(ss, 16); ss += __shfl_xor(ss, 32);
                    const float inv = rsqrtf(ss * (1.0f / 64.0f) + EPS);
#pragma unroll
                    for (int bj = 0; bj < 2; ++bj) {
                        const f32x4 o0 = v[bj][0] * inv * gv[bj][0], o1 = v[bj][1] * inv * gv[bj][1]; const int e = wc * 64 + bj * 32 + fq * 8;
                        *(u32x4*)(Z + (size_t)r * NIN + pn * 256 + e) = pack8(o0, o1);
                        if (pn >= 10) { const int c5 = (pn - 10) * 256 + e;
                            if (r >= MP) { float* o = dout + OFF_KS + (size_t)(r - MP) * 512 + c5; *(f32x4*)o = o0; *(f32x4*)(o + 4) = o1; }
                            else if (r >= MP - 512) { float* o = dout + OFF_KP + (size_t)(r - (MP - 512)) * 512 + c5; *(f32x4*)o = o0; *(f32x4*)(o + 4) = o1; } }
                    }
                }
        }
    }
};
struct EpiRes {
    static constexpr bool PERM = true, AFTER_DRAIN = false;
    const float* res_p; const float* res_s; float* out; bf16_t* hb; float* stats;
    __device__ __forceinline__ void operator()(const f32x4 (&acc)[2][2][4][2], const Unit& u, int wr, int wc, int fr, int fq) const {
        const int rbase = u.pm * 256 + wr * 64 + fr;
#pragma unroll
        for (int ai = 0; ai < 2; ++ai)
#pragma unroll
            for (int m = 0; m < 4; ++m) {
                const int r = rbase + ai * 128 + m * 16; const float* rp = r < MP ? res_p + (size_t)r * DM : res_s + (size_t)(r - MP) * DM; float ss = 0.f;
#pragma unroll
                for (int bj = 0; bj < 2; ++bj) {
                    const int c0 = u.pn * 256 + bj * 128 + wc * 32 + fq * 8;
                    const f32x4 h0 = *(const f32x4*)(rp + c0) + acc[ai][bj][m][0], h1 = *(const f32x4*)(rp + c0 + 4) + acc[ai][bj][m][1];
                    float* o = out + (size_t)r * DM + c0; *(f32x4*)o = h0; *(f32x4*)(o + 4) = h1;
                    *(u32x4*)(hb + (size_t)r * DM + c0) = pack8(h0, h1);
                    ss += sum4(h0 * h0) + sum4(h1 * h1);
                }
                ss += __shfl_xor(ss, 16); ss += __shfl_xor(ss, 32);
                if (fq == 0) stats[(size_t)r * 16 + u.pn * 4 + wc] = ss;
            }
    }
};
struct EpiGU {
    static constexpr bool PERM = true, AFTER_DRAIN = false;
    const float* stats; bf16_t* T;
    __device__ __forceinline__ void operator()(const f32x4 (&acc)[2][2][4][2], const Unit& u, int wr, int wc, int fr, int fq) const {
        const int rbase = u.pm * 256 + wr * 64 + fr;
#pragma unroll
        for (int ai = 0; ai < 2; ++ai)
#pragma unroll
            for (int m = 0; m < 4; ++m) {
                const int r = rbase + ai * 128 + m * 16; const float rs = rstd16(stats, r);
                const f32x4 g0 = acc[ai][0][m][0] * rs, g1 = acc[ai][0][m][1] * rs, u0 = acc[ai][1][m][0] * rs, u1 = acc[ai][1][m][1] * rs;
                const f32x4 t0 = g0 * sigmoid4(g0) * u0, t1 = g1 * sigmoid4(g1) * u1;
                *(u32x4*)(T + (size_t)r * FF + u.pn * 128 + wc * 32 + fq * 8) = pack8(t0, t1);
            }
    }
};
struct EpiPP {
    static constexpr bool PERM = true, AFTER_DRAIN = false;
    bf16_t* O;
    __device__ __forceinline__ void operator()(const f32x4 (&acc)[2][2][4][2], const Unit& u, int wr, int wc, int fr, int fq) const {
        const int rbase = u.pm * 256 + wr * 64 + fr;
#pragma unroll
        for (int ai = 0; ai < 2; ++ai)
#pragma unroll
            for (int m = 0; m < 4; ++m) { const int r = rbase + ai * 128 + m * 16;
#pragma unroll
                for (int bj = 0; bj < 2; ++bj) *(u32x4*)(O + (size_t)r * DM + u.pn * 256 + bj * 128 + wc * 32 + fq * 8) = pack8(acc[ai][bj][m][0], acc[ai][bj][m][1]); }
    }
};
struct EpiPG {
    static constexpr bool PERM = true, AFTER_DRAIN = false;
    const float* stats; const bf16_t* PP; float* y;
    __device__ __forceinline__ void operator()(const f32x4 (&acc)[2][2][4][2], const Unit& u, int wr, int wc, int fr, int fq) const {
        const int rbase = u.pm * 256 + wr * 64 + fr;
#pragma unroll
        for (int ai = 0; ai < 2; ++ai)
#pragma unroll
            for (int m = 0; m < 4; ++m) {
                const int r = rbase + ai * 128 + m * 16; const float rs = rstd16(stats, r);
#pragma unroll
                for (int bj = 0; bj < 2; ++bj) {
                    const int c0 = u.pn * 256 + bj * 128 + wc * 32 + fq * 8; float* o = y + (size_t)r * DM + c0;
                    const u32x4 pw = *(const u32x4*)(PP + (size_t)r * DM + c0);
                    const f32x4 p0 = {__uint_as_float(pw.x << 16), __uint_as_float(pw.x & 0xffff0000u), __uint_as_float(pw.y << 16), __uint_as_float(pw.y & 0xffff0000u)};
                    const f32x4 p1 = {__uint_as_float(pw.z << 16), __uint_as_float(pw.z & 0xffff0000u), __uint_as_float(pw.w << 16), __uint_as_float(pw.w & 0xffff0000u)};
                    const f32x4 y0 = *(const f32x4*)o + p0 * sigmoid4(acc[ai][bj][m][0] * rs), y1 = *(const f32x4*)(o + 4) + p1 * sigmoid4(acc[ai][bj][m][1] * rs);
                    *(f32x4*)o = y0; *(f32x4*)(o + 4) = y1;
                }
            }
    }
};

constexpr int NWAVES = 8, NTHR = 512;
#ifndef MK_ONE_LAUNCH
#define MK_ONE_LAUNCH 0
#endif
constexpr int NPH = 10;
constexpr int RING_OFF = 0, RING_BYTES = 131072, LDSCTL_OFF = RING_BYTES, MISC_OFF = LDSCTL_OFF + 320, LDS_BYTES = 147456;
typedef short s16x8 __attribute__((ext_vector_type(8)));
typedef short s16x4 __attribute__((ext_vector_type(4)));
typedef float f32x16 __attribute__((ext_vector_type(16)));
typedef unsigned u32x2v __attribute__((ext_vector_type(2)));

struct Frame {
    LAS unsigned char* lds; volatile LAS unsigned* MISC; gu32* ctl;
    int tid, lane, wave, vcu, G;
};
__device__ __forceinline__ float wave_sum(float v) {
#pragma unroll
    for (int o = 1; o < 64; o <<= 1) v += __shfl_xor(v, o);
    return v;
}
__device__ __forceinline__ float lg2_gamma(int h) { return log2f(1.0f - exp2f(-5.0f - (float)h)); }
__device__ __forceinline__ int crow(int r, int hi) { return (r & 3) + 8 * (r >> 2) + 4 * hi; }
__device__ __forceinline__ s16x8 frag(const LAS bf16* X, int ld, int row0, int k0, int lane) { return *(const LAS s16x8*)(X + (row0 + (lane & 31)) * ld + k0 + 8 * (lane >> 5)); }
#define MFMA32(a, b, c) __builtin_amdgcn_mfma_f32_32x32x16_bf16((a), (b), (c), 0, 0, 0)

__device__ __forceinline__ void tr_item(const float* W, int ldw, int K, int k0, int c0, bf16* WT, int d0, const float* g, LAS float* scr, int lane) {
#pragma unroll 8
    for (int i = 0; i < 32; ++i) { const int kk = 2 * i + (lane >> 5); float v = W[(size_t)(k0 + kk) * ldw + c0 + (lane & 31)]; if (g) v *= g[k0 + kk]; scr[kk * 33 + (lane & 31)] = v; }
    LDS_WAIT(); asm volatile("" ::: "memory");
    const int c = lane & 7;
#pragma unroll
    for (int j = 0; j < 4; ++j) { const int n = (lane >> 3) + 8 * j; const LAS float* s = scr + (8 * c) * 33 + n;
        v4u o; o.x = pk2(s[0 * 33], s[1 * 33]); o.y = pk2(s[2 * 33], s[3 * 33]); o.z = pk2(s[4 * 33], s[5 * 33]); o.w = pk2(s[6 * 33], s[7 * 33]);
        *(GAS v4u*)(WT + (size_t)(d0 + n) * K + k0 + 8 * c) = o; }
    LDS_WAIT(); asm volatile("" ::: "memory");
}
__device__ __forceinline__ int sigma_in(int np) {
    const int pn = np >> 8, t = np & 255;
    if (pn < 4) { const int base = (pn >> 1) * 512 + (pn & 1) * 256, tt = t & 127; return base + (tt >> 6) * 128 + (t >> 7) * 64 + (tt & 63); }
    if (pn >= 8 && pn < 12) return pn * 256 + ((t >> 5) & 3) * 64 + (t >> 7) * 32 + (t & 31);
    return np;
}
struct Ptrs {
    const float *xp, *xs, *ck, *cv, *sr, *pp, *ps, *g_mix, *w_in, *g_ro, *g_q, *g_k, *rel_bias, *w_out, *g_ffn, *w_g, *w_u, *w_d, *g_ple, *w_pg, *w_pp;
    float* out; unsigned char* ws;
};
__device__ __forceinline__ void p0_prologue(Frame& F, const Ptrs& P) {
    LAS float* scr = (LAS float*)(F.lds + RING_OFF + F.wave * 16384);
    const int gw = F.vcu * NWAVES + F.wave, NGW = F.G * NWAVES;
    bf16* Wt_in = (bf16*)(P.ws + WS_WIN); bf16* Wt_out = (bf16*)(P.ws + WS_WOUT); bf16* Wt_gu = (bf16*)(P.ws + WS_WGU);
    bf16* Wt_dn = (bf16*)(P.ws + WS_WDN); bf16* Wt_pg = (bf16*)(P.ws + WS_WPG); bf16* Wt_pp = (bf16*)(P.ws + WS_WPP);
    constexpr int I_IN = 16 * (NIN / 32), I_OUT = 16 * 32, I_GU = 16 * (NGU / 32), I_DN = (FF / 64) * 32, I_PG = 16 * 32, I_PP = 4 * 32;
    constexpr int NITEMS = I_IN + I_OUT + I_GU + I_DN + I_PG + I_PP;
    for (int it = gw; it < NITEMS; it += NGW) {
        int r = it;
        if (r < I_IN) { const int nb = r % (NIN / 32), kb = r / (NIN / 32); tr_item(P.w_in, NIN, DM, 64 * kb, sigma_in(32 * nb), Wt_in, 32 * nb, P.g_mix, scr, F.lane); continue; } r -= I_IN;
        if (r < I_OUT) { const int nb = r % 32, kb = r / 32; tr_item(P.w_out, DM, DM, 64 * kb, 32 * nb, Wt_out, 32 * nb, nullptr, scr, F.lane); continue; } r -= I_OUT;
        if (r < I_GU) { const int nb = r % (NGU / 32), kb = r / (NGU / 32); const int np = 32 * nb, pn = np >> 8, t = np & 255;
            tr_item(t < 128 ? P.w_g : P.w_u, FF, DM, 64 * kb, 128 * pn + (t & 127), Wt_gu, np, P.g_ffn, scr, F.lane); continue; } r -= I_GU;
        if (r < I_DN) { const int nb = r % 32, kb = r / 32; tr_item(P.w_d, DM, FF, 64 * kb, 32 * nb, Wt_dn, 32 * nb, nullptr, scr, F.lane); continue; } r -= I_DN;
        if (r < I_PG) { const int nb = r % 32, kb = r / 32; tr_item(P.w_pg, DM, DM, 64 * kb, 32 * nb, Wt_pg, 32 * nb, P.g_ple, scr, F.lane); continue; } r -= I_PG;
        { const int nb = r % 32, kb = r / 32; tr_item(P.w_pp, DM, PLE, 64 * kb, 32 * nb, Wt_pp, 32 * nb, nullptr, scr, F.lane); }
    }
    bf16* xb = (bf16*)(P.ws + WS_A); float* rstdx = (float*)(P.ws + WS_RSTDX);
    for (int m = gw; m < M; m += NGW) {
        const float* xr = m < MP ? P.xp + (size_t)m * DM : P.xs + (size_t)(m - MP) * DM;
        const GAS f32x4* x4 = (const GAS f32x4*)xr + F.lane; f32x4 v[4]; float s = 0.f;
#pragma unroll
        for (int j = 0; j < 4; ++j) { v[j] = x4[64 * j]; s += sum4(v[j] * v[j]); }
        s = wave_sum(s);
        GAS unsigned long long* o8 = (GAS unsigned long long*)(xb + (size_t)m * DM) + F.lane;
#pragma unroll
        for (int j = 0; j < 4; ++j) o8[64 * j] = (unsigned long long)pk2(v[j].x, v[j].y) | ((unsigned long long)pk2(v[j].z, v[j].w) << 32);
        if (F.lane == 0) rstdx[m] = rsqrtf(s * (1.0f / DM) + EPS);
    }
    bf16* pb = (bf16*)(P.ws + WS_PB);
    for (int m = gw; m < M; m += NGW) {
        const float* pr = m < MP ? P.pp + (size_t)m * PLE : P.ps + (size_t)(m - MP) * PLE;
        const f32x4 v = ((const GAS f32x4*)pr)[F.lane];
        ((GAS unsigned long long*)(pb + (size_t)m * PLE))[F.lane] = (unsigned long long)pk2(v.x, v.y) | ((unsigned long long)pk2(v.z, v.w) << 32);
    }
    float* cosT = (float*)(P.ws + WS_COS); float* sinT = (float*)(P.ws + WS_SIN);
    for (int i = (F.vcu * NTHR + F.tid); i < MP * 64; i += F.G * NTHR) {
        const int pos = i >> 6, j = i & 63;
        const float inv = exp2f(-(float)j * (13.287712379549449f / 64.0f));
        const float ang = (float)pos * inv;
        const float k = rintf(ang * 0.15915494309189535f);
        float r = fmaf(-k, 6.28125f, ang); r = fmaf(-k, 1.9353071795864769e-3f, r);
        cosT[i] = __cosf(r); sinT[i] = __sinf(r);
    }
}

__device__ __forceinline__ void attn_item(Frame& F, const Ptrs& P, int ci, int hg) {
    const bf16* Z = (const bf16*)(P.ws + WS_Z); bf16* MIX = (bf16*)(P.ws + WS_A);
    const int tid = F.tid, lane = F.lane, wave = F.wave, un = wave >> 1, qb = wave & 1, h = 4 * hg + un, tu = tid & 127, hi = lane >> 5, l31 = lane & 31;
    constexpr int LD = 72;
    LAS bf16* Qs = (LAS bf16*)(F.lds + un * 27648); LAS bf16* Ks = Qs + 64 * LD; LAS bf16* VT = Ks + 64 * LD;
    LAS float* BT = (LAS float*)(F.lds + 110592);
    LAS float* SC = (LAS float*)(F.lds + 110592 + 8320) + wave * 32;
    const bool samp = ci >= NCP; const int row0 = samp ? MP + (ci - NCP) * 64 : ci * 64; const int sb = ci - NCP;
    for (int i = tid; i < 4 * 513; i += NTHR) { const int hh = i / 513, idx = i % 513; const float* rb = P.rel_bias + (size_t)(4 * hg + hh) * 513; BT[hh * 520 + idx] = (rb[idx] - rb[512]) * LOG2E; }
    { const int row = tu >> 1, c0 = (tu & 1) * 32; const v4u* src = (const v4u*)(Z + (size_t)(row0 + row) * NIN + ZQA + h * 64 + c0);
#pragma unroll
      for (int i = 0; i < 4; ++i) *(LAS v4u*)(Qs + row * LD + c0 + 8 * i) = src[i]; }
    f32x16 o0 = {}, o1 = {}; float m_run = -1e30f, l_run = 0.f;
    const int jlo = samp ? 0 : (ci >= 8 ? 0 : 8 - ci);
    const float SCL = 0.125f * LOG2E;
    for (int j = jlo; j < 9; ++j) {
        __syncthreads();
        { const int row = tu >> 1, c0 = (tu & 1) * 32;
          if (samp && j < 8) {
              const float* ks = P.ck + ((size_t)(sb * 512 + 64 * j + row) * 8 + h) * 64 + c0; const float* vs = P.cv + ((size_t)(sb * 512 + 64 * j + row) * 8 + h) * 64 + c0;
#pragma unroll
              for (int i = 0; i < 8; ++i) { const f32x4 a = *(const f32x4*)(ks + 4 * i); *(LAS u32x2v*)(Ks + row * LD + c0 + 4 * i) = (u32x2v){pk2(a.x, a.y), pk2(a.z, a.w)};
                  const f32x4 b = *(const f32x4*)(vs + 4 * i);
                  VT[(c0 + 4 * i + 0) * LD + row] = (bf16)f2bf(b.x); VT[(c0 + 4 * i + 1) * LD + row] = (bf16)f2bf(b.y); VT[(c0 + 4 * i + 2) * LD + row] = (bf16)f2bf(b.z); VT[(c0 + 4 * i + 3) * LD + row] = (bf16)f2bf(b.w); }
          } else {
              const int kr = samp ? row0 + row : (ci - 8 + j) * 64 + row;
              const v4u* ks = (const v4u*)(Z + (size_t)kr * NIN + ZKA + h * 64 + c0); const bf16* vs = Z + (size_t)kr * NIN + ZVA + h * 64 + c0;
#pragma unroll
              for (int i = 0; i < 4; ++i) *(LAS v4u*)(Ks + row * LD + c0 + 8 * i) = ks[i];
#pragma unroll
              for (int i = 0; i < 4; ++i) { const v4u w = *(const v4u*)(vs + 8 * i);
#pragma unroll
                  for (int q = 0; q < 4; ++q) { const unsigned x = w[q]; VT[(c0 + 8 * i + 2 * q) * LD + row] = (bf16)(x & 0xffffu); VT[(c0 + 8 * i + 2 * q + 1) * LD + row] = (bf16)(x >> 16); } }
          } }
        __syncthreads();
        f32x16 p[2];
#pragma unroll
        for (int lb = 0; lb < 2; ++lb) { f32x16 a = {};
#pragma unroll
            for (int s = 0; s < 4; ++s) a = MFMA32(frag(Ks, LD, 32 * lb, 16 * s, lane), frag(Qs, LD, 32 * qb, 16 * s, lane), a);
            p[lb] = a; }
        const int t = 32 * qb + l31; float mx = -1e30f;
#pragma unroll
        for (int lb = 0; lb < 2; ++lb)
#pragma unroll
            for (int r = 0; r < 16; ++r) { const int lw = 64 * j + 32 * lb + crow(r, hi); int idx = 768 + t - lw; idx = idx < 0 ? 0 : (idx > 512 ? 512 : idx);
                const float v = p[lb][r] * SCL + BT[un * 520 + idx]; p[lb][r] = v; mx = fmaxf(mx, v); }
        mx = fmaxf(mx, __shfl_xor(mx, 32));
        const float m_new = fmaxf(m_run, mx), alpha = exp2f(m_run - m_new); m_run = m_new; float ls = 0.f;
#pragma unroll
        for (int lb = 0; lb < 2; ++lb)
#pragma unroll
            for (int r = 0; r < 16; ++r) { const float e = exp2f(p[lb][r] - m_new); p[lb][r] = e; ls += e; }
        l_run = l_run * alpha + ls;
        if (hi == 0) SC[l31] = alpha;
        asm volatile("s_waitcnt lgkmcnt(0)" ::: "memory");
#pragma unroll
        for (int r = 0; r < 16; ++r) { const float f = SC[crow(r, hi)]; o0[r] *= f; o1[r] *= f; }
        asm volatile("s_waitcnt lgkmcnt(0)" ::: "memory");
#pragma unroll
        for (int lb = 0; lb < 2; ++lb)
#pragma unroll
            for (int s2 = 0; s2 < 2; ++s2) {
                s16x8 pa;
#pragma unroll
                for (int q = 0; q < 4; ++q) { const unsigned w = pk2(p[lb][8 * s2 + 2 * q], p[lb][8 * s2 + 2 * q + 1]); pa[2 * q] = (short)(w & 0xffffu); pa[2 * q + 1] = (short)(w >> 16); }
                const int kb = 32 * lb + 16 * s2 + 4 * hi;
#pragma unroll
                for (int eb = 0; eb < 2; ++eb) {
                    const LAS bf16* vr = VT + (32 * eb + l31) * LD + kb;
                    const s16x4 lo = *(const LAS s16x4*)vr, hh = *(const LAS s16x4*)(vr + 8);
                    const s16x8 vb = {lo[0], lo[1], lo[2], lo[3], hh[0], hh[1], hh[2], hh[3]};
                    if (eb == 0) o0 = MFMA32(pa, vb, o0); else o1 = MFMA32(pa, vb, o1);
                }
            }
    }
    l_run += __shfl_xor(l_run, 32);
    if (hi == 0) SC[l31] = 1.0f / l_run;
    asm volatile("s_waitcnt lgkmcnt(0)" ::: "memory");
#pragma unroll
    for (int r = 0; r < 16; ++r) { const int n = 32 * qb + crow(r, hi); const float f = SC[crow(r, hi)];
        bf16* dst = MIX + (size_t)(row0 + n) * DM + 512 + h * 64 + l31;
        dst[0] = (bf16)f2bf(o0[r] * f); dst[32] = (bf16)f2bf(o1[r] * f); }
    __syncthreads();
}

__device__ __forceinline__ void retU_item(Frame& F, const Ptrs& P, int ci, int h) {
    const bf16* Z = (const bf16*)(P.ws + WS_Z);
    const int tid = F.tid, lane = F.lane, wave = F.wave, hi = lane >> 5, l31 = lane & 31;
    constexpr int LD = 72;
    LAS bf16* vT = (LAS bf16*)(F.lds); LAS bf16* kT = vT + 128 * LD;
    const bool samp = ci >= NCP; const int row0 = samp ? MP + (ci - NCP) * 64 : ci * 64;
    const float lg2 = lg2_gamma(h);
    __syncthreads();
    { const int m = tid >> 3, c0 = (tid & 7) * 16; const float zeta = exp2f((float)(63 - m) * lg2);
      const bf16* vs = Z + (size_t)(row0 + m) * NIN + ZV + h * 128 + c0; const bf16* ks = Z + (size_t)(row0 + m) * NIN + ZK + h * 128 + c0;
#pragma unroll
      for (int i = 0; i < 16; ++i) { vT[(c0 + i) * LD + m] = vs[i]; kT[(c0 + i) * LD + m] = (bf16)f2bf(bf2f(ks[i]) * zeta); } }
    __syncthreads();
    const LAS bf16* X = samp ? kT : vT; const LAS bf16* Y = samp ? vT : kT;
    const int ib = wave >> 1, jb0 = 2 * (wave & 1);
    f32x16 a0 = {}, a1 = {};
#pragma unroll
    for (int s = 0; s < 4; ++s) { const s16x8 a = frag(X, LD, 32 * ib, 16 * s, lane);
        a0 = MFMA32(a, frag(Y, LD, 32 * jb0, 16 * s, lane), a0); a1 = MFMA32(a, frag(Y, LD, 32 * jb0 + 32, 16 * s, lane), a1); }
    if (!samp) {
        bf16* UR = (bf16*)(P.ws + WS_UR) + (size_t)(ci * 4 + h) * 16384;
#pragma unroll
        for (int r = 0; r < 16; ++r) { const int e = 32 * ib + crow(r, hi); UR[e * 128 + 32 * jb0 + l31] = (bf16)f2bf(a0[r]); UR[e * 128 + 32 * jb0 + 32 + l31] = (bf16)f2bf(a1[r]); }
    } else {
        const int b = ci - NCP; const float g64 = exp2f(64.0f * lg2);
        const float* R0 = P.sr + (size_t)(b * 4 + h) * 16384; float* RO = P.out + OFF_RS + (size_t)(b * 4 + h) * 16384;
#pragma unroll
        for (int r = 0; r < 16; ++r) { const int d = 32 * ib + crow(r, hi); const int e0 = 32 * jb0 + l31;
            RO[d * 128 + e0] = g64 * R0[d * 128 + e0] + a0[r]; RO[d * 128 + e0 + 32] = g64 * R0[d * 128 + e0 + 32] + a1[r]; }
    }
}
__device__ __forceinline__ void ret_scan(Frame& F, const Ptrs& P) {
    const int gid = F.vcu * NTHR + F.tid;
    if (gid >= 32768) return;
    unsigned* base = (unsigned*)(P.ws + WS_UR) + gid; const int h = gid >> 13;
    const float g64 = exp2f(64.0f * lg2_gamma(h)); float R0 = 0.f, R1 = 0.f;
#pragma unroll 8
    for (int c = 0; c < NCP; ++c) { const unsigned u = base[(size_t)c * 32768]; base[(size_t)c * 32768] = pk2(R0, R1);
        R0 = g64 * R0 + __uint_as_float(u << 16); R1 = g64 * R1 + __uint_as_float(u & 0xffff0000u); }
    const int el = (2 * gid) & 16383, e = el >> 7, d = el & 127;
    float* o = P.out + OFF_RP + (size_t)h * 16384; o[d * 128 + e] = R0; o[(d + 1) * 128 + e] = R1;
}
__device__ __forceinline__ void retO_item(Frame& F, const Ptrs& P, int ci, int h) {
    const bf16* Z = (const bf16*)(P.ws + WS_Z); bf16* MIX = (bf16*)(P.ws + WS_A);
    const int tid = F.tid, lane = F.lane, wave = F.wave, hi = lane >> 5, l31 = lane & 31;
    constexpr int LQ = 136, LV = 72;
    LAS bf16* q = (LAS bf16*)(F.lds); LAS bf16* k = q + 64 * LQ; LAS bf16* vT = k + 64 * LQ; LAS bf16* RT = vT + 128 * LV; LAS bf16* Sm = RT + 128 * LQ;
    LAS float* ssq = (LAS float*)(Sm + 64 * LV);
    const bool samp = ci >= NCP; const int row0 = samp ? MP + (ci - NCP) * 64 : ci * 64;
    const float lg2 = lg2_gamma(h);
    __syncthreads();
    { const int m = tid >> 3, c0 = (tid & 7) * 16;
      const bf16* qs = Z + (size_t)(row0 + m) * NIN + ZQ + h * 128 + c0; const bf16* ks = Z + (size_t)(row0 + m) * NIN + ZK + h * 128 + c0; const bf16* vs = Z + (size_t)(row0 + m) * NIN + ZV + h * 128 + c0;
      *(LAS v4u*)(q + m * LQ + c0) = *(const v4u*)qs; *(LAS v4u*)(q + m * LQ + c0 + 8) = *(const v4u*)(qs + 8);
      *(LAS v4u*)(k + m * LQ + c0) = *(const v4u*)ks; *(LAS v4u*)(k + m * LQ + c0 + 8) = *(const v4u*)(ks + 8);
#pragma unroll
      for (int i = 0; i < 16; ++i) vT[(c0 + i) * LV + m] = vs[i];
      if (!samp) { const bf16* rs = (const bf16*)(P.ws + WS_UR) + (size_t)(ci * 4 + h) * 16384; const int e = tid >> 2, d0 = (tid & 3) * 32;
#pragma unroll
          for (int i = 0; i < 4; ++i) *(LAS v4u*)(RT + e * LQ + d0 + 8 * i) = *(const v4u*)(rs + e * 128 + d0 + 8 * i);
      } else { const float* rs = P.sr + (size_t)((ci - NCP) * 4 + h) * 16384;
#pragma unroll
          for (int i = 0; i < 8; ++i) { const int idx = i * 512 + tid, d = idx >> 5, e0 = (idx & 31) * 4; const f32x4 v = *(const f32x4*)(rs + d * 128 + e0);
              RT[(e0 + 0) * LQ + d] = (bf16)f2bf(v.x); RT[(e0 + 1) * LQ + d] = (bf16)f2bf(v.y); RT[(e0 + 2) * LQ + d] = (bf16)f2bf(v.z); RT[(e0 + 3) * LQ + d] = (bf16)f2bf(v.w); } }
    }
    __syncthreads();
    if (wave < 4) { const int nb = wave >> 1, mb = wave & 1; f32x16 a = {};
#pragma unroll
        for (int s = 0; s < 8; ++s) a = MFMA32(frag(q, LQ, 32 * nb, 16 * s, lane), frag(k, LQ, 32 * mb, 16 * s, lane), a);
        const int mcol = 32 * mb + l31;
#pragma unroll
        for (int r = 0; r < 16; ++r) { const int n = 32 * nb + crow(r, hi); const float dv = n >= mcol ? a[r] * exp2f((float)(n - mcol) * lg2) : 0.f; Sm[n * LV + mcol] = (bf16)f2bf(dv); } }
    __syncthreads();
    const int nb = wave >> 2, eb = wave & 3; f32x16 ai = {}, ac = {};
#pragma unroll
    for (int s = 0; s < 4; ++s) ai = MFMA32(frag(Sm, LV, 32 * nb, 16 * s, lane), frag(vT, LV, 32 * eb, 16 * s, lane), ai);
#pragma unroll
    for (int s = 0; s < 8; ++s) ac = MFMA32(frag(q, LQ, 32 * nb, 16 * s, lane), frag(RT, LQ, 32 * eb, 16 * s, lane), ac);
    float o[16];
#pragma unroll
    for (int r = 0; r < 16; ++r) { const int n = 32 * nb + crow(r, hi); o[r] = ai[r] + exp2f((float)(n + 1) * lg2) * ac[r];
        float s = o[r] * o[r]; s += __shfl_xor(s, 1); s += __shfl_xor(s, 2); s += __shfl_xor(s, 4); s += __shfl_xor(s, 8); s += __shfl_xor(s, 16);
        if (l31 == 0) ssq[(nb * 4 + eb) * 32 + crow(r, hi)] = s; }
    __syncthreads();
    const int e = 32 * eb + l31; const float gro = P.g_ro[h * 128 + e];
#pragma unroll
    for (int r = 0; r < 16; ++r) { const int nl = crow(r, hi), n = 32 * nb + nl;
        const float tot = (ssq[(nb * 4 + 0) * 32 + nl] + ssq[(nb * 4 + 1) * 32 + nl]) + (ssq[(nb * 4 + 2) * 32 + nl] + ssq[(nb * 4 + 3) * 32 + nl]);
        const float inv = rsqrtf(tot * (1.0f / 128.0f) + EPS);
        const float g = bf2f(Z[(size_t)(row0 + n) * NIN + ZG + h * 128 + e]);
        const float sg = g / (1.0f + exp2f(-g * LOG2E));
        MIX[(size_t)(row0 + n) * DM + h * 128 + e] = (bf16)f2bf(sg * o[r] * inv * gro); }
}

struct Args { const float* in[21]; float* out; unsigned char* ws; int ph_lo, ph_hi; };
template <int PHM> __global__ void __launch_bounds__(NTHR, 2) skel_fwd(Args args) {
    extern __shared__ __attribute__((aligned(16))) unsigned char lds[];
    Frame F;
    F.lds = (LAS unsigned char*)lds; F.MISC = (volatile LAS unsigned*)(F.lds + MISC_OFF);
    F.tid = threadIdx.x; F.lane = F.tid & 63; F.wave = __builtin_amdgcn_readfirstlane(F.tid >> 6);
    F.G = gridDim.x; { const int bx = blockIdx.x; F.vcu = (F.G % 8 == 0) ? (bx % 8) * (F.G / 8) + bx / 8 : bx; }
    unsigned char* ws = args.ws; F.ctl = (gu32*)(ws + WS_CTL);
    Ptrs P; P.xp = args.in[0]; P.xs = args.in[1]; P.ck = args.in[2]; P.cv = args.in[3]; P.sr = args.in[4]; P.pp = args.in[5]; P.ps = args.in[6]; P.g_mix = args.in[7]; P.w_in = args.in[8];
    P.g_ro = args.in[9]; P.g_q = args.in[10]; P.g_k = args.in[11]; P.rel_bias = args.in[12]; P.w_out = args.in[13]; P.g_ffn = args.in[14]; P.w_g = args.in[15]; P.w_u = args.in[16];
    P.w_d = args.in[17]; P.g_ple = args.in[18]; P.w_pg = args.in[19]; P.w_pp = args.in[20]; P.out = args.out; P.ws = ws;
    for (int u = F.tid; u < (LDS_BYTES - LDSCTL_OFF) / 4; u += NTHR) ((LAS unsigned*)(F.lds + LDSCTL_OFF))[u] = 0u;
    __syncthreads();
    XcdBarrier bar; bar.bar = (unsigned*)(F.ctl + CW_BAR); bar.x = 0; bar.st = nullptr;
    if (MK_ONE_LAUNCH) bar = xcd_barrier_post((unsigned*)(F.ctl + CW_BAR), F.MISC + 8);
#define GRID_BAR() do { if (MK_ONE_LAUNCH) xcd_barrier(bar); } while (0)
    const int lo = args.ph_lo, hi = args.ph_hi;
#define IN(k) (((PHM >> (k)) & 1) && lo <= (k) && (k) < hi)
#define BOTH(k) (IN(k) && IN((k) + 1))
    bf16* XB = (bf16*)(ws + WS_A); bf16* ZB = (bf16*)(ws + WS_Z); bf16* HB = (bf16*)(ws + WS_HB); bf16* TB = (bf16*)(ws + WS_T); bf16* PPB = (bf16*)(ws + WS_A);
    float* ST1 = (float*)(ws + WS_ST1); float* ST2 = (float*)(ws + WS_ST2);

    if (IN(0)) { p0_prologue(F, P); if (BOTH(0)) GRID_BAR(); }
    if (IN(1)) {
        pg8::Gemm g{XB, (const bf16*)(ws + WS_WIN), M, NIN, DM}; pg8::StaticOrder S; S.init(M, NIN, F.G, (int)blockIdx.x);
        EpiIn E{ZB, (const float*)(ws + WS_RSTDX), (const float*)(ws + WS_COS), (const float*)(ws + WS_SIN), P.g_q, P.g_k, P.out};
        pg8::gemm_phase<EpiIn, pg8::StaticOrder, true, true>(F.lds + RING_OFF, g, S, E);
        if (BOTH(1)) GRID_BAR();
    }
    if (IN(2)) {
        for (int it = F.vcu; it < NCH * 2; it += F.G) attn_item(F, P, it >> 1, it & 1);
        for (int it = F.vcu; it < NCH * RH; it += F.G) retU_item(F, P, it >> 2, it & 3);
        if (BOTH(2)) GRID_BAR();
    }
    if (IN(3)) { ret_scan(F, P); if (BOTH(3)) GRID_BAR(); }
    if (IN(4)) {
        for (int it = F.vcu; it < NCH * RH; it += F.G) retO_item(F, P, it >> 2, it & 3);
        __syncthreads();
        if (BOTH(4)) GRID_BAR();
    }
    if (IN(5)) {
        pg8::Gemm g{(const bf16*)(ws + WS_A), (const bf16*)(ws + WS_WOUT), M, DM, DM}; pg8::StaticOrder S; S.init(M, DM, F.G, (int)blockIdx.x);
        EpiRes E{P.xp, P.xs, P.out, HB, ST1};
        pg8::gemm_phase<EpiRes, pg8::StaticOrder, true, true>(F.lds + RING_OFF, g, S, E);
        if (BOTH(5)) GRID_BAR();
    }
    if (IN(6)) {
        pg8::Gemm g{HB, (const bf16*)(ws + WS_WGU), M, NGU, DM}; pg8::StaticOrder S; S.init(M, NGU, F.G, (int)blockIdx.x);
        EpiGU E{ST1, TB};
        pg8::gemm_phase<EpiGU, pg8::StaticOrder, true, true>(F.lds + RING_OFF, g, S, E);
        if (BOTH(6)) GRID_BAR();
    }
    if (IN(7)) {
        pg8::Gemm g{TB, (const bf16*)(ws + WS_WDN), M, DM, FF}; pg8::StaticOrder S; S.init(M, DM, F.G, (int)blockIdx.x);
        EpiRes E{P.out, P.out + (size_t)MP * DM, P.out, HB, ST2};
        pg8::gemm_phase<EpiRes, pg8::StaticOrder, true, true>(F.lds + RING_OFF, g, S, E);
        if (BOTH(7)) GRID_BAR();
    }
    if (IN(8)) {
        pg8::Gemm g{(const bf16*)(ws + WS_PB), (const bf16*)(ws + WS_WPP), M, DM, PLE}; pg8::StaticOrder S; S.init(M, DM, F.G, (int)blockIdx.x);
        EpiPP E{PPB};
        pg8::gemm_phase<EpiPP, pg8::StaticOrder, true, true>(F.lds + RING_OFF, g, S, E);
        if (BOTH(8)) GRID_BAR();
    }
    if (IN(9)) {
        pg8::Gemm g{HB, (const bf16*)(ws + WS_WPG), M, DM, DM}; pg8::StaticOrder S; S.init(M, DM, F.G, (int)blockIdx.x);
        EpiPG E{ST2, PPB, P.out};
        pg8::gemm_phase<EpiPG, pg8::StaticOrder, true, true>(F.lds + RING_OFF, g, S, E);
    }
#undef IN
#undef BOTH
}

extern "C" void kernel_launch(void* const* d_in, const int* in_sizes, int n_in, void* d_out, int out_size, void* d_ws, size_t ws_size, hipStream_t stream) {
    static int grid = 0;
    if (grid == 0) {
        if (n_in != 21 || out_size != (int)OUT_TOTAL || ws_size < WS_END) { fprintf(stderr, "kernel_launch: unexpected shapes n_in %d out %d ws %zu\n", n_in, out_size, ws_size); grid = -1; return; }
#if MK_ONE_LAUNCH
        if (hipFuncSetAttribute((const void*)skel_fwd<0x3ff>, hipFuncAttributeMaxDynamicSharedMemorySize, LDS_BYTES) != hipSuccess) { fprintf(stderr, "kernel_launch: hipFuncSetAttribute failed\n"); grid = -1; return; }
#else
#define SETATTR(ph) (void)hipFuncSetAttribute((const void*)skel_fwd<(1 << (ph))>, hipFuncAttributeMaxDynamicSharedMemorySize, LDS_BYTES)
        SETATTR(0); SETATTR(1); SETATTR(2); SETATTR(3); SETATTR(4); SETATTR(5); SETATTR(6); SETATTR(7); SETATTR(8); SETATTR(9);
#endif
        int dev = 0, cus = 0;
        if (hipGetDevice(&dev) != hipSuccess || hipDeviceGetAttribute(&cus, hipDeviceAttributeMultiprocessorCount, dev) != hipSuccess) { grid = -1; return; }
        (void)hipGetLastError();
        grid = cus;
    }
    if (grid < 0) return;
    (void)hipMemsetAsync((char*)d_ws + WS_CTL, 0, CTL_ZERO_BYTES, stream);
    Args a{};
    for (int i = 0; i < 21; ++i) a.in[i] = (const float*)d_in[i];
    a.out = (float*)d_out; a.ws = (unsigned char*)d_ws;
#if MK_ONE_LAUNCH
    a.ph_lo = 0; a.ph_hi = NPH;
    hipLaunchKernelGGL(skel_fwd<0x3ff>, dim3(grid), dim3(NTHR), LDS_BYTES, stream, a);
#else
#define LAUNCH_PH(ph) do { a.ph_lo = (ph); a.ph_hi = (ph) + 1; hipLaunchKernelGGL(skel_fwd<(1 << (ph))>, dim3(grid), dim3(NTHR), LDS_BYTES, stream, a); } while (0)
    LAUNCH_PH(0); LAUNCH_PH(1); LAUNCH_PH(2); LAUNCH_PH(3); LAUNCH_PH(4); LAUNCH_PH(5); LAUNCH_PH(6); LAUNCH_PH(7); LAUNCH_PH(8); LAUNCH_PH(9);
#endif
}
```

```cpp
#include <hip/hip_runtime.h>
#include <cstdio>
#include <cstdint>
namespace pg8 {
#define PG8_LAS __attribute__((address_space(3)))
typedef unsigned short bf16_t;
typedef short bf16x8 __attribute__((ext_vector_type(8)));
typedef float f32x4 __attribute__((ext_vector_type(4)));
typedef unsigned u32x4 __attribute__((ext_vector_type(4)));
constexpr int BM = 256, BK = 64, HALF = 128, HTB = HALF * BK * 2  , STAGE_BYTES = 8 * HTB, NXCD = 8, WGM = 8;

__host__ __device__ __forceinline__ int lds_byte(int r, int c) { const int st = (r >> 4) * 2 + (c >> 5), rr = r & 15, cc = c & 31, ob = rr * 64 + cc * 2; return st * 1024 + (ob ^ (((ob >> 9) & 1) << 5)); }
__host__ __device__ __forceinline__ void stage_rc(int b, int& R, int& C) { const int st = b / 1024, sb = b % 1024, swz = sb ^ (((sb >> 9) & 1) << 5); R = (st >> 1) * 16 + swz / 64; C = (st & 1) * 32 + (swz % 64) / 2; }
__host__ __device__ __forceinline__ int perm32(int rho) { const int n = rho >> 4, i = rho & 15; return 8 * (i >> 2) + 4 * n + (i & 3); }

struct Unit { int pm, pn; };
struct Gemm { const bf16_t* A; const bf16_t* Bt; int M, N, K; };

struct StaticOrder {
    int nM, nN, nwg, G, c;
    __host__ __device__ void init(int M, int N, int G_, int c_) { nM = M / BM; nN = N / BM; nwg = nM * nN; G = G_; c = c_; }
    __host__ __device__ bool next(int i, Unit& u) const {
        const long L = (long)i * G + c; if (L >= nwg) return false;
        int wgid = (int)L; { const int q = nwg / NXCD, r = nwg % NXCD, xcd = wgid % NXCD, off = wgid / NXCD; wgid = (xcd < r ? xcd * (q + 1) : r * (q + 1) + (xcd - r) * q) + off; }
        const int nig = WGM * nN, gid = wgid / nig, fm = gid * WGM, gsz = (nM - fm) < WGM ? (nM - fm) : WGM;
        u.pm = fm + ((wgid % nig) % gsz); u.pn = (wgid % nig) / gsz; return true;
    }
    __device__ __forceinline__ void a_ready(const Unit&) const {}
    __device__ __forceinline__ void done(const Unit&) const {}
};

__device__ __forceinline__ unsigned cvt_pk_bf16(float lo, float hi) { unsigned r; asm volatile("v_cvt_pk_bf16_f32 %0, %1, %2" : "=v"(r) : "v"(lo), "v"(hi)); return r; }
typedef float f32x2 __attribute__((ext_vector_type(2)));
template <class Epi, class Sched, bool ALIGN_EPI = false, bool SP2 = false>
__device__ __forceinline__ void gemm_phase(PG8_LAS unsigned char* lds, const Gemm g, const Sched& S, const Epi& E) {
    int tid_ = threadIdx.x; asm volatile("" : "+v"(tid_));
    const int tid = tid_, wid = __builtin_amdgcn_readfirstlane(tid >> 6), lane = tid & 63, wr = wid >> 2, wc = wid & 3, fr = lane & 15, fq = lane >> 4;
    const int K = g.K, nt = K / BK;
    unsigned voffA[2], voffB[2];
#pragma unroll
    for (int i = 0; i < 2; ++i) { int R, C; stage_rc(tid * 16 + i * 8192, R, C); const int Rb = Epi::PERM ? ((R & ~31) + perm32(R & 31)) : R;
        voffA[i] = (unsigned)(R * K + C) * 2u; voffB[i] = (unsigned)(Rb * K + C) * 2u; }
    const size_t kstep = (size_t)(BK * 2);
    const size_t hstep = (size_t)HALF * K * 2;
    const size_t tstep = 2 * hstep;
    const unsigned ldsw = (unsigned)wid * 1024u;
    const int aoff = lds_byte(wr * 64 + fr, fq * 8), boff = lds_byte(wc * 32 + fr, fq * 8);
#define PG8_SA(b, h) (((b) * 2 + (h)) * HTB)
#define PG8_SB(b, h) ((4 + (b) * 2 + (h)) * HTB)
#define PG8_STAGE(bufoff, gbase, voff) do { _Pragma("unroll") for (int _i = 0; _i < 2; ++_i) \
        __builtin_amdgcn_global_load_lds((const unsigned*)((const char*)(gbase) + (voff)[_i]), (PG8_LAS unsigned*)(lds + (bufoff) + ldsw + _i * 8192), 16, 0, 0); } while (0)
#define PG8_LDA(dst, b, h) do { _Pragma("unroll") for (int m = 0; m < 4; ++m) _Pragma("unroll") for (int k = 0; k < 2; ++k) dst[m][k] = *(const PG8_LAS bf16x8*)(lds + PG8_SA(b, h) + aoff + m * 2048 + k * 1024); } while (0)
#define PG8_LDB(dst, b, h) do { _Pragma("unroll") for (int n = 0; n < 2; ++n) _Pragma("unroll") for (int k = 0; k < 2; ++k) dst[n][k] = *(const PG8_LAS bf16x8*)(lds + PG8_SB(b, h) + boff + n * 2048 + k * 1024); } while (0)
#define PG8_MMA(ai, bj, At, Bt) do { __builtin_amdgcn_s_setprio(1); _Pragma("unroll") for (int m = 0; m < 4; ++m) _Pragma("unroll") for (int n = 0; n < 2; ++n) _Pragma("unroll") for (int k = 0; k < 2; ++k) \
        acc[ai][bj][m][n] = __builtin_amdgcn_mfma_f32_16x16x32_bf16(Bt[n][k], At[m][k], acc[ai][bj][m][n], 0, 0, 0); __builtin_amdgcn_s_setprio(0); } while (0)
#define PG8_WAIT_V(n) asm volatile("s_waitcnt vmcnt(" #n ")" ::: "memory")
#define PG8_WAIT_L(n) asm volatile("s_waitcnt lgkmcnt(" #n ")" ::: "memory")
#define PG8_BAR __builtin_amdgcn_s_barrier()
#define PG8_SCHED __builtin_amdgcn_sched_barrier(0)
    Unit cur, nxt; int ui = 0;
    if (!S.next(0, cur)) return;
    f32x4 acc[2][2][4][2];
#pragma unroll
    for (int a = 0; a < 2; ++a)
#pragma unroll
        for (int b = 0; b < 2; ++b)
#pragma unroll
            for (int m = 0; m < 4; ++m)
#pragma unroll
                for (int n = 0; n < 2; ++n) acc[a][b][m][n] = (f32x4){0.f, 0.f, 0.f, 0.f};
    bf16x8 At[4][2], B0[2][2], B1[2][2];
    const char* cA = (const char*)g.A + (size_t)cur.pm * tstep; const char* cB = (const char*)g.Bt + (size_t)cur.pn * tstep;
    S.a_ready(cur);
    if constexpr (SP2) {
        PG8_STAGE(PG8_SB(0, 0), cB, voffB); PG8_STAGE(PG8_SB(0, 1), cB + hstep, voffB); PG8_STAGE(PG8_SA(0, 0), cA, voffA); PG8_STAGE(PG8_SA(0, 1), cA + hstep, voffA);
        if (wr == 1) PG8_BAR;
        PG8_WAIT_V(2); PG8_BAR;
        PG8_STAGE(PG8_SB(1, 0), cB + kstep, voffB); PG8_STAGE(PG8_SA(1, 0), cA + kstep, voffA); PG8_STAGE(PG8_SB(1, 1), cB + hstep + kstep, voffB);
        PG8_WAIT_V(6); PG8_BAR;
    } else {
        PG8_STAGE(PG8_SB(0, 0), cB, voffB); PG8_STAGE(PG8_SA(0, 0), cA, voffA); PG8_STAGE(PG8_SB(0, 1), cB + hstep, voffB); PG8_STAGE(PG8_SA(0, 1), cA + hstep, voffA);
        if (wr == 1) PG8_BAR;
        PG8_WAIT_V(4); PG8_BAR;
        PG8_STAGE(PG8_SB(1, 0), cB + kstep, voffB); PG8_STAGE(PG8_SA(1, 0), cA + kstep, voffA); PG8_STAGE(PG8_SB(1, 1), cB + hstep + kstep, voffB);
        PG8_WAIT_V(6); PG8_BAR;
    }
    for (;;) {
        const bool has_next = S.next(ui + 1, nxt);
        const char* nA = has_next ? (const char*)g.A + (size_t)nxt.pm * tstep : cA; const char* nB = has_next ? (const char*)g.Bt + (size_t)nxt.pn * tstep : cB;
        for (int t = 0; t < nt; t += 2) {
            const bool last = (t == nt - 2);
            const char* a1 = cA + (size_t)(t + 1) * kstep;
            const char* a2 = last ? nA : cA + (size_t)(t + 2) * kstep; const char* b2 = last ? nB : cB + (size_t)(t + 2) * kstep;
            const char* a3 = a2 + kstep; const char* b3 = b2 + kstep;
            if (last && has_next) S.a_ready(nxt);
            if constexpr (SP2) {
            PG8_LDB(B0, 0, 0); PG8_LDB(B1, 0, 1); PG8_SCHED; PG8_LDA(At, 0, 0); PG8_STAGE(PG8_SA(1, 1), a1 + hstep, voffA);
            PG8_WAIT_V(8); PG8_WAIT_L(0); PG8_BAR; PG8_MMA(0, 0, At, B0); PG8_MMA(0, 1, At, B1); PG8_BAR; PG8_SCHED;
            PG8_LDA(At, 0, 1); PG8_STAGE(PG8_SB(0, 0), b2, voffB); PG8_STAGE(PG8_SB(0, 1), b2 + hstep, voffB); PG8_STAGE(PG8_SA(0, 0), a2, voffA);
            PG8_WAIT_V(8); PG8_WAIT_L(0); PG8_BAR; PG8_MMA(1, 0, At, B0); PG8_MMA(1, 1, At, B1); PG8_BAR; PG8_SCHED;
            PG8_LDB(B0, 1, 0); PG8_LDB(B1, 1, 1); PG8_SCHED; PG8_LDA(At, 1, 0); PG8_STAGE(PG8_SA(0, 1), a2 + hstep, voffA);
            PG8_WAIT_V(8); PG8_WAIT_L(0); PG8_BAR; PG8_MMA(0, 0, At, B0); PG8_MMA(0, 1, At, B1); PG8_BAR; PG8_SCHED;
            PG8_LDA(At, 1, 1); PG8_STAGE(PG8_SB(1, 0), b3, voffB); PG8_STAGE(PG8_SB(1, 1), b3 + hstep, voffB); PG8_STAGE(PG8_SA(1, 0), a3, voffA);
            PG8_WAIT_V(8); PG8_WAIT_L(0); PG8_BAR; PG8_MMA(1, 0, At, B0); PG8_MMA(1, 1, At, B1); PG8_BAR; PG8_SCHED;
            } else {
            PG8_LDB(B0, 0, 0); PG8_SCHED; PG8_LDA(At, 0, 0); PG8_STAGE(PG8_SA(1, 1), a1 + hstep, voffA);
            PG8_WAIT_L(8); PG8_BAR; PG8_WAIT_L(0); PG8_MMA(0, 0, At, B0); PG8_BAR; PG8_SCHED;
            PG8_LDB(B1, 0, 1); PG8_STAGE(PG8_SB(0, 0), b2, voffB);
            PG8_BAR; PG8_WAIT_L(0); PG8_MMA(0, 1, At, B1); PG8_BAR;
            PG8_LDA(At, 0, 1); PG8_STAGE(PG8_SA(0, 0), a2, voffA);
            PG8_BAR; PG8_WAIT_L(0); PG8_MMA(1, 0, At, B0); PG8_BAR; PG8_SCHED;
            PG8_STAGE(PG8_SB(0, 1), b2 + hstep, voffB);
            PG8_WAIT_V(6); PG8_BAR; PG8_MMA(1, 1, At, B1); PG8_BAR;
            PG8_LDB(B0, 1, 0); PG8_SCHED; PG8_LDA(At, 1, 0); PG8_STAGE(PG8_SA(0, 1), a2 + hstep, voffA);
            PG8_WAIT_L(8); PG8_BAR; PG8_WAIT_L(0); PG8_MMA(0, 0, At, B0); PG8_BAR; PG8_SCHED;
            PG8_LDB(B1, 1, 1); PG8_STAGE(PG8_SB(1, 0), b3, voffB);
            PG8_BAR; PG8_WAIT_L(0); PG8_MMA(0, 1, At, B1); PG8_BAR;
            PG8_LDA(At, 1, 1); PG8_STAGE(PG8_SA(1, 0), a3, voffA);
            PG8_BAR; PG8_WAIT_L(0); PG8_MMA(1, 0, At, B0); PG8_BAR; PG8_SCHED;
            PG8_STAGE(PG8_SB(1, 1), b3 + hstep, voffB);
            PG8_WAIT_V(6); PG8_BAR; PG8_MMA(1, 1, At, B1); PG8_BAR;
            }
        }
        if constexpr (ALIGN_EPI) { if (wr == 0) PG8_BAR; }
        if constexpr (!Epi::AFTER_DRAIN) { E(acc, cur, wr, wc, fr, fq); S.done(cur); }
        if (!has_next) break;
#pragma unroll
        for (int a = 0; a < 2; ++a)
#pragma unroll
            for (int b = 0; b < 2; ++b)
#pragma unroll
                for (int m = 0; m < 4; ++m)
#pragma unroll
                    for (int n = 0; n < 2; ++n) acc[a][b][m][n] = (f32x4){0.f, 0.f, 0.f, 0.f};
        cur = nxt; cA = nA; cB = nB; ++ui;
        if constexpr (ALIGN_EPI) { if (wr == 1) PG8_BAR; }
    }
    PG8_WAIT_V(0);
    if constexpr (!ALIGN_EPI) { if (wr == 0) PG8_BAR; }
    PG8_BAR;
    if constexpr (Epi::AFTER_DRAIN) { E.fused(acc, cur, wr, wc, fr, fq, lds, wid, lane); S.done(cur); }
#undef PG8_SA
#undef PG8_SB
#undef PG8_STAGE
#undef PG8_LDA
#undef PG8_LDB
#undef PG8_MMA
#undef PG8_WAIT_V
#undef PG8_WAIT_L
#undef PG8_BAR
#undef PG8_SCHED
}
}
#define GAS __attribute__((address_space(1)))
#define LAS __attribute__((address_space(3)))
typedef unsigned short bf16;
typedef unsigned v4u __attribute__((ext_vector_type(4)));
typedef float f32x4 __attribute__((ext_vector_type(4)));
typedef short bf16x8 __attribute__((ext_vector_type(8)));
typedef GAS unsigned gu32;
typedef GAS unsigned long long gu64;
#define RLX_AGENT __ATOMIC_RELAXED, __HIP_MEMORY_SCOPE_AGENT
#define LDS_WAIT() asm volatile("s_waitcnt lgkmcnt(0)" ::: "memory")
#define VM_WAIT() asm volatile("s_waitcnt vmcnt(0)" ::: "memory")
__device__ __forceinline__ unsigned long long rt() { return __builtin_amdgcn_s_memrealtime(); }
__device__ __forceinline__ unsigned f2bf(float f) { unsigned u = __builtin_bit_cast(unsigned, f); return (u + 0x7fffu + ((u >> 16) & 1u)) >> 16; }
__device__ __forceinline__ unsigned pk2(float lo, float hi) { return f2bf(lo) | (f2bf(hi) << 16); }

#define XB_TMO      128
#define XB_XCNT(j)  (256  + 64 * (j))
#define XB_XSUB(j)  (1280 + 64 * (j))
#define XB_XGEN(j)  (2304 + 64 * (j))
#define XB_TOP      3328
#define XB_TOPGEN   3392
#define XCD_BAR_WORDS 3456
#define XB_SPIN_CAP (1u << 18)

__device__ __forceinline__ unsigned xb_ld(unsigned* p)              { return __hip_atomic_load(p, __ATOMIC_RELAXED, __HIP_MEMORY_SCOPE_AGENT); }
__device__ __forceinline__ unsigned xb_add(unsigned* p, unsigned v) { return __hip_atomic_fetch_add(p, v, __ATOMIC_RELAXED, __HIP_MEMORY_SCOPE_AGENT); }
__device__ __forceinline__ unsigned xb_xcc_id() { return (unsigned)__builtin_amdgcn_s_getreg((3 << 11) | 20) & 0xFu; }
#define XB_SPIN(cond, bar) do { unsigned _sp = 0; while (cond) { __builtin_amdgcn_s_sleep(1); \
    if ((++_sp & 255u) == 0u) { if (xb_ld(&(bar)[XB_TMO])) break; if (_sp > XB_SPIN_CAP) { atomicAdd(&(bar)[XB_TMO], 1u); break; } } } } while (0)

struct XcdBarrier {
    unsigned* bar; unsigned x;
    volatile LAS unsigned* st;
};

__device__ __forceinline__ XcdBarrier xcd_barrier_post(unsigned* bar, volatile LAS unsigned* st) {
    XcdBarrier b; b.bar = bar; b.x = xb_xcc_id(); b.st = st;
    if (threadIdx.x == 0) (void)xb_add(&bar[XB_XCNT(b.x)], 1u);
    return b;
}
__device__ __forceinline__ void xcd_barrier_complete(unsigned* bar, unsigned x, unsigned& nloc, unsigned& nx) {
    const unsigned G = gridDim.x * gridDim.y * gridDim.z;
    unsigned sum, cnt, mine, sp = 0u;
    for (;;) {
        sum = 0u; cnt = 0u; mine = 0u;
#pragma unroll
        for (unsigned j = 0; j < 16; ++j) { const unsigned c = xb_ld(&bar[XB_XCNT(j)]); sum += c; cnt += (c > 0u) ? 1u : 0u; mine = (j == x) ? c : mine; }
        if (sum == G) break;
        __builtin_amdgcn_s_sleep(1);
        if ((++sp & 255u) == 0u) { if (xb_ld(&bar[XB_TMO])) break; if (sp > XB_SPIN_CAP) { atomicAdd(&bar[XB_TMO], 1u); break; } }
    }
    nloc = mine > 0u ? mine : 1u; nx = cnt > 0u ? cnt : 1u;
}

__device__ __forceinline__ void xcd_barrier(const XcdBarrier& b) {
    asm volatile("s_waitcnt vmcnt(0)" ::: "memory");
    __syncthreads();
    if (threadIdx.x == 0) {
        unsigned* bar = b.bar;
        __builtin_amdgcn_s_waitcnt(0);
        unsigned nloc = b.st[0], nx = b.st[1];
        if (nloc == 0u) { xcd_barrier_complete(bar, b.x, nloc, nx); b.st[0] = nloc; b.st[1] = nx; }
        const unsigned old = xb_add(&bar[XB_XSUB(b.x)], 1u);
        const unsigned gen = old / nloc;
        if (old + 1u == (gen + 1u) * nloc) {
            __builtin_amdgcn_fence(__ATOMIC_RELEASE, "agent");
            asm volatile("s_waitcnt vmcnt(0)" ::: "memory");
            const unsigned og = xb_add(&bar[XB_TOP], 1u);
            const unsigned tg = og / nx;
            if (og + 1u == (tg + 1u) * nx) xb_add(&bar[XB_TOPGEN], 1u);
            else XB_SPIN(xb_ld(&bar[XB_TOPGEN]) == tg, bar);
            __builtin_amdgcn_fence(__ATOMIC_ACQUIRE, "agent");
            xb_add(&bar[XB_XGEN(b.x)], 1u);
            asm volatile("s_waitcnt vmcnt(0)" ::: "memory");
        } else {
            XB_SPIN(xb_ld(&bar[XB_XGEN(b.x)]) == gen, bar);
            __builtin_amdgcn_fence(__ATOMIC_ACQUIRE, "agent");
            asm volatile("s_waitcnt vmcnt(0)" ::: "memory");
        }
    }
    __syncthreads();
}

constexpr int DM = 1024, MP = 16384, MS = 2048, M = MP + MS;
constexpr int NIN = 3584, FF = 2816, NGU = 2 * FF, PLE = 256, PAST = 2048;
constexpr int NCP = 256, NCS = 32, NCH = NCP + NCS;
constexpr int RH = 4, RD = 128, AH = 8, AD = 64;
constexpr float EPS = 1e-6f, LOG2E = 1.4426950408889634f;
constexpr int ZQ = 0, ZK = 512, ZV = 1024, ZG = 1536, ZQA = 2048, ZKA = 2560, ZVA = 3072;
constexpr size_t OFF_Y = 0, OFF_RP = (size_t)M * DM, OFF_KP = OFF_RP + 65536, OFF_VP = OFF_KP + 262144, OFF_RS = OFF_VP + 262144,
                 OFF_KS = OFF_RS + 2097152, OFF_VS = OFF_KS + 1048576, OUT_TOTAL = OFF_VS + 1048576;
static_assert(OUT_TOTAL == 23658496, "output size");

constexpr size_t MiB = 1u << 20;
constexpr size_t WS_CTL = 0, CTL_ZERO_BYTES = 1 * MiB;
constexpr size_t WS_RSTDX = 1 * MiB, WS_ST1 = 2 * MiB, WS_ST2 = 4 * MiB;
constexpr size_t WS_WIN = 6 * MiB, WS_WOUT = 13 * MiB, WS_WGU = 15 * MiB, WS_WDN = 26 * MiB, WS_WPG = 32 * MiB, WS_WPP = 34 * MiB;
constexpr size_t WS_COS = 35 * MiB, WS_SIN = 39 * MiB, WS_PB = 43 * MiB;
constexpr size_t WS_A = 52 * MiB;
constexpr size_t WS_Z = 88 * MiB;
constexpr size_t WS_UR = 214 * MiB;
constexpr size_t WS_HB = 88 * MiB;
constexpr size_t WS_T = 124 * MiB;
constexpr size_t WS_END = 246 * MiB;
static_assert(WS_T + (size_t)M * FF * 2 <= WS_END && WS_Z + (size_t)M * NIN * 2 <= WS_UR && WS_HB + (size_t)M * DM * 2 <= WS_T, "ws map");

constexpr int CW_TMO = 0, CW_CODE = 1, CW_BAR = 4096;

using pg8::u32x4; using pg8::bf16_t; using pg8::Unit;
__device__ __forceinline__ u32x4 pack8(f32x4 a, f32x4 b) { u32x4 w; w.x = pg8::cvt_pk_bf16(a[0], a[1]); w.y = pg8::cvt_pk_bf16(a[2], a[3]); w.z = pg8::cvt_pk_bf16(b[0], b[1]); w.w = pg8::cvt_pk_bf16(b[2], b[3]); return w; }
__device__ __forceinline__ float bf2f(unsigned short b) { return __uint_as_float((unsigned)b << 16); }
__device__ __forceinline__ float sum4(f32x4 a) { return (a[0] + a[1]) + (a[2] + a[3]); }
__device__ __forceinline__ float rstd16(const float* st, int r) {
    const f32x4* p = (const f32x4*)(st + (size_t)r * 16); const f32x4 a = p[0], b = p[1], c = p[2], d = p[3];
    return rsqrtf(((sum4(a) + sum4(b)) + (sum4(c) + sum4(d))) * (1.0f / DM) + EPS);
}
__device__ __forceinline__ f32x4 sigmoid4(f32x4 g) { f32x4 o;
#pragma unroll
    for (int i = 0; i < 4; ++i) o[i] = __builtin_amdgcn_rcpf(1.0f + __builtin_amdgcn_exp2f(-g[i] * LOG2E));
    return o; }

struct EpiIn {
    static constexpr bool PERM = true, AFTER_DRAIN = false;
    bf16_t* Z; const float* rstd; const float* cosT; const float* sinT; const float* gq; const float* gk; float* dout;
    __device__ __forceinline__ void operator()(const f32x4 (&acc)[2][2][4][2], const Unit& u, int wr, int wc, int fr, int fq) const {
        const int pn = u.pn; const int rbase = u.pm * 256 + wr * 64 + fr;
        if (pn < 4) {
            const int sec = (pn >> 1) * 512, head = 2 * (pn & 1) + (wc >> 1), j0 = (wc & 1) * 32 + fq * 8;
            const float osc = (pn >= 2) ? 0.08838834764831845f : 1.0f;
#pragma unroll
            for (int ai = 0; ai < 2; ++ai)
#pragma unroll
                for (int m = 0; m < 4; ++m) {
                    const int r = rbase + ai * 128 + m * 16; const float rs = rstd[r] * osc; const int pos = r < MP ? r : PAST + ((r - MP) & 63);
                    const f32x4 c0 = *(const f32x4*)(cosT + (size_t)pos * 64 + j0), c1 = *(const f32x4*)(cosT + (size_t)pos * 64 + j0 + 4);
                    const f32x4 s0 = *(const f32x4*)(sinT + (size_t)pos * 64 + j0), s1 = *(const f32x4*)(sinT + (size_t)pos * 64 + j0 + 4);
                    const f32x4 x1a = acc[ai][0][m][0] * rs, x1b = acc[ai][0][m][1] * rs, x2a = acc[ai][1][m][0] * rs, x2b = acc[ai][1][m][1] * rs;
                    const f32x4 o1a = x1a * c0 - x2a * s0, o1b = x1b * c1 - x2b * s1, o2a = x1a * s0 + x2a * c0, o2b = x1b * s1 + x2b * c1;
                    bf16_t* dst = Z + (size_t)r * NIN + sec + head * 128 + j0;
                    *(u32x4*)dst = pack8(o1a, o1b); *(u32x4*)(dst + 64) = pack8(o2a, o2b);
                }
        } else if (pn < 8 || pn >= 12) {
#pragma unroll
            for (int ai = 0; ai < 2; ++ai)
#pragma unroll
                for (int m = 0; m < 4; ++m) {
                    const int r = rbase + ai * 128 + m * 16; const float rs = rstd[r];
#pragma unroll
                    for (int bj = 0; bj < 2; ++bj) {
                        const f32x4 v0 = acc[ai][bj][m][0] * rs, v1 = acc[ai][bj][m][1] * rs; const int t = bj * 128 + wc * 32 + fq * 8;
                        *(u32x4*)(Z + (size_t)r * NIN + pn * 256 + t) = pack8(v0, v1);
                        if (pn >= 12) { const int c5 = (pn - 12) * 256 + t;
                            if (r >= MP) { float* o = dout + OFF_VS + (size_t)(r - MP) * 512 + c5; *(f32x4*)o = v0; *(f32x4*)(o + 4) = v1; }
                            else if (r >= MP - 512) { float* o = dout + OFF_VP + (size_t)(r - (MP - 512)) * 512 + c5; *(f32x4*)o = v0; *(f32x4*)(o + 4) = v1; } }
                    }
                }
        } else {
            const float* g = pn < 10 ? gq : gk; f32x4 gv[2][2];
#pragma unroll
            for (int bj = 0; bj < 2; ++bj)
#pragma unroll
                for (int n = 0; n < 2; ++n) gv[bj][n] = *(const f32x4*)(g + bj * 32 + fq * 8 + 4 * n);
#pragma unroll
            for (int ai = 0; ai < 2; ++ai)
#pragma unroll
                for (int m = 0; m < 4; ++m) {
                    const int r = rbase + ai * 128 + m * 16; const float rs = rstd[r]; f32x4 v[2][2]; float ss = 0.f;
#pragma unroll
                    for (int bj = 0; bj < 2; ++bj)
#pragma unroll
                        for (int n = 0; n < 2; ++n) { v[bj][n] = acc[ai][bj][m][n] * rs; ss += sum4(v[bj][n] * v[bj][n]); }
                    ss += __shfl_xor(ss, 16); ss += __shfl_xor(ss, 32);
                    const float inv = rsqrtf(ss * (1.0f / 64.0f) + EPS);
#pragma unroll
                    for (int bj = 0; bj < 2; ++bj) {
                        const f32x4 o0 = v[bj][0] * inv * gv[bj][0], o1 = v[bj][1] * inv * gv[bj][1]; const int e = wc * 64 + bj * 32 + fq * 8;
                        *(u32x4*)(Z + (size_t)r * NIN + pn * 256 + e) = pack8(o0, o1);
                        if (pn >= 10) { const int c5 = (pn - 10) * 256 + e;
                            if (r >= MP) { float* o = dout + OFF_KS + (size_t)(r - MP) * 512 + c5; *(f32x4*)o = o0; *(f32x4*)(o + 4) = o1; }
                            else if (r >= MP - 512) { float* o = dout + OFF_KP + (size_t)(r - (MP - 512)) * 512 + c5; *(f32x4*)o = o0; *(f32x4*)(o + 4) = o1; } }
                    }
                }
        }
    }
};
struct EpiRes {
    static constexpr bool PERM = true, AFTER_DRAIN = false;
    const float* res_p; const float* res_s; float* out; bf16_t* hb; float* stats;
    __device__ __forceinline__ void operator()(const f32x4 (&acc)[2][2][4][2], const Unit& u, int wr, int wc, int fr, int fq) const {
        const int rbase = u.pm * 256 + wr * 64 + fr;
#pragma unroll
        for (int ai = 0; ai < 2; ++ai)
#pragma unroll
            for (int m = 0; m < 4; ++m) {
                const int r = rbase + ai * 128 + m * 16; const float* rp = r < MP ? res_p + (size_t)r * DM : res_s + (size_t)(r - MP) * DM; float ss = 0.f;
#pragma unroll
                for (int bj = 0; bj < 2; ++bj) {
                    const int c0 = u.pn * 256 + bj * 128 + wc * 32 + fq * 8;
                    const f32x4 h0 = *(const f32x4*)(rp + c0) + acc[ai][bj][m][0], h1 = *(const f32x4*)(rp + c0 + 4) + acc[ai][bj][m][1];
                    float* o = out + (size_t)r * DM + c0; *(f32x4*)o = h0; *(f32x4*)(o + 4) = h1;
                    *(u32x4*)(hb + (size_t)r * DM + c0) = pack8(h0, h1);
                    ss += sum4(h0 * h0) + sum4(h1 * h1);
                }
                ss += __shfl_xor(ss, 16); ss += __shfl_xor(ss, 32);
                if (fq == 0) stats[(size_t)r * 16 + u.pn * 4 + wc] = ss;
            }
    }
};
struct EpiGU {
    static constexpr bool PERM = true, AFTER_DRAIN = false;
    const float* stats; bf16_t* T;
    __device__ __forceinline__ void operator()(const f32x4 (&acc)[2][2][4][2], const Unit& u, int wr, int wc, int fr, int fq) const {
        const int rbase = u.pm * 256 + wr * 64 + fr;
#pragma unroll
        for (int ai = 0; ai < 2; ++ai)
#pragma unroll
            for (int m = 0; m < 4; ++m) {
                const int r = rbase + ai * 128 + m * 16; const float rs = rstd16(stats, r);
                const f32x4 g0 = acc[ai][0][m][0] * rs, g1 = acc[ai][0][m][1] * rs, u0 = acc[ai][1][m][0] * rs, u1 = acc[ai][1][m][1] * rs;
                const f32x4 t0 = g0 * sigmoid4(g0) * u0, t1 = g1 * sigmoid4(g1) * u1;
                *(u32x4*)(T + (size_t)r * FF + u.pn * 128 + wc * 32 + fq * 8) = pack8(t0, t1);
            }
    }
};
struct EpiPP {
    static constexpr bool PERM = true, AFTER_DRAIN = false;
    bf16_t* O;
    __device__ __forceinline__ void operator()(const f32x4 (&acc)[2][2][4][2], const Unit& u, int wr, int wc, int fr, int fq) const {
        const unsigned boff = (unsigned)((u.pm * 256 + wr * 64 + fr) * DM + u.pn * 256 + wc * 32 + fq * 8) * 2u;
#pragma unroll
        for (int ai = 0; ai < 2; ++ai)
#pragma unroll
            for (int m = 0; m < 4; ++m) {
#pragma unroll
                for (int bj = 0; bj < 2; ++bj) *(u32x4*)((char*)O + (boff + (unsigned)((ai * 128 + m * 16) * DM + bj * 128) * 2u)) = pack8(acc[ai][bj][m][0], acc[ai][bj][m][1]);
                asm volatile("" ::: "memory"); }
    }
};
struct EpiPG {
    static constexpr bool PERM = true, AFTER_DRAIN = false;
    const float* stats; const bf16_t* PP; float* y;
    __device__ __forceinline__ void operator()(const f32x4 (&acc)[2][2][4][2], const Unit& u, int wr, int wc, int fr, int fq) const {
        const int rbase = u.pm * 256 + wr * 64 + fr;
#pragma unroll
        for (int ai = 0; ai < 2; ++ai)
#pragma unroll
            for (int m = 0; m < 4; ++m) {
                const int r = rbase + ai * 128 + m * 16; const float rs = rstd16(stats, r);
#pragma unroll
                for (int bj = 0; bj < 2; ++bj) {
                    const int c0 = u.pn * 256 + bj * 128 + wc * 32 + fq * 8; float* o = y + (size_t)r * DM + c0;
                    const u32x4 pw = *(const u32x4*)(PP + (size_t)r * DM + c0);
                    const f32x4 p0 = {__uint_as_float(pw.x << 16), __uint_as_float(pw.x & 0xffff0000u), __uint_as_float(pw.y << 16), __uint_as_float(pw.y & 0xffff0000u)};
                    const f32x4 p1 = {__uint_as_float(pw.z << 16), __uint_as_float(pw.z & 0xffff0000u), __uint_as_float(pw.w << 16), __uint_as_float(pw.w & 0xffff0000u)};
                    const f32x4 y0 = *(const f32x4*)o + p0 * sigmoid4(acc[ai][bj][m][0] * rs), y1 = *(const f32x4*)(o + 4) + p1 * sigmoid4(acc[ai][bj][m][1] * rs);
                    *(f32x4*)o = y0; *(f32x4*)(o + 4) = y1;
                }
            }
    }
};

constexpr int NWAVES = 8, NTHR = 512;
#ifndef MK_ONE_LAUNCH
#define MK_ONE_LAUNCH 1
#endif
constexpr int NPH = 10;
constexpr int RING_OFF = 0, RING_BYTES = 131072, LDSCTL_OFF = RING_BYTES, MISC_OFF = LDSCTL_OFF + 320, LDS_BYTES = 147456;
typedef short s16x8 __attribute__((ext_vector_type(8)));
typedef short s16x4 __attribute__((ext_vector_type(4)));
typedef float f32x16 __attribute__((ext_vector_type(16)));
typedef unsigned u32x2v __attribute__((ext_vector_type(2)));

struct Frame {
    LAS unsigned char* lds; volatile LAS unsigned* MISC; gu32* ctl;
    int tid, lane, wave, vcu, G;
};
__device__ __forceinline__ float wave_sum(float v) {
#pragma unroll
    for (int o = 1; o < 64; o <<= 1) v += __shfl_xor(v, o);
    return v;
}
__device__ __forceinline__ float lg2_gamma(int h) { return log2f(1.0f - exp2f(-5.0f - (float)h)); }
__device__ __forceinline__ int crow(int r, int hi) { return (r & 3) + 8 * (r >> 2) + 4 * hi; }
__device__ __forceinline__ s16x8 frag(const LAS bf16* X, int ld, int row0, int k0, int lane) { return *(const LAS s16x8*)(X + (row0 + (lane & 31)) * ld + k0 + 8 * (lane >> 5)); }
#define MFMA32(a, b, c) __builtin_amdgcn_mfma_f32_32x32x16_bf16((a), (b), (c), 0, 0, 0)

__device__ __forceinline__ void tr_item(const float* W, int ldw, int K, int k0, int c0, bf16* WT, int d0, const float* g, LAS float* scr, int lane) {
#pragma unroll 8
    for (int i = 0; i < 32; ++i) { const int kk = 2 * i + (lane >> 5); float v = W[(size_t)(k0 + kk) * ldw + c0 + (lane & 31)]; if (g) v *= g[k0 + kk]; scr[kk * 33 + (lane & 31)] = v; }
    LDS_WAIT(); asm volatile("" ::: "memory");
    const int c = lane & 7;
#pragma unroll
    for (int j = 0; j < 4; ++j) { const int n = (lane >> 3) + 8 * j; const LAS float* s = scr + (8 * c) * 33 + n;
        v4u o; o.x = pk2(s[0 * 33], s[1 * 33]); o.y = pk2(s[2 * 33], s[3 * 33]); o.z = pk2(s[4 * 33], s[5 * 33]); o.w = pk2(s[6 * 33], s[7 * 33]);
        *(GAS v4u*)(WT + (size_t)(d0 + n) * K + k0 + 8 * c) = o; }
    LDS_WAIT(); asm volatile("" ::: "memory");
}
__device__ __forceinline__ int sigma_in(int np) {
    const int pn = np >> 8, t = np & 255;
    if (pn < 4) { const int base = (pn >> 1) * 512 + (pn & 1) * 256, tt = t & 127; return base + (tt >> 6) * 128 + (t >> 7) * 64 + (tt & 63); }
    if (pn >= 8 && pn < 12) return pn * 256 + ((t >> 5) & 3) * 64 + (t >> 7) * 32 + (t & 31);
    return np;
}
struct Ptrs {
    const float *xp, *xs, *ck, *cv, *sr, *pp, *ps, *g_mix, *w_in, *g_ro, *g_q, *g_k, *rel_bias, *w_out, *g_ffn, *w_g, *w_u, *w_d, *g_ple, *w_pg, *w_pp;
    float* out; unsigned char* ws;
};
__device__ __forceinline__ void p0_prologue(Frame& F, const Ptrs& P) {
    LAS float* scr = (LAS float*)(F.lds + RING_OFF + F.wave * 16384);
    const int gw = F.vcu * NWAVES + F.wave, NGW = F.G * NWAVES;
    bf16* Wt_in = (bf16*)(P.ws + WS_WIN); bf16* Wt_out = (bf16*)(P.ws + WS_WOUT); bf16* Wt_gu = (bf16*)(P.ws + WS_WGU);
    bf16* Wt_dn = (bf16*)(P.ws + WS_WDN); bf16* Wt_pg = (bf16*)(P.ws + WS_WPG); bf16* Wt_pp = (bf16*)(P.ws + WS_WPP);
    constexpr int I_IN = 16 * (NIN / 32), I_OUT = 16 * 32, I_GU = 16 * (NGU / 32), I_DN = (FF / 64) * 32, I_PG = 16 * 32, I_PP = 4 * 32;
    constexpr int NITEMS = I_IN + I_OUT + I_GU + I_DN + I_PG + I_PP;
    for (int it = gw; it < NITEMS; it += NGW) {
        int r = it;
        if (r < I_IN) { const int nb = r % (NIN / 32), kb = r / (NIN / 32); tr_item(P.w_in, NIN, DM, 64 * kb, sigma_in(32 * nb), Wt_in, 32 * nb, P.g_mix, scr, F.lane); continue; } r -= I_IN;
        if (r < I_OUT) { const int nb = r % 32, kb = r / 32; tr_item(P.w_out, DM, DM, 64 * kb, 32 * nb, Wt_out, 32 * nb, nullptr, scr, F.lane); continue; } r -= I_OUT;
        if (r < I_GU) { const int nb = r % (NGU / 32), kb = r / (NGU / 32); const int np = 32 * nb, pn = np >> 8, t = np & 255;
            tr_item(t < 128 ? P.w_g : P.w_u, FF, DM, 64 * kb, 128 * pn + (t & 127), Wt_gu, np, P.g_ffn, scr, F.lane); continue; } r -= I_GU;
        if (r < I_DN) { const int nb = r % 32, kb = r / 32; tr_item(P.w_d, DM, FF, 64 * kb, 32 * nb, Wt_dn, 32 * nb, nullptr, scr, F.lane); continue; } r -= I_DN;
        if (r < I_PG) { const int nb = r % 32, kb = r / 32; tr_item(P.w_pg, DM, DM, 64 * kb, 32 * nb, Wt_pg, 32 * nb, P.g_ple, scr, F.lane); continue; } r -= I_PG;
        { const int nb = r % 32, kb = r / 32; tr_item(P.w_pp, DM, PLE, 64 * kb, 32 * nb, Wt_pp, 32 * nb, nullptr, scr, F.lane); }
    }
    bf16* xb = (bf16*)(P.ws + WS_A); float* rstdx = (float*)(P.ws + WS_RSTDX);
    for (int m = gw; m < M; m += NGW) {
        const float* xr = m < MP ? P.xp + (size_t)m * DM : P.xs + (size_t)(m - MP) * DM;
        const GAS f32x4* x4 = (const GAS f32x4*)xr + F.lane; f32x4 v[4]; float s = 0.f;
#pragma unroll
        for (int j = 0; j < 4; ++j) { v[j] = x4[64 * j]; s += sum4(v[j] * v[j]); }
        s = wave_sum(s);
        GAS unsigned long long* o8 = (GAS unsigned long long*)(xb + (size_t)m * DM) + F.lane;
#pragma unroll
        for (int j = 0; j < 4; ++j) o8[64 * j] = (unsigned long long)pk2(v[j].x, v[j].y) | ((unsigned long long)pk2(v[j].z, v[j].w) << 32);
        if (F.lane == 0) rstdx[m] = rsqrtf(s * (1.0f / DM) + EPS);
    }
    bf16* pb = (bf16*)(P.ws + WS_PB);
    for (int m = gw; m < M; m += NGW) {
        const float* pr = m < MP ? P.pp + (size_t)m * PLE : P.ps + (size_t)(m - MP) * PLE;
        const f32x4 v = ((const GAS f32x4*)pr)[F.lane];
        ((GAS unsigned long long*)(pb + (size_t)m * PLE))[F.lane] = (unsigned long long)pk2(v.x, v.y) | ((unsigned long long)pk2(v.z, v.w) << 32);
    }
    float* cosT = (float*)(P.ws + WS_COS); float* sinT = (float*)(P.ws + WS_SIN);
    for (int i = (F.vcu * NTHR + F.tid); i < MP * 64; i += F.G * NTHR) {
        const int pos = i >> 6, j = i & 63;
        const float inv = exp2f(-(float)j * (13.287712379549449f / 64.0f));
        const float ang = (float)pos * inv;
        const float k = rintf(ang * 0.15915494309189535f);
        float r = fmaf(-k, 6.28125f, ang); r = fmaf(-k, 1.9353071795864769e-3f, r);
        cosT[i] = __cosf(r); sinT[i] = __sinf(r);
    }
}

__device__ __forceinline__ void attn_item(Frame& F, const Ptrs& P, int ci, int hg) {
    const bf16* Z = (const bf16*)(P.ws + WS_Z); bf16* MIX = (bf16*)(P.ws + WS_A);
    const int tid = F.tid, lane = F.lane, wave = F.wave, un = wave >> 1, qb = wave & 1, h = 4 * hg + un, tu = tid & 127, hi = lane >> 5, l31 = lane & 31;
    constexpr int LD = 72;
    LAS bf16* Qs = (LAS bf16*)(F.lds + un * 27648); LAS bf16* Ks = Qs + 64 * LD; LAS bf16* VT = Ks + 64 * LD;
    LAS float* BT = (LAS float*)(F.lds + 110592);
    LAS float* SC = (LAS float*)(F.lds + 110592 + 8320) + wave * 32;
    const bool samp = ci >= NCP; const int row0 = samp ? MP + (ci - NCP) * 64 : ci * 64; const int sb = ci - NCP;
    for (int i = tid; i < 4 * 513; i += NTHR) { const int hh = i / 513, idx = i % 513; const float* rb = P.rel_bias + (size_t)(4 * hg + hh) * 513; BT[hh * 520 + idx] = (rb[idx] - rb[512]) * LOG2E; }
    { const int row = tu >> 1, c0 = (tu & 1) * 32; const v4u* src = (const v4u*)(Z + (size_t)(row0 + row) * NIN + ZQA + h * 64 + c0);
#pragma unroll
      for (int i = 0; i < 4; ++i) *(LAS v4u*)(Qs + row * LD + c0 + 8 * i) = src[i]; }
    f32x16 o0 = {}, o1 = {}; float m_run = -1e30f, l_run = 0.f;
    const int jlo = samp ? 0 : (ci >= 8 ? 0 : 8 - ci);
    const float SCL = 0.125f * LOG2E;
    for (int j = jlo; j < 9; ++j) {
        __syncthreads();
        { const int row = tu >> 1, c0 = (tu & 1) * 32;
          if (samp && j < 8) {
              const float* ks = P.ck + ((size_t)(sb * 512 + 64 * j + row) * 8 + h) * 64 + c0; const float* vs = P.cv + ((size_t)(sb * 512 + 64 * j + row) * 8 + h) * 64 + c0;
#pragma unroll
              for (int i = 0; i < 8; ++i) { const f32x4 a = *(const f32x4*)(ks + 4 * i); *(LAS u32x2v*)(Ks + row * LD + c0 + 4 * i) = (u32x2v){pk2(a.x, a.y), pk2(a.z, a.w)};
                  const f32x4 b = *(const f32x4*)(vs + 4 * i);
                  VT[(c0 + 4 * i + 0) * LD + row] = (bf16)f2bf(b.x); VT[(c0 + 4 * i + 1) * LD + row] = (bf16)f2bf(b.y); VT[(c0 + 4 * i + 2) * LD + row] = (bf16)f2bf(b.z); VT[(c0 + 4 * i + 3) * LD + row] = (bf16)f2bf(b.w); }
          } else {
              const int kr = samp ? row0 + row : (ci - 8 + j) * 64 + row;
              const v4u* ks = (const v4u*)(Z + (size_t)kr * NIN + ZKA + h * 64 + c0); const bf16* vs = Z + (size_t)kr * NIN + ZVA + h * 64 + c0;
#pragma unroll
              for (int i = 0; i < 4; ++i) *(LAS v4u*)(Ks + row * LD + c0 + 8 * i) = ks[i];
#pragma unroll
              for (int i = 0; i < 4; ++i) { const v4u w = *(const v4u*)(vs + 8 * i);
#pragma unroll
                  for (int q = 0; q < 4; ++q) { const unsigned x = w[q]; VT[(c0 + 8 * i + 2 * q) * LD + row] = (bf16)(x & 0xffffu); VT[(c0 + 8 * i + 2 * q + 1) * LD + row] = (bf16)(x >> 16); } }
          } }
        __syncthreads();
        f32x16 p[2];
#pragma unroll
        for (int lb = 0; lb < 2; ++lb) { f32x16 a = {};
#pragma unroll
            for (int s = 0; s < 4; ++s) a = MFMA32(frag(Ks, LD, 32 * lb, 16 * s, lane), frag(Qs, LD, 32 * qb, 16 * s, lane), a);
            p[lb] = a; }
        const int t = 32 * qb + l31; float mx = -1e30f;
#pragma unroll
        for (int lb = 0; lb < 2; ++lb)
#pragma unroll
            for (int r = 0; r < 16; ++r) { const int lw = 64 * j + 32 * lb + crow(r, hi); int idx = 768 + t - lw; idx = idx < 0 ? 0 : (idx > 512 ? 512 : idx);
                const float v = p[lb][r] * SCL + BT[un * 520 + idx]; p[lb][r] = v; mx = fmaxf(mx, v); }
        mx = fmaxf(mx, __shfl_xor(mx, 32));
        const float m_new = fmaxf(m_run, mx), alpha = exp2f(m_run - m_new); m_run = m_new; float ls = 0.f;
#pragma unroll
        for (int lb = 0; lb < 2; ++lb)
#pragma unroll
            for (int r = 0; r < 16; ++r) { const float e = exp2f(p[lb][r] - m_new); p[lb][r] = e; ls += e; }
        l_run = l_run * alpha + ls;
        if (hi == 0) SC[l31] = alpha;
        asm volatile("s_waitcnt lgkmcnt(0)" ::: "memory");
#pragma unroll
        for (int r = 0; r < 16; ++r) { const float f = SC[crow(r, hi)]; o0[r] *= f; o1[r] *= f; }
        asm volatile("s_waitcnt lgkmcnt(0)" ::: "memory");
#pragma unroll
        for (int lb = 0; lb < 2; ++lb)
#pragma unroll
            for (int s2 = 0; s2 < 2; ++s2) {
                s16x8 pa;
#pragma unroll
                for (int q = 0; q < 4; ++q) { const unsigned w = pk2(p[lb][8 * s2 + 2 * q], p[lb][8 * s2 + 2 * q + 1]); pa[2 * q] = (short)(w & 0xffffu); pa[2 * q + 1] = (short)(w >> 16); }
                const int kb = 32 * lb + 16 * s2 + 4 * hi;
#pragma unroll
                for (int eb = 0; eb < 2; ++eb) {
                    const LAS bf16* vr = VT + (32 * eb + l31) * LD + kb;
                    const s16x4 lo = *(const LAS s16x4*)vr, hh = *(const LAS s16x4*)(vr + 8);
                    const s16x8 vb = {lo[0], lo[1], lo[2], lo[3], hh[0], hh[1], hh[2], hh[3]};
                    if (eb == 0) o0 = MFMA32(pa, vb, o0); else o1 = MFMA32(pa, vb, o1);
                }
            }
    }
    l_run += __shfl_xor(l_run, 32);
    if (hi == 0) SC[l31] = 1.0f / l_run;
    asm volatile("s_waitcnt lgkmcnt(0)" ::: "memory");
#pragma unroll
    for (int r = 0; r < 16; ++r) { const int n = 32 * qb + crow(r, hi); const float f = SC[crow(r, hi)];
        bf16* dst = MIX + (size_t)(row0 + n) * DM + 512 + h * 64 + l31;
        dst[0] = (bf16)f2bf(o0[r] * f); dst[32] = (bf16)f2bf(o1[r] * f); }
    __syncthreads();
}

__device__ __forceinline__ void retU_item(Frame& F, const Ptrs& P, int ci, int h) {
    const bf16* Z = (const bf16*)(P.ws + WS_Z);
    const int tid = F.tid, lane = F.lane, wave = F.wave, hi = lane >> 5, l31 = lane & 31;
    constexpr int LD = 72;
    LAS bf16* vT = (LAS bf16*)(F.lds); LAS bf16* kT = vT + 128 * LD;
    const bool samp = ci >= NCP; const int row0 = samp ? MP + (ci - NCP) * 64 : ci * 64;
    const float lg2 = lg2_gamma(h);
    __syncthreads();
    { const int m = tid >> 3, c0 = (tid & 7) * 16; const float zeta = exp2f((float)(63 - m) * lg2);
      const bf16* vs = Z + (size_t)(row0 + m) * NIN + ZV + h * 128 + c0; const bf16* ks = Z + (size_t)(row0 + m) * NIN + ZK + h * 128 + c0;
#pragma unroll
      for (int i = 0; i < 16; ++i) { vT[(c0 + i) * LD + m] = vs[i]; kT[(c0 + i) * LD + m] = (bf16)f2bf(bf2f(ks[i]) * zeta); } }
    __syncthreads();
    const LAS bf16* X = samp ? kT : vT; const LAS bf16* Y = samp ? vT : kT;
    const int ib = wave >> 1, jb0 = 2 * (wave & 1);
    f32x16 a0 = {}, a1 = {};
#pragma unroll
    for (int s = 0; s < 4; ++s) { const s16x8 a = frag(X, LD, 32 * ib, 16 * s, lane);
        a0 = MFMA32(a, frag(Y, LD, 32 * jb0, 16 * s, lane), a0); a1 = MFMA32(a, frag(Y, LD, 32 * jb0 + 32, 16 * s, lane), a1); }
    if (!samp) {
        bf16* UR = (bf16*)(P.ws + WS_UR) + (size_t)(ci * 4 + h) * 16384;
#pragma unroll
        for (int r = 0; r < 16; ++r) { const int e = 32 * ib + crow(r, hi); UR[e * 128 + 32 * jb0 + l31] = (bf16)f2bf(a0[r]); UR[e * 128 + 32 * jb0 + 32 + l31] = (bf16)f2bf(a1[r]); }
    } else {
        const int b = ci - NCP; const float g64 = exp2f(64.0f * lg2);
        const float* R0 = P.sr + (size_t)(b * 4 + h) * 16384; float* RO = P.out + OFF_RS + (size_t)(b * 4 + h) * 16384;
#pragma unroll
        for (int r = 0; r < 16; ++r) { const int d = 32 * ib + crow(r, hi); const int e0 = 32 * jb0 + l31;
            RO[d * 128 + e0] = g64 * R0[d * 128 + e0] + a0[r]; RO[d * 128 + e0 + 32] = g64 * R0[d * 128 + e0 + 32] + a1[r]; }
    }
}
__device__ __forceinline__ void ret_scan(Frame& F, const Ptrs& P) {
    const int gid = F.vcu * NTHR + F.tid;
    if (gid >= 32768) return;
    unsigned* base = (unsigned*)(P.ws + WS_UR) + gid; const int h = gid >> 13;
    const float g64 = exp2f(64.0f * lg2_gamma(h)); float R0 = 0.f, R1 = 0.f;
#pragma unroll 8
    for (int c = 0; c < NCP; ++c) { const unsigned u = base[(size_t)c * 32768]; base[(size_t)c * 32768] = pk2(R0, R1);
        R0 = g64 * R0 + __uint_as_float(u << 16); R1 = g64 * R1 + __uint_as_float(u & 0xffff0000u); }
    const int el = (2 * gid) & 16383, e = el >> 7, d = el & 127;
    float* o = P.out + OFF_RP + (size_t)h * 16384; o[d * 128 + e] = R0; o[(d + 1) * 128 + e] = R1;
}
__device__ __forceinline__ void retO_item(Frame& F, const Ptrs& P, int ci, int h) {
    const bf16* Z = (const bf16*)(P.ws + WS_Z); bf16* MIX = (bf16*)(P.ws + WS_A);
    const int tid = F.tid, lane = F.lane, wave = F.wave, hi = lane >> 5, l31 = lane & 31;
    constexpr int LQ = 136, LV = 72;
    LAS bf16* q = (LAS bf16*)(F.lds); LAS bf16* k = q + 64 * LQ; LAS bf16* vT = k + 64 * LQ; LAS bf16* RT = vT + 128 * LV; LAS bf16* Sm = RT + 128 * LQ;
    LAS float* ssq = (LAS float*)(Sm + 64 * LV);
    const bool samp = ci >= NCP; const int row0 = samp ? MP + (ci - NCP) * 64 : ci * 64;
    const float lg2 = lg2_gamma(h);
    __syncthreads();
    { const int m = tid >> 3, c0 = (tid & 7) * 16;
      const bf16* qs = Z + (size_t)(row0 + m) * NIN + ZQ + h * 128 + c0; const bf16* ks = Z + (size_t)(row0 + m) * NIN + ZK + h * 128 + c0; const bf16* vs = Z + (size_t)(row0 + m) * NIN + ZV + h * 128 + c0;
      *(LAS v4u*)(q + m * LQ + c0) = *(const v4u*)qs; *(LAS v4u*)(q + m * LQ + c0 + 8) = *(const v4u*)(qs + 8);
      *(LAS v4u*)(k + m * LQ + c0) = *(const v4u*)ks; *(LAS v4u*)(k + m * LQ + c0 + 8) = *(const v4u*)(ks + 8);
#pragma unroll
      for (int i = 0; i < 16; ++i) vT[(c0 + i) * LV + m] = vs[i];
      if (!samp) { const bf16* rs = (const bf16*)(P.ws + WS_UR) + (size_t)(ci * 4 + h) * 16384; const int e = tid >> 2, d0 = (tid & 3) * 32;
#pragma unroll
          for (int i = 0; i < 4; ++i) *(LAS v4u*)(RT + e * LQ + d0 + 8 * i) = *(const v4u*)(rs + e * 128 + d0 + 8 * i);
      } else { const float* rs = P.sr + (size_t)((ci - NCP) * 4 + h) * 16384;
#pragma unroll
          for (int i = 0; i < 8; ++i) { const int idx = i * 512 + tid, d = idx >> 5, e0 = (idx & 31) * 4; const f32x4 v = *(const f32x4*)(rs + d * 128 + e0);
              RT[(e0 + 0) * LQ + d] = (bf16)f2bf(v.x); RT[(e0 + 1) * LQ + d] = (bf16)f2bf(v.y); RT[(e0 + 2) * LQ + d] = (bf16)f2bf(v.z); RT[(e0 + 3) * LQ + d] = (bf16)f2bf(v.w); } }
    }
    __syncthreads();
    if (wave < 4) { const int nb = wave >> 1, mb = wave & 1; f32x16 a = {};
#pragma unroll
        for (int s = 0; s < 8; ++s) a = MFMA32(frag(q, LQ, 32 * nb, 16 * s, lane), frag(k, LQ, 32 * mb, 16 * s, lane), a);
        const int mcol = 32 * mb + l31;
#pragma unroll
        for (int r = 0; r < 16; ++r) { const int n = 32 * nb + crow(r, hi); const float dv = n >= mcol ? a[r] * exp2f((float)(n - mcol) * lg2) : 0.f; Sm[n * LV + mcol] = (bf16)f2bf(dv); } }
    __syncthreads();
    const int nb = wave >> 2, eb = wave & 3; f32x16 ai = {}, ac = {};
#pragma unroll
    for (int s = 0; s < 4; ++s) ai = MFMA32(frag(Sm, LV, 32 * nb, 16 * s, lane), frag(vT, LV, 32 * eb, 16 * s, lane), ai);
#pragma unroll
    for (int s = 0; s < 8; ++s) ac = MFMA32(frag(q, LQ, 32 * nb, 16 * s, lane), frag(RT, LQ, 32 * eb, 16 * s, lane), ac);
    float o[16];
#pragma unroll
    for (int r = 0; r < 16; ++r) { const int n = 32 * nb + crow(r, hi); o[r] = ai[r] + exp2f((float)(n + 1) * lg2) * ac[r];
        float s = o[r] * o[r]; s += __shfl_xor(s, 1); s += __shfl_xor(s, 2); s += __shfl_xor(s, 4); s += __shfl_xor(s, 8); s += __shfl_xor(s, 16);
        if (l31 == 0) ssq[(nb * 4 + eb) * 32 + crow(r, hi)] = s; }
    __syncthreads();
    const int e = 32 * eb + l31; const float gro = P.g_ro[h * 128 + e];
#pragma unroll
    for (int r = 0; r < 16; ++r) { const int nl = crow(r, hi), n = 32 * nb + nl;
        const float tot = (ssq[(nb * 4 + 0) * 32 + nl] + ssq[(nb * 4 + 1) * 32 + nl]) + (ssq[(nb * 4 + 2) * 32 + nl] + ssq[(nb * 4 + 3) * 32 + nl]);
        const float inv = rsqrtf(tot * (1.0f / 128.0f) + EPS);
        const float g = bf2f(Z[(size_t)(row0 + n) * NIN + ZG + h * 128 + e]);
        const float sg = g / (1.0f + exp2f(-g * LOG2E));
        MIX[(size_t)(row0 + n) * DM + h * 128 + e] = (bf16)f2bf(sg * o[r] * inv * gro); }
}

struct Args { const float* in[21]; float* out; unsigned char* ws; int ph_lo, ph_hi; };
template <int PHM> __global__ void __launch_bounds__(NTHR, 2) skel_fwd(Args args) {
    extern __shared__ __attribute__((aligned(16))) unsigned char lds[];
    Frame F;
    F.lds = (LAS unsigned char*)lds; F.MISC = (volatile LAS unsigned*)(F.lds + MISC_OFF);
    F.tid = threadIdx.x; F.lane = F.tid & 63; F.wave = __builtin_amdgcn_readfirstlane(F.tid >> 6);
    F.G = gridDim.x; { const int bx = blockIdx.x; F.vcu = (F.G % 8 == 0) ? (bx % 8) * (F.G / 8) + bx / 8 : bx; }
    unsigned char* ws = args.ws; F.ctl = (gu32*)(ws + WS_CTL);
    Ptrs P; P.xp = args.in[0]; P.xs = args.in[1]; P.ck = args.in[2]; P.cv = args.in[3]; P.sr = args.in[4]; P.pp = args.in[5]; P.ps = args.in[6]; P.g_mix = args.in[7]; P.w_in = args.in[8];
    P.g_ro = args.in[9]; P.g_q = args.in[10]; P.g_k = args.in[11]; P.rel_bias = args.in[12]; P.w_out = args.in[13]; P.g_ffn = args.in[14]; P.w_g = args.in[15]; P.w_u = args.in[16];
    P.w_d = args.in[17]; P.g_ple = args.in[18]; P.w_pg = args.in[19]; P.w_pp = args.in[20]; P.out = args.out; P.ws = ws;
    for (int u = F.tid; u < (LDS_BYTES - LDSCTL_OFF) / 4; u += NTHR) ((LAS unsigned*)(F.lds + LDSCTL_OFF))[u] = 0u;
    __syncthreads();
    XcdBarrier bar; bar.bar = (unsigned*)(F.ctl + CW_BAR); bar.x = 0; bar.st = nullptr;
    if (MK_ONE_LAUNCH) bar = xcd_barrier_post((unsigned*)(F.ctl + CW_BAR), F.MISC + 8);
#define GRID_BAR() do { if (MK_ONE_LAUNCH) xcd_barrier(bar); } while (0)
    const int lo = args.ph_lo, hi = args.ph_hi;
#define IN(k) (((PHM >> (k)) & 1) && lo <= (k) && (k) < hi)
#define BOTH(k) (IN(k) && IN((k) + 1))
    bf16* XB = (bf16*)(ws + WS_A); bf16* ZB = (bf16*)(ws + WS_Z); bf16* HB = (bf16*)(ws + WS_HB); bf16* TB = (bf16*)(ws + WS_T); bf16* PPB = (bf16*)(ws + WS_A);
    float* ST1 = (float*)(ws + WS_ST1); float* ST2 = (float*)(ws + WS_ST2);

    if (IN(0)) { p0_prologue(F, P); if (BOTH(0)) GRID_BAR(); }
    if (IN(1)) {
        pg8::Gemm g{XB, (const bf16*)(ws + WS_WIN), M, NIN, DM}; pg8::StaticOrder S; S.init(M, NIN, F.G, (int)blockIdx.x);
        EpiIn E{ZB, (const float*)(ws + WS_RSTDX), (const float*)(ws + WS_COS), (const float*)(ws + WS_SIN), P.g_q, P.g_k, P.out};
        pg8::gemm_phase<EpiIn, pg8::StaticOrder, true, true>(F.lds + RING_OFF, g, S, E);
        if (BOTH(1)) GRID_BAR();
    }
    if (IN(2)) {
        for (int it = F.vcu; it < NCH * 2; it += F.G) attn_item(F, P, it >> 1, it & 1);
        for (int it = F.vcu; it < NCH * RH; it += F.G) retU_item(F, P, it >> 2, it & 3);
        if (BOTH(2)) GRID_BAR();
    }
    if (IN(3)) { ret_scan(F, P); if (BOTH(3)) GRID_BAR(); }
    if (IN(4)) {
        for (int it = F.vcu; it < NCH * RH; it += F.G) retO_item(F, P, it >> 2, it & 3);
        __syncthreads();
        if (BOTH(4)) GRID_BAR();
    }
    if (IN(5)) {
        pg8::Gemm g{(const bf16*)(ws + WS_A), (const bf16*)(ws + WS_WOUT), M, DM, DM}; pg8::StaticOrder S; S.init(M, DM, F.G, (int)blockIdx.x);
        EpiRes E{P.xp, P.xs, P.out, HB, ST1};
        pg8::gemm_phase<EpiRes, pg8::StaticOrder, true, true>(F.lds + RING_OFF, g, S, E);
        if (BOTH(5)) GRID_BAR();
    }
    if (IN(6)) {
        pg8::Gemm g{HB, (const bf16*)(ws + WS_WGU), M, NGU, DM}; pg8::StaticOrder S; S.init(M, NGU, F.G, (int)blockIdx.x);
        EpiGU E{ST1, TB};
        pg8::gemm_phase<EpiGU, pg8::StaticOrder, true, true>(F.lds + RING_OFF, g, S, E);
        if (BOTH(6)) GRID_BAR();
    }
    if (IN(7)) {
        pg8::Gemm g{TB, (const bf16*)(ws + WS_WDN), M, DM, FF}; pg8::StaticOrder S; S.init(M, DM, F.G, (int)blockIdx.x);
        EpiRes E{P.out, P.out + (size_t)MP * DM, P.out, HB, ST2};
        pg8::gemm_phase<EpiRes, pg8::StaticOrder, true, true>(F.lds + RING_OFF, g, S, E);
        if (BOTH(7)) GRID_BAR();
    }
    if (IN(8)) {
        pg8::Gemm g{(const bf16*)(ws + WS_PB), (const bf16*)(ws + WS_WPP), M, DM, PLE}; pg8::StaticOrder S; S.init(M, DM, F.G, (int)blockIdx.x);
        EpiPP E{PPB};
        pg8::gemm_phase<EpiPP, pg8::StaticOrder, true, true>(F.lds + RING_OFF, g, S, E);
        if (BOTH(8)) GRID_BAR();
    }
    if (IN(9)) {
        pg8::Gemm g{HB, (const bf16*)(ws + WS_WPG), M, DM, DM}; pg8::StaticOrder S; S.init(M, DM, F.G, (int)blockIdx.x);
        EpiPG E{ST2, PPB, P.out};
        pg8::gemm_phase<EpiPG, pg8::StaticOrder, true, true>(F.lds + RING_OFF, g, S, E);
    }
#undef IN
#undef BOTH
}

extern "C" void kernel_launch(void* const* d_in, const int* in_sizes, int n_in, void* d_out, int out_size, void* d_ws, size_t ws_size, hipStream_t stream) {
    static int grid = 0;
    if (grid == 0) {
        if (n_in != 21 || out_size != (int)OUT_TOTAL || ws_size < WS_END) { fprintf(stderr, "kernel_launch: unexpected shapes n_in %d out %d ws %zu\n", n_in, out_size, ws_size); grid = -1; return; }
#if MK_ONE_LAUNCH
        if (hipFuncSetAttribute((const void*)skel_fwd<0x3ff>, hipFuncAttributeMaxDynamicSharedMemorySize, LDS_BYTES) != hipSuccess) { fprintf(stderr, "kernel_launch: hipFuncSetAttribute failed\n"); grid = -1; return; }
#else
#define SETATTR(ph) (void)hipFuncSetAttribute((const void*)skel_fwd<(1 << (ph))>, hipFuncAttributeMaxDynamicSharedMemorySize, LDS_BYTES)
        SETATTR(0); SETATTR(1); SETATTR(2); SETATTR(3); SETATTR(4); SETATTR(5); SETATTR(6); SETATTR(7); SETATTR(8); SETATTR(9);
#endif
        int dev = 0, cus = 0;
        if (hipGetDevice(&dev) != hipSuccess || hipDeviceGetAttribute(&cus, hipDeviceAttributeMultiprocessorCount, dev) != hipSuccess) { grid = -1; return; }
        (void)hipGetLastError();
        grid = cus;
    }
    if (grid < 0) return;
    (void)hipMemsetAsync((char*)d_ws + WS_CTL, 0, CTL_ZERO_BYTES, stream);
    Args a{};
    for (int i = 0; i < 21; ++i) a.in[i] = (const float*)d_in[i];
    a.out = (float*)d_out; a.ws = (unsigned char*)d_ws;
#if MK_ONE_LAUNCH
    a.ph_lo = 0; a.ph_hi = NPH;
    hipLaunchKernelGGL(skel_fwd<0x3ff>, dim3(grid), dim3(NTHR), LDS_BYTES, stream, a);
#else
#define LAUNCH_PH(ph) do { a.ph_lo = (ph); a.ph_hi = (ph) + 1; hipLaunchKernelGGL(skel_fwd<(1 << (ph))>, dim3(grid), dim3(NTHR), LDS_BYTES, stream, a); } while (0)
    LAUNCH_PH(0); LAUNCH_PH(1); LAUNCH_PH(2); LAUNCH_PH(3); LAUNCH_PH(4); LAUNCH_PH(5); LAUNCH_PH(6); LAUNCH_PH(7); LAUNCH_PH(8); LAUNCH_PH(9);
#endif
}
```

```cpp
#include <hip/hip_runtime.h>
#include <cstdio>
#include <cstdint>
namespace pg8 {
#define PG8_LAS __attribute__((address_space(3)))
typedef unsigned short bf16_t;
typedef short bf16x8 __attribute__((ext_vector_type(8)));
typedef float f32x4 __attribute__((ext_vector_type(4)));
typedef unsigned u32x4 __attribute__((ext_vector_type(4)));
constexpr int BM = 256, BK = 64, HALF = 128, HTB = HALF * BK * 2  , STAGE_BYTES = 8 * HTB, NXCD = 8, WGM = 8;

__host__ __device__ __forceinline__ int lds_byte(int r, int c) { const int st = (r >> 4) * 2 + (c >> 5), rr = r & 15, cc = c & 31, ob = rr * 64 + cc * 2; return st * 1024 + (ob ^ (((ob >> 9) & 1) << 5)); }
__host__ __device__ __forceinline__ void stage_rc(int b, int& R, int& C) { const int st = b / 1024, sb = b % 1024, swz = sb ^ (((sb >> 9) & 1) << 5); R = (st >> 1) * 16 + swz / 64; C = (st & 1) * 32 + (swz % 64) / 2; }
__host__ __device__ __forceinline__ int perm32(int rho) { const int n = rho >> 4, i = rho & 15; return 8 * (i >> 2) + 4 * n + (i & 3); }

struct Unit { int pm, pn; };
struct Gemm { const bf16_t* A; const bf16_t* Bt; int M, N, K; };

struct StaticOrder {
    int nM, nN, nwg, G, c;
    __host__ __device__ void init(int M, int N, int G_, int c_) { nM = M / BM; nN = N / BM; nwg = nM * nN; G = G_; c = c_; }
    __host__ __device__ bool next(int i, Unit& u) const {
        const long L = (long)i * G + c; if (L >= nwg) return false;
        int wgid = (int)L; { const int q = nwg / NXCD, r = nwg % NXCD, xcd = wgid % NXCD, off = wgid / NXCD; wgid = (xcd < r ? xcd * (q + 1) : r * (q + 1) + (xcd - r) * q) + off; }
        const int nig = WGM * nN, gid = wgid / nig, fm = gid * WGM, gsz = (nM - fm) < WGM ? (nM - fm) : WGM;
        u.pm = fm + ((wgid % nig) % gsz); u.pn = (wgid % nig) / gsz; return true;
    }
    __device__ __forceinline__ void a_ready(const Unit&) const {}
    __device__ __forceinline__ void done(const Unit&) const {}
};

__device__ __forceinline__ unsigned cvt_pk_bf16(float lo, float hi) { unsigned r; asm volatile("v_cvt_pk_bf16_f32 %0, %1, %2" : "=v"(r) : "v"(lo), "v"(hi)); return r; }
typedef float f32x2 __attribute__((ext_vector_type(2)));
template <class Epi, class Sched, bool ALIGN_EPI = false, bool SP2 = false>
__device__ __forceinline__ void gemm_phase(PG8_LAS unsigned char* lds, const Gemm g, const Sched& S, const Epi& E) {
    int tid_ = threadIdx.x; asm volatile("" : "+v"(tid_));
    const int tid = tid_, wid = __builtin_amdgcn_readfirstlane(tid >> 6), lane = tid & 63, wr = wid >> 2, wc = wid & 3, fr = lane & 15, fq = lane >> 4;
    const int K = g.K, nt = K / BK;
    unsigned voffA[2], voffB[2];
#pragma unroll
    for (int i = 0; i < 2; ++i) { int R, C; stage_rc(tid * 16 + i * 8192, R, C); const int Rb = Epi::PERM ? ((R & ~31) + perm32(R & 31)) : R;
        voffA[i] = (unsigned)(R * K + C) * 2u; voffB[i] = (unsigned)(Rb * K + C) * 2u; }
    const size_t kstep = (size_t)(BK * 2);
    const size_t hstep = (size_t)HALF * K * 2;
    const size_t tstep = 2 * hstep;
    const unsigned ldsw = (unsigned)wid * 1024u;
    const int aoff = lds_byte(wr * 64 + fr, fq * 8), boff = lds_byte(wc * 32 + fr, fq * 8);
#define PG8_SA(b, h) (((b) * 2 + (h)) * HTB)
#define PG8_SB(b, h) ((4 + (b) * 2 + (h)) * HTB)
#define PG8_STAGE(bufoff, gbase, voff) do { _Pragma("unroll") for (int _i = 0; _i < 2; ++_i) \
        __builtin_amdgcn_global_load_lds((const unsigned*)((const char*)(gbase) + (voff)[_i]), (PG8_LAS unsigned*)(lds + (bufoff) + ldsw + _i * 8192), 16, 0, 0); } while (0)
#define PG8_LDA(dst, b, h) do { _Pragma("unroll") for (int m = 0; m < 4; ++m) _Pragma("unroll") for (int k = 0; k < 2; ++k) dst[m][k] = *(const PG8_LAS bf16x8*)(lds + PG8_SA(b, h) + aoff + m * 2048 + k * 1024); } while (0)
#define PG8_LDB(dst, b, h) do { _Pragma("unroll") for (int n = 0; n < 2; ++n) _Pragma("unroll") for (int k = 0; k < 2; ++k) dst[n][k] = *(const PG8_LAS bf16x8*)(lds + PG8_SB(b, h) + boff + n * 2048 + k * 1024); } while (0)
#define PG8_MMA(ai, bj, At, Bt) do { __builtin_amdgcn_s_setprio(1); _Pragma("unroll") for (int m = 0; m < 4; ++m) _Pragma("unroll") for (int n = 0; n < 2; ++n) _Pragma("unroll") for (int k = 0; k < 2; ++k) \
        acc[ai][bj][m][n] = __builtin_amdgcn_mfma_f32_16x16x32_bf16(Bt[n][k], At[m][k], acc[ai][bj][m][n], 0, 0, 0); __builtin_amdgcn_s_setprio(0); } while (0)
#define PG8_WAIT_V(n) asm volatile("s_waitcnt vmcnt(" #n ")" ::: "memory")
#define PG8_WAIT_L(n) asm volatile("s_waitcnt lgkmcnt(" #n ")" ::: "memory")
#define PG8_BAR __builtin_amdgcn_s_barrier()
#define PG8_SCHED __builtin_amdgcn_sched_barrier(0)
    Unit cur, nxt; int ui = 0;
    if (!S.next(0, cur)) return;
    f32x4 acc[2][2][4][2];
#pragma unroll
    for (int a = 0; a < 2; ++a)
#pragma unroll
        for (int b = 0; b < 2; ++b)
#pragma unroll
            for (int m = 0; m < 4; ++m)
#pragma unroll
                for (int n = 0; n < 2; ++n) acc[a][b][m][n] = (f32x4){0.f, 0.f, 0.f, 0.f};
    bf16x8 At[4][2], B0[2][2], B1[2][2];
    const char* cA = (const char*)g.A + (size_t)cur.pm * tstep; const char* cB = (const char*)g.Bt + (size_t)cur.pn * tstep;
    S.a_ready(cur);
    if constexpr (SP2) {
        PG8_STAGE(PG8_SB(0, 0), cB, voffB); PG8_STAGE(PG8_SB(0, 1), cB + hstep, voffB); PG8_STAGE(PG8_SA(0, 0), cA, voffA); PG8_STAGE(PG8_SA(0, 1), cA + hstep, voffA);
        if (wr == 1) PG8_BAR;
        PG8_WAIT_V(2); PG8_BAR;
        PG8_STAGE(PG8_SB(1, 0), cB + kstep, voffB); PG8_STAGE(PG8_SA(1, 0), cA + kstep, voffA); PG8_STAGE(PG8_SB(1, 1), cB + hstep + kstep, voffB);
        PG8_WAIT_V(6); PG8_BAR;
    } else {
        PG8_STAGE(PG8_SB(0, 0), cB, voffB); PG8_STAGE(PG8_SA(0, 0), cA, voffA); PG8_STAGE(PG8_SB(0, 1), cB + hstep, voffB); PG8_STAGE(PG8_SA(0, 1), cA + hstep, voffA);
        if (wr == 1) PG8_BAR;
        PG8_WAIT_V(4); PG8_BAR;
        PG8_STAGE(PG8_SB(1, 0), cB + kstep, voffB); PG8_STAGE(PG8_SA(1, 0), cA + kstep, voffA); PG8_STAGE(PG8_SB(1, 1), cB + hstep + kstep, voffB);
        PG8_WAIT_V(6); PG8_BAR;
    }
    for (;;) {
        const bool has_next = S.next(ui + 1, nxt);
        const char* nA = has_next ? (const char*)g.A + (size_t)nxt.pm * tstep : cA; const char* nB = has_next ? (const char*)g.Bt + (size_t)nxt.pn * tstep : cB;
        for (int t = 0; t < nt; t += 2) {
            const bool last = (t == nt - 2);
            const char* a1 = cA + (size_t)(t + 1) * kstep;
            const char* a2 = last ? nA : cA + (size_t)(t + 2) * kstep; const char* b2 = last ? nB : cB + (size_t)(t + 2) * kstep;
            const char* a3 = a2 + kstep; const char* b3 = b2 + kstep;
            if (last && has_next) S.a_ready(nxt);
            if constexpr (SP2) {
            PG8_LDB(B0, 0, 0); PG8_LDB(B1, 0, 1); PG8_SCHED; PG8_LDA(At, 0, 0); PG8_STAGE(PG8_SA(1, 1), a1 + hstep, voffA);
            PG8_WAIT_V(8); PG8_WAIT_L(0); PG8_BAR; PG8_MMA(0, 0, At, B0); PG8_MMA(0, 1, At, B1); PG8_BAR; PG8_SCHED;
            PG8_LDA(At, 0, 1); PG8_STAGE(PG8_SB(0, 0), b2, voffB); PG8_STAGE(PG8_SB(0, 1), b2 + hstep, voffB); PG8_STAGE(PG8_SA(0, 0), a2, voffA);
            PG8_WAIT_V(8); PG8_WAIT_L(0); PG8_BAR; PG8_MMA(1, 0, At, B0); PG8_MMA(1, 1, At, B1); PG8_BAR; PG8_SCHED;
            PG8_LDB(B0, 1, 0); PG8_LDB(B1, 1, 1); PG8_SCHED; PG8_LDA(At, 1, 0); PG8_STAGE(PG8_SA(0, 1), a2 + hstep, voffA);
            PG8_WAIT_V(8); PG8_WAIT_L(0); PG8_BAR; PG8_MMA(0, 0, At, B0); PG8_MMA(0, 1, At, B1); PG8_BAR; PG8_SCHED;
            PG8_LDA(At, 1, 1); PG8_STAGE(PG8_SB(1, 0), b3, voffB); PG8_STAGE(PG8_SB(1, 1), b3 + hstep, voffB); PG8_STAGE(PG8_SA(1, 0), a3, voffA);
            PG8_WAIT_V(8); PG8_WAIT_L(0); PG8_BAR; PG8_MMA(1, 0, At, B0); PG8_MMA(1, 1, At, B1); PG8_BAR; PG8_SCHED;
            } else {
            PG8_LDB(B0, 0, 0); PG8_SCHED; PG8_LDA(At, 0, 0); PG8_STAGE(PG8_SA(1, 1), a1 + hstep, voffA);
            PG8_WAIT_L(8); PG8_BAR; PG8_WAIT_L(0); PG8_MMA(0, 0, At, B0); PG8_BAR; PG8_SCHED;
            PG8_LDB(B1, 0, 1); PG8_STAGE(PG8_SB(0, 0), b2, voffB);
            PG8_BAR; PG8_WAIT_L(0); PG8_MMA(0, 1, At, B1); PG8_BAR;
            PG8_LDA(At, 0, 1); PG8_STAGE(PG8_SA(0, 0), a2, voffA);
            PG8_BAR; PG8_WAIT_L(0); PG8_MMA(1, 0, At, B0); PG8_BAR; PG8_SCHED;
            PG8_STAGE(PG8_SB(0, 1), b2 + hstep, voffB);
            PG8_WAIT_V(6); PG8_BAR; PG8_MMA(1, 1, At, B1); PG8_BAR;
            PG8_LDB(B0, 1, 0); PG8_SCHED; PG8_LDA(At, 1, 0); PG8_STAGE(PG8_SA(0, 1), a2 + hstep, voffA);
            PG8_WAIT_L(8); PG8_BAR; PG8_WAIT_L(0); PG8_MMA(0, 0, At, B0); PG8_BAR; PG8_SCHED;
            PG8_LDB(B1, 1, 1); PG8_STAGE(PG8_SB(1, 0), b3, voffB);
            PG8_BAR; PG8_WAIT_L(0); PG8_MMA(0, 1, At, B1); PG8_BAR;
            PG8_LDA(At, 1, 1); PG8_STAGE(PG8_SA(1, 0), a3, voffA);
            PG8_BAR; PG8_WAIT_L(0); PG8_MMA(1, 0, At, B0); PG8_BAR; PG8_SCHED;
            PG8_STAGE(PG8_SB(1, 1), b3 + hstep, voffB);
            PG8_WAIT_V(6); PG8_BAR; PG8_MMA(1, 1, At, B1); PG8_BAR;
            }
        }
        if constexpr (ALIGN_EPI) { if (wr == 0) PG8_BAR; }
        if constexpr (!Epi::AFTER_DRAIN) { E(acc, cur, wr, wc, fr, fq); S.done(cur); }
        if (!has_next) break;
#pragma unroll
        for (int a = 0; a < 2; ++a)
#pragma unroll
            for (int b = 0; b < 2; ++b)
#pragma unroll
                for (int m = 0; m < 4; ++m)
#pragma unroll
                    for (int n = 0; n < 2; ++n) acc[a][b][m][n] = (f32x4){0.f, 0.f, 0.f, 0.f};
        cur = nxt; cA = nA; cB = nB; ++ui;
        if constexpr (ALIGN_EPI) { if (wr == 1) PG8_BAR; }
    }
    PG8_WAIT_V(0);
    if constexpr (!ALIGN_EPI) { if (wr == 0) PG8_BAR; }
    PG8_BAR;
    if constexpr (Epi::AFTER_DRAIN) { E.fused(acc, cur, wr, wc, fr, fq, lds, wid, lane); S.done(cur); }
#undef PG8_SA
#undef PG8_SB
#undef PG8_STAGE
#undef PG8_LDA
#undef PG8_LDB
#undef PG8_MMA
#undef PG8_WAIT_V
#undef PG8_WAIT_L
#undef PG8_BAR
#undef PG8_SCHED
}
}
#define GAS __attribute__((address_space(1)))
#define LAS __attribute__((address_space(3)))
typedef unsigned short bf16;
typedef unsigned v4u __attribute__((ext_vector_type(4)));
typedef float f32x4 __attribute__((ext_vector_type(4)));
typedef short bf16x8 __attribute__((ext_vector_type(8)));
typedef GAS unsigned gu32;
typedef GAS unsigned long long gu64;
#define RLX_AGENT __ATOMIC_RELAXED, __HIP_MEMORY_SCOPE_AGENT
#define LDS_WAIT() asm volatile("s_waitcnt lgkmcnt(0)" ::: "memory")
#define VM_WAIT() asm volatile("s_waitcnt vmcnt(0)" ::: "memory")
__device__ __forceinline__ unsigned long long rt() { return __builtin_amdgcn_s_memrealtime(); }
__device__ __forceinline__ unsigned f2bf(float f) { unsigned u = __builtin_bit_cast(unsigned, f); return (u + 0x7fffu + ((u >> 16) & 1u)) >> 16; }
__device__ __forceinline__ unsigned pk2(float lo, float hi) { return f2bf(lo) | (f2bf(hi) << 16); }

#define XB_TMO      128
#define XB_XCNT(j)  (256  + 64 * (j))
#define XB_XSUB(j)  (1280 + 64 * (j))
#define XB_XGEN(j)  (2304 + 64 * (j))
#define XB_TOP      3328
#define XB_TOPGEN   3392
#define XCD_BAR_WORDS 3456
#define XB_SPIN_CAP (1u << 18)

__device__ __forceinline__ unsigned xb_ld(unsigned* p)              { return __hip_atomic_load(p, __ATOMIC_RELAXED, __HIP_MEMORY_SCOPE_AGENT); }
__device__ __forceinline__ unsigned xb_add(unsigned* p, unsigned v) { return __hip_atomic_fetch_add(p, v, __ATOMIC_RELAXED, __HIP_MEMORY_SCOPE_AGENT); }
__device__ __forceinline__ unsigned xb_xcc_id() { return (unsigned)__builtin_amdgcn_s_getreg((3 << 11) | 20) & 0xFu; }
#define XB_SPIN(cond, bar) do { unsigned _sp = 0; while (cond) { __builtin_amdgcn_s_sleep(1); \
    if ((++_sp & 255u) == 0u) { if (xb_ld(&(bar)[XB_TMO])) break; if (_sp > XB_SPIN_CAP) { atomicAdd(&(bar)[XB_TMO], 1u); break; } } } } while (0)

struct XcdBarrier {
    unsigned* bar; unsigned x;
    volatile LAS unsigned* st;
};

__device__ __forceinline__ XcdBarrier xcd_barrier_post(unsigned* bar, volatile LAS unsigned* st) {
    XcdBarrier b; b.bar = bar; b.x = xb_xcc_id(); b.st = st;
    if (threadIdx.x == 0) (void)xb_add(&bar[XB_XCNT(b.x)], 1u);
    return b;
}
__device__ __forceinline__ void xcd_barrier_complete(unsigned* bar, unsigned x, unsigned& nloc, unsigned& nx) {
    const unsigned G = gridDim.x * gridDim.y * gridDim.z;
    unsigned sum, cnt, mine, sp = 0u;
    for (;;) {
        sum = 0u; cnt = 0u; mine = 0u;
#pragma unroll
        for (unsigned j = 0; j < 16; ++j) { const unsigned c = xb_ld(&bar[XB_XCNT(j)]); sum += c; cnt += (c > 0u) ? 1u : 0u; mine = (j == x) ? c : mine; }
        if (sum == G) break;
        __builtin_amdgcn_s_sleep(1);
        if ((++sp & 255u) == 0u) { if (xb_ld(&bar[XB_TMO])) break; if (sp > XB_SPIN_CAP) { atomicAdd(&bar[XB_TMO], 1u); break; } }
    }
    nloc = mine > 0u ? mine : 1u; nx = cnt > 0u ? cnt : 1u;
}

__device__ __forceinline__ void xcd_barrier(const XcdBarrier& b) {
    asm volatile("s_waitcnt vmcnt(0)" ::: "memory");
    __syncthreads();
    if (threadIdx.x == 0) {
        unsigned* bar = b.bar;
        __builtin_amdgcn_s_waitcnt(0);
        unsigned nloc = b.st[0], nx = b.st[1];
        if (nloc == 0u) { xcd_barrier_complete(bar, b.x, nloc, nx); b.st[0] = nloc; b.st[1] = nx; }
        const unsigned old = xb_add(&bar[XB_XSUB(b.x)], 1u);
        const unsigned gen = old / nloc;
        if (old + 1u == (gen + 1u) * nloc) {
            __builtin_amdgcn_fence(__ATOMIC_RELEASE, "agent");
            asm volatile("s_waitcnt vmcnt(0)" ::: "memory");
            const unsigned og = xb_add(&bar[XB_TOP], 1u);
            const unsigned tg = og / nx;
            if (og + 1u == (tg + 1u) * nx) xb_add(&bar[XB_TOPGEN], 1u);
            else XB_SPIN(xb_ld(&bar[XB_TOPGEN]) == tg, bar);
            __builtin_amdgcn_fence(__ATOMIC_ACQUIRE, "agent");
            xb_add(&bar[XB_XGEN(b.x)], 1u);
            asm volatile("s_waitcnt vmcnt(0)" ::: "memory");
        } else {
            XB_SPIN(xb_ld(&bar[XB_XGEN(b.x)]) == gen, bar);
            __builtin_amdgcn_fence(__ATOMIC_ACQUIRE, "agent");
            asm volatile("s_waitcnt vmcnt(0)" ::: "memory");
        }
    }
    __syncthreads();
}

constexpr int DM = 1024, MP = 16384, MS = 2048, M = MP + MS;
constexpr int NIN = 3584, FF = 2816, NGU = 2 * FF, PLE = 256, PAST = 2048;
constexpr int NCP = 256, NCS = 32, NCH = NCP + NCS;
constexpr int RH = 4, RD = 128, AH = 8, AD = 64;
constexpr float EPS = 1e-6f, LOG2E = 1.4426950408889634f;
constexpr int ZQ = 0, ZK = 512, ZV = 1024, ZG = 1536, ZQA = 2048, ZKA = 2560, ZVA = 3072;
constexpr size_t OFF_Y = 0, OFF_RP = (size_t)M * DM, OFF_KP = OFF_RP + 65536, OFF_VP = OFF_KP + 262144, OFF_RS = OFF_VP + 262144,
                 OFF_KS = OFF_RS + 2097152, OFF_VS = OFF_KS + 1048576, OUT_TOTAL = OFF_VS + 1048576;
static_assert(OUT_TOTAL == 23658496, "output size");

constexpr size_t MiB = 1u << 20;
constexpr size_t WS_CTL = 0, CTL_ZERO_BYTES = 1 * MiB;
constexpr size_t WS_RSTDX = 1 * MiB, WS_ST1 = 2 * MiB, WS_ST2 = 4 * MiB;
constexpr size_t WS_WIN = 6 * MiB, WS_WOUT = 13 * MiB, WS_WGU = 15 * MiB, WS_WDN = 26 * MiB, WS_WPG = 32 * MiB, WS_WPP = 34 * MiB;
constexpr size_t WS_COS = 35 * MiB, WS_SIN = 39 * MiB, WS_PB = 43 * MiB;
constexpr size_t WS_A = 52 * MiB;
constexpr size_t WS_Z = 88 * MiB;
constexpr size_t WS_UF = 214 * MiB;
constexpr size_t WS_RB = 230 * MiB;
constexpr size_t WS_HB = 88 * MiB;
constexpr size_t WS_T = 124 * MiB;
constexpr size_t WS_END = 246 * MiB;
static_assert(WS_T + (size_t)M * FF * 2 <= WS_END && WS_Z + (size_t)M * NIN * 2 <= WS_UF && WS_HB + (size_t)M * DM * 2 <= WS_T, "ws map");

constexpr int CW_TMO = 0, CW_CODE = 1, CW_BAR = 4096;

using pg8::u32x4; using pg8::bf16_t; using pg8::Unit;
__device__ __forceinline__ u32x4 pack8(f32x4 a, f32x4 b) { u32x4 w; w.x = pg8::cvt_pk_bf16(a[0], a[1]); w.y = pg8::cvt_pk_bf16(a[2], a[3]); w.z = pg8::cvt_pk_bf16(b[0], b[1]); w.w = pg8::cvt_pk_bf16(b[2], b[3]); return w; }
__device__ __forceinline__ float lg2_gamma(int h) { return log2f(1.0f - exp2f(-5.0f - (float)h)); }
__device__ __forceinline__ float bf2f(unsigned short b) { return __uint_as_float((unsigned)b << 16); }
__device__ __forceinline__ float sum4(f32x4 a) { return (a[0] + a[1]) + (a[2] + a[3]); }
__device__ __forceinline__ float rstd16(const float* st, int r) {
    const f32x4* p = (const f32x4*)(st + (size_t)r * 16); const f32x4 a = p[0], b = p[1], c = p[2], d = p[3];
    return rsqrtf(((sum4(a) + sum4(b)) + (sum4(c) + sum4(d))) * (1.0f / DM) + EPS);
}
__device__ __forceinline__ f32x4 sigmoid4(f32x4 g) { f32x4 o;
#pragma unroll
    for (int i = 0; i < 4; ++i) o[i] = __builtin_amdgcn_rcpf(1.0f + __builtin_amdgcn_exp2f(-g[i] * LOG2E));
    return o; }

struct EpiIn {
    static constexpr bool PERM = true, AFTER_DRAIN = false;
    bf16_t* Z; const float* rstd; const float* cosT; const float* sinT; const float* gq; const float* gk; float* dout;
    __device__ __forceinline__ void operator()(const f32x4 (&acc)[2][2][4][2], const Unit& u, int wr, int wc, int fr, int fq) const {
        const int pn = u.pn; const int rbase = u.pm * 256 + wr * 64 + fr;
        if (pn < 4) {
            const int sec = (pn >> 1) * 512, head = 2 * (pn & 1) + (wc >> 1), j0 = (wc & 1) * 32 + fq * 8;
            const float osc = (pn >= 2) ? 0.08838834764831845f : 1.0f; const float lgs = (pn >= 2) ? -lg2_gamma(head) : lg2_gamma(head);
#pragma unroll
            for (int ai = 0; ai < 2; ++ai)
#pragma unroll
                for (int m = 0; m < 4; ++m) {
                    const int r = rbase + ai * 128 + m * 16; const int pos = r < MP ? r : PAST + ((r - MP) & 63); const int nloc = r < MP ? (r & 255) : ((r - MP) & 63);
                    const float rs = rstd[r] * osc * exp2f((float)nloc * lgs);
                    const f32x4 c0 = *(const f32x4*)(cosT + (size_t)pos * 64 + j0), c1 = *(const f32x4*)(cosT + (size_t)pos * 64 + j0 + 4);
                    const f32x4 s0 = *(const f32x4*)(sinT + (size_t)pos * 64 + j0), s1 = *(const f32x4*)(sinT + (size_t)pos * 64 + j0 + 4);
                    const f32x4 x1a = acc[ai][0][m][0] * rs, x1b = acc[ai][0][m][1] * rs, x2a = acc[ai][1][m][0] * rs, x2b = acc[ai][1][m][1] * rs;
                    const f32x4 o1a = x1a * c0 - x2a * s0, o1b = x1b * c1 - x2b * s1, o2a = x1a * s0 + x2a * c0, o2b = x1b * s1 + x2b * c1;
                    bf16_t* dst = Z + (size_t)r * NIN + sec + head * 128 + j0;
                    *(u32x4*)dst = pack8(o1a, o1b); *(u32x4*)(dst + 64) = pack8(o2a, o2b);
                }
        } else if (pn < 8 || pn >= 12) {
#pragma unroll
            for (int ai = 0; ai < 2; ++ai)
#pragma unroll
                for (int m = 0; m < 4; ++m) {
                    const int r = rbase + ai * 128 + m * 16; const float rs = rstd[r];
#pragma unroll
                    for (int bj = 0; bj < 2; ++bj) {
                        const f32x4 v0 = acc[ai][bj][m][0] * rs, v1 = acc[ai][bj][m][1] * rs; const int t = bj * 128 + wc * 32 + fq * 8;
                        *(u32x4*)(Z + (size_t)r * NIN + pn * 256 + t) = pack8(v0, v1);
                        if (pn >= 12) { const int c5 = (pn - 12) * 256 + t;
                            if (r >= MP) { float* o = dout + OFF_VS + (size_t)(r - MP) * 512 + c5; *(f32x4*)o = v0; *(f32x4*)(o + 4) = v1; }
                            else if (r >= MP - 512) { float* o = dout + OFF_VP + (size_t)(r - (MP - 512)) * 512 + c5; *(f32x4*)o = v0; *(f32x4*)(o + 4) = v1; } }
                    }
                }
        } else {
            const float* g = pn < 10 ? gq : gk; f32x4 gv[2][2];
#pragma unroll
            for (int bj = 0; bj < 2; ++bj)
#pragma unroll
                for (int n = 0; n < 2; ++n) gv[bj][n] = *(const f32x4*)(g + bj * 32 + fq * 8 + 4 * n);
#pragma unroll
            for (int ai = 0; ai < 2; ++ai)
#pragma unroll
                for (int m = 0; m < 4; ++m) {
                    const int r = rbase + ai * 128 + m * 16; const float rs = rstd[r]; f32x4 v[2][2]; float ss = 0.f;
#pragma unroll
                    for (int bj = 0; bj < 2; ++bj)
#pragma unroll
                        for (int n = 0; n < 2; ++n) { v[bj][n] = acc[ai][bj][m][n] * rs; ss += sum4(v[bj][n] * v[bj][n]); }
                    ss += __shfl_xor(ss, 16); ss += __shfl_xor(ss, 32);
                    const float inv = rsqrtf(ss * (1.0f / 64.0f) + EPS) * (pn < 10 ? 0.125f * LOG2E : 1.0f);
#pragma unroll
                    for (int bj = 0; bj < 2; ++bj) {
                        const f32x4 o0 = v[bj][0] * inv * gv[bj][0], o1 = v[bj][1] * inv * gv[bj][1]; const int e = wc * 64 + bj * 32 + fq * 8;
                        *(u32x4*)(Z + (size_t)r * NIN + pn * 256 + e) = pack8(o0, o1);
                        if (pn >= 10) { const int c5 = (pn - 10) * 256 + e;
                            if (r >= MP) { float* o = dout + OFF_KS + (size_t)(r - MP) * 512 + c5; *(f32x4*)o = o0; *(f32x4*)(o + 4) = o1; }
                            else if (r >= MP - 512) { float* o = dout + OFF_KP + (size_t)(r - (MP - 512)) * 512 + c5; *(f32x4*)o = o0; *(f32x4*)(o + 4) = o1; } }
                    }
                }
        }
    }
};
struct EpiRes {
    static constexpr bool PERM = true, AFTER_DRAIN = false;
    const float* res_p; const float* res_s; float* out; bf16_t* hb; float* stats;
    __device__ __forceinline__ void operator()(const f32x4 (&acc)[2][2][4][2], const Unit& u, int wr, int wc, int fr, int fq) const {
        const int rbase = u.pm * 256 + wr * 64 + fr;
#pragma unroll
        for (int ai = 0; ai < 2; ++ai)
#pragma unroll
            for (int m = 0; m < 4; ++m) {
                const int r = rbase + ai * 128 + m * 16; const float* rp = r < MP ? res_p + (size_t)r * DM : res_s + (size_t)(r - MP) * DM; float ss = 0.f;
#pragma unroll
                for (int bj = 0; bj < 2; ++bj) {
                    const int c0 = u.pn * 256 + bj * 128 + wc * 32 + fq * 8;
                    const f32x4 h0 = *(const f32x4*)(rp + c0) + acc[ai][bj][m][0], h1 = *(const f32x4*)(rp + c0 + 4) + acc[ai][bj][m][1];
                    float* o = out + (size_t)r * DM + c0; *(f32x4*)o = h0; *(f32x4*)(o + 4) = h1;
                    *(u32x4*)(hb + (size_t)r * DM + c0) = pack8(h0, h1);
                    ss += sum4(h0 * h0) + sum4(h1 * h1);
                }
                ss += __shfl_xor(ss, 16); ss += __shfl_xor(ss, 32);
                if (fq == 0) stats[(size_t)r * 16 + u.pn * 4 + wc] = ss;
            }
    }
};
struct EpiGU {
    static constexpr bool PERM = true, AFTER_DRAIN = false;
    const float* stats; bf16_t* T;
    __device__ __forceinline__ void operator()(const f32x4 (&acc)[2][2][4][2], const Unit& u, int wr, int wc, int fr, int fq) const {
        const int rbase = u.pm * 256 + wr * 64 + fr;
#pragma unroll
        for (int ai = 0; ai < 2; ++ai)
#pragma unroll
            for (int m = 0; m < 4; ++m) {
                const int r = rbase + ai * 128 + m * 16; const float rs = rstd16(stats, r);
                const f32x4 g0 = acc[ai][0][m][0] * rs, g1 = acc[ai][0][m][1] * rs, u0 = acc[ai][1][m][0] * rs, u1 = acc[ai][1][m][1] * rs;
                const f32x4 t0 = g0 * sigmoid4(g0) * u0, t1 = g1 * sigmoid4(g1) * u1;
                *(u32x4*)(T + (size_t)r * FF + u.pn * 128 + wc * 32 + fq * 8) = pack8(t0, t1);
            }
    }
};
struct EpiPP {
    static constexpr bool PERM = true, AFTER_DRAIN = false;
    bf16_t* O;
    __device__ __forceinline__ void operator()(const f32x4 (&acc)[2][2][4][2], const Unit& u, int wr, int wc, int fr, int fq) const {
        const unsigned boff = (unsigned)((u.pm * 256 + wr * 64 + fr) * DM + u.pn * 256 + wc * 32 + fq * 8) * 2u;
#pragma unroll
        for (int ai = 0; ai < 2; ++ai)
#pragma unroll
            for (int m = 0; m < 4; ++m) {
#pragma unroll
                for (int bj = 0; bj < 2; ++bj) *(u32x4*)((char*)O + (boff + (unsigned)((ai * 128 + m * 16) * DM + bj * 128) * 2u)) = pack8(acc[ai][bj][m][0], acc[ai][bj][m][1]);
                asm volatile("" ::: "memory"); }
    }
};
struct EpiPG {
    static constexpr bool PERM = true, AFTER_DRAIN = false;
    const float* stats; const bf16_t* PP; float* y;
    __device__ __forceinline__ void operator()(const f32x4 (&acc)[2][2][4][2], const Unit& u, int wr, int wc, int fr, int fq) const {
        const int rbase = u.pm * 256 + wr * 64 + fr;
#pragma unroll
        for (int ai = 0; ai < 2; ++ai)
#pragma unroll
            for (int m = 0; m < 4; ++m) {
                const int r = rbase + ai * 128 + m * 16; const float rs = rstd16(stats, r);
#pragma unroll
                for (int bj = 0; bj < 2; ++bj) {
                    const int c0 = u.pn * 256 + bj * 128 + wc * 32 + fq * 8; float* o = y + (size_t)r * DM + c0;
                    const u32x4 pw = *(const u32x4*)(PP + (size_t)r * DM + c0);
                    const f32x4 p0 = {__uint_as_float(pw.x << 16), __uint_as_float(pw.x & 0xffff0000u), __uint_as_float(pw.y << 16), __uint_as_float(pw.y & 0xffff0000u)};
                    const f32x4 p1 = {__uint_as_float(pw.z << 16), __uint_as_float(pw.z & 0xffff0000u), __uint_as_float(pw.w << 16), __uint_as_float(pw.w & 0xffff0000u)};
                    const f32x4 y0 = *(const f32x4*)o + p0 * sigmoid4(acc[ai][bj][m][0] * rs), y1 = *(const f32x4*)(o + 4) + p1 * sigmoid4(acc[ai][bj][m][1] * rs);
                    *(f32x4*)o = y0; *(f32x4*)(o + 4) = y1;
                }
            }
    }
};

constexpr int NWAVES = 8, NTHR = 512;
#ifndef MK_ONE_LAUNCH
#define MK_ONE_LAUNCH 1
#endif
constexpr int NPH = 10;
constexpr int RING_OFF = 0, RING_BYTES = 131072, LDSCTL_OFF = RING_BYTES, MISC_OFF = LDSCTL_OFF + 320, LDS_BYTES = 147456;
typedef short s16x8 __attribute__((ext_vector_type(8)));
typedef short s16x4 __attribute__((ext_vector_type(4)));
typedef float f32x16 __attribute__((ext_vector_type(16)));
typedef unsigned u32x2v __attribute__((ext_vector_type(2)));

struct Frame {
    LAS unsigned char* lds; volatile LAS unsigned* MISC; gu32* ctl;
    int tid, lane, wave, vcu, G;
};
__device__ __forceinline__ float wave_sum(float v) {
#pragma unroll
    for (int o = 1; o < 64; o <<= 1) v += __shfl_xor(v, o);
    return v;
}
__device__ __forceinline__ int crow(int r, int hi) { return (r & 3) + 8 * (r >> 2) + 4 * hi; }
__device__ __forceinline__ s16x8 frag(const LAS bf16* X, int ld, int row0, int k0, int lane) { return *(const LAS s16x8*)(X + (row0 + (lane & 31)) * ld + k0 + 8 * (lane >> 5)); }
#define MFMA32(a, b, c) __builtin_amdgcn_mfma_f32_32x32x16_bf16((a), (b), (c), 0, 0, 0)

__device__ __forceinline__ void tr_item(const float* W, int ldw, int K, int k0, int c0, bf16* WT, int d0, const float* g, LAS float* scr, int lane) {
#pragma unroll 8
    for (int i = 0; i < 32; ++i) { const int kk = 2 * i + (lane >> 5); float v = W[(size_t)(k0 + kk) * ldw + c0 + (lane & 31)]; if (g) v *= g[k0 + kk]; scr[kk * 33 + (lane & 31)] = v; }
    LDS_WAIT(); asm volatile("" ::: "memory");
    const int c = lane & 7;
#pragma unroll
    for (int j = 0; j < 4; ++j) { const int n = (lane >> 3) + 8 * j; const LAS float* s = scr + (8 * c) * 33 + n;
        v4u o; o.x = pk2(s[0 * 33], s[1 * 33]); o.y = pk2(s[2 * 33], s[3 * 33]); o.z = pk2(s[4 * 33], s[5 * 33]); o.w = pk2(s[6 * 33], s[7 * 33]);
        *(GAS v4u*)(WT + (size_t)(d0 + n) * K + k0 + 8 * c) = o; }
    LDS_WAIT(); asm volatile("" ::: "memory");
}
__device__ __forceinline__ int sigma_in(int np) {
    const int pn = np >> 8, t = np & 255;
    if (pn < 4) { const int base = (pn >> 1) * 512 + (pn & 1) * 256, tt = t & 127; return base + (tt >> 6) * 128 + (t >> 7) * 64 + (tt & 63); }
    if (pn >= 8 && pn < 12) return pn * 256 + ((t >> 5) & 3) * 64 + (t >> 7) * 32 + (t & 31);
    return np;
}
struct Ptrs {
    const float *xp, *xs, *ck, *cv, *sr, *pp, *ps, *g_mix, *w_in, *g_ro, *g_q, *g_k, *rel_bias, *w_out, *g_ffn, *w_g, *w_u, *w_d, *g_ple, *w_pg, *w_pp;
    float* out; unsigned char* ws;
};
__device__ __forceinline__ void p0_prologue(Frame& F, const Ptrs& P) {
    LAS float* scr = (LAS float*)(F.lds + RING_OFF + F.wave * 16384);
    const int gw = F.vcu * NWAVES + F.wave, NGW = F.G * NWAVES;
    bf16* Wt_in = (bf16*)(P.ws + WS_WIN); bf16* Wt_out = (bf16*)(P.ws + WS_WOUT); bf16* Wt_gu = (bf16*)(P.ws + WS_WGU);
    bf16* Wt_dn = (bf16*)(P.ws + WS_WDN); bf16* Wt_pg = (bf16*)(P.ws + WS_WPG); bf16* Wt_pp = (bf16*)(P.ws + WS_WPP);
    constexpr int I_IN = 16 * (NIN / 32), I_OUT = 16 * 32, I_GU = 16 * (NGU / 32), I_DN = (FF / 64) * 32, I_PG = 16 * 32, I_PP = 4 * 32;
    constexpr int NITEMS = I_IN + I_OUT + I_GU + I_DN + I_PG + I_PP;
    for (int it = gw; it < NITEMS; it += NGW) {
        int r = it;
        if (r < I_IN) { const int nb = r % (NIN / 32), kb = r / (NIN / 32); tr_item(P.w_in, NIN, DM, 64 * kb, sigma_in(32 * nb), Wt_in, 32 * nb, P.g_mix, scr, F.lane); continue; } r -= I_IN;
        if (r < I_OUT) { const int nb = r % 32, kb = r / 32; tr_item(P.w_out, DM, DM, 64 * kb, 32 * nb, Wt_out, 32 * nb, nullptr, scr, F.lane); continue; } r -= I_OUT;
        if (r < I_GU) { const int nb = r % (NGU / 32), kb = r / (NGU / 32); const int np = 32 * nb, pn = np >> 8, t = np & 255;
            tr_item(t < 128 ? P.w_g : P.w_u, FF, DM, 64 * kb, 128 * pn + (t & 127), Wt_gu, np, P.g_ffn, scr, F.lane); continue; } r -= I_GU;
        if (r < I_DN) { const int nb = r % 32, kb = r / 32; tr_item(P.w_d, DM, FF, 64 * kb, 32 * nb, Wt_dn, 32 * nb, nullptr, scr, F.lane); continue; } r -= I_DN;
        if (r < I_PG) { const int nb = r % 32, kb = r / 32; tr_item(P.w_pg, DM, DM, 64 * kb, 32 * nb, Wt_pg, 32 * nb, P.g_ple, scr, F.lane); continue; } r -= I_PG;
        { const int nb = r % 32, kb = r / 32; tr_item(P.w_pp, DM, PLE, 64 * kb, 32 * nb, Wt_pp, 32 * nb, nullptr, scr, F.lane); }
    }
    bf16* xb = (bf16*)(P.ws + WS_A); float* rstdx = (float*)(P.ws + WS_RSTDX);
    for (int m = gw; m < M; m += NGW) {
        const float* xr = m < MP ? P.xp + (size_t)m * DM : P.xs + (size_t)(m - MP) * DM;
        const GAS f32x4* x4 = (const GAS f32x4*)xr + F.lane; f32x4 v[4]; float s = 0.f;
#pragma unroll
        for (int j = 0; j < 4; ++j) { v[j] = x4[64 * j]; s += sum4(v[j] * v[j]); }
        s = wave_sum(s);
        GAS unsigned long long* o8 = (GAS unsigned long long*)(xb + (size_t)m * DM) + F.lane;
#pragma unroll
        for (int j = 0; j < 4; ++j) o8[64 * j] = (unsigned long long)pk2(v[j].x, v[j].y) | ((unsigned long long)pk2(v[j].z, v[j].w) << 32);
        if (F.lane == 0) rstdx[m] = rsqrtf(s * (1.0f / DM) + EPS);
    }
    bf16* pb = (bf16*)(P.ws + WS_PB);
    for (int m = gw; m < M; m += NGW) {
        const float* pr = m < MP ? P.pp + (size_t)m * PLE : P.ps + (size_t)(m - MP) * PLE;
        const f32x4 v = ((const GAS f32x4*)pr)[F.lane];
        ((GAS unsigned long long*)(pb + (size_t)m * PLE))[F.lane] = (unsigned long long)pk2(v.x, v.y) | ((unsigned long long)pk2(v.z, v.w) << 32);
    }
    float* cosT = (float*)(P.ws + WS_COS); float* sinT = (float*)(P.ws + WS_SIN);
    for (int i = (F.vcu * NTHR + F.tid); i < MP * 64; i += F.G * NTHR) {
        const int pos = i >> 6, j = i & 63;
        const float inv = exp2f(-(float)j * (13.287712379549449f / 64.0f));
        const float ang = (float)pos * inv;
        const float k = rintf(ang * 0.15915494309189535f);
        float r = fmaf(-k, 6.28125f, ang); r = fmaf(-k, 1.9353071795864769e-3f, r);
        cosT[i] = __cosf(r); sinT[i] = __sinf(r);
    }
}

typedef short v4i16_t __attribute__((ext_vector_type(4)));
__device__ __forceinline__ s16x4 trrd(const LAS bf16* p) { return __builtin_bit_cast(s16x4, __builtin_amdgcn_ds_read_tr16_b64_v4i16((LAS v4i16_t*)p)); }
__device__ __forceinline__ s16x8 frag_tr(const LAS bf16* X, int ld, int rA, int rB, int c0, int lane) {
    const int i = lane & 15, co = c0 + 16 * ((lane >> 4) & 1) + 4 * (i & 3);
    const s16x4 lo = trrd(X + (rA + (i >> 2)) * ld + co), hh = trrd(X + (rB + (i >> 2)) * ld + co);
    return (s16x8){lo[0], lo[1], lo[2], lo[3], hh[0], hh[1], hh[2], hh[3]};
}
__device__ __forceinline__ s16x8 pack_p(const f32x16& p, int s2) { u32x4 w;
    w.x = pg8::cvt_pk_bf16(p[8 * s2 + 0], p[8 * s2 + 1]); w.y = pg8::cvt_pk_bf16(p[8 * s2 + 2], p[8 * s2 + 3]); w.z = pg8::cvt_pk_bf16(p[8 * s2 + 4], p[8 * s2 + 5]); w.w = pg8::cvt_pk_bf16(p[8 * s2 + 6], p[8 * s2 + 7]);
    return __builtin_bit_cast(s16x8, w); }
__device__ __forceinline__ void unpack8(v4u w, float* f) {
    f[0] = __uint_as_float(w.x << 16); f[1] = __uint_as_float(w.x & 0xffff0000u); f[2] = __uint_as_float(w.y << 16); f[3] = __uint_as_float(w.y & 0xffff0000u);
    f[4] = __uint_as_float(w.z << 16); f[5] = __uint_as_float(w.z & 0xffff0000u); f[6] = __uint_as_float(w.w << 16); f[7] = __uint_as_float(w.w & 0xffff0000u); }
constexpr int LDT = 160;
constexpr int LQ = 136;

constexpr int LKA = 72, LVA = 96;
__device__ __forceinline__ void attn_unit(Frame& F, const Ptrs& P, const bool samp, const int idx, const int h) {
    const bf16* Z = (const bf16*)(P.ws + WS_Z); bf16* MIX = (bf16*)(P.ws + WS_A);
    const int tid = F.tid, lane = F.lane, wave = F.wave, hi = lane >> 5, l31 = lane & 31, wp = wave >> 1, qb = wave & 1;
    LAS bf16* Kb = (LAS bf16*)F.lds; LAS bf16* Vb = Kb + 2 * 64 * LKA; LAS float* BTX = (LAS float*)(F.lds + 43008); LAS float* SC = (LAS float*)(F.lds + 46336) + wave * 32;
    LAS bf16* OS = (LAS bf16*)(F.lds + 47360) + wave * (32 * LKA);
    const int nsteps = samp ? 9 : 12, t0 = samp ? 0 : (idx >= 2 ? 0 : 8 - 4 * idx);
    const int rowq = samp ? MP + 64 * idx + 32 * qb : 256 * idx + 64 * wp + 32 * qb;
    const bool wact = samp ? (wp == 0) : true;
    __syncthreads();
    { const float* rb = P.rel_bias + (size_t)h * 513; const float rb512 = rb[512];
      for (int i = tid; i < 832; i += NTHR) BTX[i] = i <= 512 ? (rb[i] - rb512) * LOG2E : 0.f; }
    s16x8 qf[4];
    { const bf16* qs = Z + (size_t)(rowq + l31) * NIN + ZQA + h * 64 + 8 * hi;
#pragma unroll
      for (int s = 0; s < 4; ++s) qf[s] = wact ? *(const s16x8*)(qs + 16 * s) : (s16x8){0, 0, 0, 0, 0, 0, 0, 0}; }
    const int srow = tid >> 3, sch = tid & 7; v4u kreg, vreg;
#define A_LOAD(t) do { if (samp && (t) < 8) { \
            const float* ks_ = P.ck + ((size_t)(idx * 512 + 64 * (t) + srow) * 8 + h) * 64 + sch * 8; const float* vs_ = P.cv + ((size_t)(idx * 512 + 64 * (t) + srow) * 8 + h) * 64 + sch * 8; \
            const f32x4 a_ = *(const f32x4*)ks_, b_ = *(const f32x4*)(ks_ + 4), c_ = *(const f32x4*)vs_, d_ = *(const f32x4*)(vs_ + 4); \
            kreg = pack8(a_, b_); vreg = pack8(c_, d_); \
        } else { const int kr_ = samp ? MP + 64 * idx + srow : 64 * (4 * idx - 8 + (t)) + srow; const bf16* s_ = Z + (size_t)kr_ * NIN + h * 64 + sch * 8; \
            kreg = *(const v4u*)(s_ + ZKA); vreg = *(const v4u*)(s_ + ZVA); } } while (0)
#define A_STORE(buf) do { *(LAS v4u*)(Kb + (buf) * 64 * LKA + srow * LKA + sch * 8) = kreg; *(LAS v4u*)(Vb + (buf) * 64 * LVA + srow * LVA + sch * 8) = vreg; } while (0)
    f32x16 o0 = {}, o1 = {}; float m_run = 0.f, l_run = 0.f; bool first = true;
    const int b0 = 768 + 32 * qb + l31 - 4 * hi;
    A_LOAD(t0); A_STORE(0); __syncthreads();
    for (int t = t0, it = 0; t < nsteps; ++t, ++it) {
        if (t + 1 < nsteps) A_LOAD(t + 1);
        const int j = samp ? t : t - wp;
        if (wact && j >= 0 && j <= 8) {
            const LAS bf16* Kc = Kb + (it & 1) * 64 * LKA; const LAS bf16* Vc = Vb + (it & 1) * 64 * LVA;
            f32x16 p[2];
#pragma unroll
            for (int lb = 0; lb < 2; ++lb) { f32x16 c;
                if (j >= 4) { const LAS float* bp = BTX + (b0 - 64 * j - 32 * lb);
#pragma unroll
                    for (int r = 0; r < 16; ++r) c[r] = bp[-((r & 3) + 8 * (r >> 2))] - m_run;
                } else {
#pragma unroll
                    for (int r = 0; r < 16; ++r) c[r] = -m_run; }
#pragma unroll
                for (int s = 0; s < 4; ++s) c = MFMA32(frag(Kc, LKA, 32 * lb, 16 * s, lane), qf[s], c);
                p[lb] = c; }
            float mx = p[0][0];
#pragma unroll
            for (int r = 0; r < 16; ++r) { mx = fmaxf(mx, p[0][r]); mx = fmaxf(mx, p[1][r]); }
            mx = fmaxf(mx, __shfl_xor(mx, 32));
            if (first || __any(mx > 8.0f)) {
                const float d = first ? mx : fmaxf(mx, 0.f); m_run += d;
#pragma unroll
                for (int r = 0; r < 16; ++r) { p[0][r] -= d; p[1][r] -= d; }
                if (!first) { const float alpha = exp2f(-d); l_run *= alpha;
                    if (hi == 0) SC[l31] = alpha;
                    asm volatile("s_waitcnt lgkmcnt(0)" ::: "memory");
#pragma unroll
                    for (int r = 0; r < 16; ++r) { const float f = SC[crow(r, hi)]; o0[r] *= f; o1[r] *= f; }
                    asm volatile("s_waitcnt lgkmcnt(0)" ::: "memory"); }
                first = false;
            }
            float ls = 0.f;
#pragma unroll
            for (int r = 0; r < 16; ++r) { p[0][r] = __builtin_amdgcn_exp2f(p[0][r]); p[1][r] = __builtin_amdgcn_exp2f(p[1][r]); ls += p[0][r] + p[1][r]; }
            l_run += ls;
#pragma unroll
            for (int lb = 0; lb < 2; ++lb)
#pragma unroll
                for (int s2 = 0; s2 < 2; ++s2) { const s16x8 pa = pack_p(p[lb], s2); const int kb = 32 * lb + 16 * s2 + 4 * hi;
                    o0 = MFMA32(pa, frag_tr(Vc, LVA, kb, kb + 8, 0, lane), o0); o1 = MFMA32(pa, frag_tr(Vc, LVA, kb, kb + 8, 32, lane), o1); }
        }
        if (t + 1 < nsteps) A_STORE((it + 1) & 1);
        __syncthreads();
    }
#undef A_LOAD
#undef A_STORE
    if (wact) {
        l_run += __shfl_xor(l_run, 32);
        if (hi == 0) SC[l31] = 1.0f / l_run;
        asm volatile("s_waitcnt lgkmcnt(0)" ::: "memory");
#pragma unroll
        for (int r = 0; r < 16; ++r) { const int n = crow(r, hi); const float f = SC[n]; OS[n * LKA + l31] = (bf16)f2bf(o0[r] * f); OS[n * LKA + 32 + l31] = (bf16)f2bf(o1[r] * f); }
        asm volatile("s_waitcnt lgkmcnt(0)" ::: "memory");
        const int row = lane >> 1, half = lane & 1; bf16* dst = MIX + (size_t)(rowq + row) * DM + 512 + h * 64 + 32 * half;
#pragma unroll
        for (int c = 0; c < 4; ++c) *(v4u*)(dst + 8 * c) = *(const LAS v4u*)(OS + row * LKA + 32 * half + 8 * c);
    }
}

__device__ __forceinline__ void retU_item(Frame& F, const Ptrs& P, const bool samp, const int idx, const int h) {
    const bf16* Z = (const bf16*)(P.ws + WS_Z);
    const int tid = F.tid, lane = F.lane, wave = F.wave, hi = lane >> 5, l31 = lane & 31;
    LAS bf16* Vi = (LAS bf16*)F.lds; LAS bf16* Ki = Vi + 128 * LDT;
    const int T = samp ? 64 : 256, row0 = samp ? MP + 64 * idx : 256 * idx;
    const LAS bf16* X = samp ? Ki : Vi; const LAS bf16* Y = samp ? Vi : Ki;
    const int ib = wave >> 1, jb0 = 2 * (wave & 1);
    f32x16 a0 = {}, a1 = {};
    for (int p0 = 0; p0 < T; p0 += 128) {
        const int rows = (T - p0) < 128 ? (T - p0) : 128;
        __syncthreads();
        for (int c = tid; c < rows * 16; c += NTHR) { const int row = c >> 4, ch = c & 15;
            const bf16* src = Z + (size_t)(row0 + p0 + row) * NIN + h * 128 + ch * 8;
            *(LAS v4u*)(Vi + row * LDT + ch * 8) = *(const v4u*)(src + ZV); *(LAS v4u*)(Ki + row * LDT + ch * 8) = *(const v4u*)(src + ZK); }
        __syncthreads();
        for (int s = 0; s < rows / 16; ++s) { const int rA = 16 * s + 8 * hi;
            const s16x8 a = frag_tr(X, LDT, rA, rA + 4, 32 * ib, lane);
            a0 = MFMA32(a, frag_tr(Y, LDT, rA, rA + 4, 32 * jb0, lane), a0); a1 = MFMA32(a, frag_tr(Y, LDT, rA, rA + 4, 32 * jb0 + 32, lane), a1); }
    }
    const float lg2 = lg2_gamma(h), gT1 = exp2f((float)(T - 1) * lg2);
    if (!samp) {
        float* UF = (float*)(P.ws + WS_UF) + (size_t)(idx * 4 + h) * 16384;
#pragma unroll
        for (int r = 0; r < 16; ++r) { const int e = 32 * ib + crow(r, hi); UF[e * 128 + 32 * jb0 + l31] = gT1 * a0[r]; UF[e * 128 + 32 * jb0 + 32 + l31] = gT1 * a1[r]; }
    } else {
        const float g64 = exp2f(64.0f * lg2);
        const float* R0 = P.sr + (size_t)(idx * 4 + h) * 16384; float* RO = P.out + OFF_RS + (size_t)(idx * 4 + h) * 16384;
#pragma unroll
        for (int r = 0; r < 16; ++r) { const int d = 32 * ib + crow(r, hi); const int e0 = 32 * jb0 + l31;
            RO[d * 128 + e0] = g64 * R0[d * 128 + e0] + gT1 * a0[r]; RO[d * 128 + e0 + 32] = g64 * R0[d * 128 + e0 + 32] + gT1 * a1[r]; }
    }
}
__device__ __forceinline__ void ret_scan(Frame& F, const Ptrs& P) {
    const int gid = F.vcu * NTHR + F.tid;
    if (gid < 32768) {
        typedef float f32x2v __attribute__((ext_vector_type(2)));
        const f32x2v* uf = (const f32x2v*)(P.ws + WS_UF) + gid; unsigned* rb = (unsigned*)(P.ws + WS_RB) + gid; const int h = gid >> 13;
        const float g = exp2f(256.0f * lg2_gamma(h)); float R0 = 0.f, R1 = 0.f;
        f32x2v u[64];
#pragma unroll
        for (int c = 0; c < 64; ++c) u[c] = uf[(size_t)c * 32768];
#pragma unroll
        for (int c = 0; c < 64; ++c) { rb[(size_t)c * 32768] = pk2(R0, R1); R0 = g * R0 + u[c].x; R1 = g * R1 + u[c].y; }
        const int el = (2 * gid) & 16383, e = el >> 7, d = el & 127;
        float* o = P.out + OFF_RP + (size_t)h * 16384; o[d * 128 + e] = R0; o[(d + 1) * 128 + e] = R1;
    }
}
__device__ __forceinline__ void retO_item(Frame& F, const Ptrs& P, const bool samp, const int idx, const int h) {
    const bf16* Z = (const bf16*)(P.ws + WS_Z); bf16* MIX = (bf16*)(P.ws + WS_A);
    const int tid = F.tid, lane = F.lane, wave = F.wave, hi = lane >> 5, l31 = lane & 31;
    LAS bf16* RT = (LAS bf16*)F.lds; LAS bf16* Kb = RT + 128 * LQ; LAS bf16* Vb = Kb + 2 * 64 * LQ; LAS bf16* OS = Kb + wave * (32 * LQ);
    const int T = samp ? 64 : 256, row0 = samp ? MP + 64 * idx : 256 * idx, nkb_all = T / 64;
    const int rb = wave < 4 ? wave : 11 - wave; const bool act = rb * 32 < T; const int nkb = act ? (rb >> 1) + 1 : 0;
    const float gam = exp2f(lg2_gamma(h));
    __syncthreads();
    if (!samp) { const bf16* rs = (const bf16*)(P.ws + WS_RB) + (size_t)(idx * 4 + h) * 16384;
#pragma unroll
        for (int i = 0; i < 4; ++i) { const int c = tid + NTHR * i, e = c >> 4, ch = c & 15; *(LAS v4u*)(RT + e * LQ + ch * 8) = *(const v4u*)(rs + e * 128 + ch * 8); }
    } else { const float* rs = P.sr + (size_t)(idx * 4 + h) * 16384;
#pragma unroll
        for (int i = 0; i < 8; ++i) { const int id = i * NTHR + tid, d = id >> 5, e0 = (id & 31) * 4; const f32x4 v = *(const f32x4*)(rs + d * 128 + e0);
            RT[(e0 + 0) * LQ + d] = (bf16)f2bf(v.x); RT[(e0 + 1) * LQ + d] = (bf16)f2bf(v.y); RT[(e0 + 2) * LQ + d] = (bf16)f2bf(v.z); RT[(e0 + 3) * LQ + d] = (bf16)f2bf(v.w); } }
    s16x8 qf[8];
    { const bf16* qs = Z + (size_t)(row0 + (act ? 32 * rb : 0) + l31) * NIN + ZQ + h * 128 + 8 * hi;
#pragma unroll
      for (int s = 0; s < 8; ++s) qf[s] = *(const s16x8*)(qs + 16 * s); }
    v4u kreg[2], vreg[2];
#define R_LOAD(kb) do { _Pragma("unroll") for (int i_ = 0; i_ < 2; ++i_) { const int c_ = tid + NTHR * i_; const bf16* s_ = Z + (size_t)(row0 + 64 * (kb) + (c_ >> 4)) * NIN + h * 128 + (c_ & 15) * 8; \
        kreg[i_] = *(const v4u*)(s_ + ZK); vreg[i_] = *(const v4u*)(s_ + ZV); } } while (0)
#define R_STORE(buf) do { _Pragma("unroll") for (int i_ = 0; i_ < 2; ++i_) { const int c_ = tid + NTHR * i_; \
        *(LAS v4u*)(Kb + (buf) * 64 * LQ + (c_ >> 4) * LQ + (c_ & 15) * 8) = kreg[i_]; *(LAS v4u*)(Vb + (buf) * 64 * LDT + (c_ >> 4) * LDT + (c_ & 15) * 8) = vreg[i_]; } } while (0)
    R_LOAD(0); R_STORE(0); __syncthreads();
    f32x16 acc[4];
#pragma unroll
    for (int eb = 0; eb < 4; ++eb) { f32x16 a = {};
        if (act) {
#pragma unroll
            for (int s = 0; s < 8; ++s) a = MFMA32(qf[s], frag(RT, LQ, 32 * eb, 16 * s, lane), a); }
        acc[eb] = a * gam; }
    for (int kb = 0; kb < nkb_all; ++kb) {
        if (kb + 1 < nkb_all) R_LOAD(kb + 1);
        if (kb < nkb) {
            const LAS bf16* Kc = Kb + (kb & 1) * 64 * LQ; const LAS bf16* Vc = Vb + (kb & 1) * 64 * LDT; const bool diag = (kb == nkb - 1);
#pragma unroll
            for (int lb = 0; lb < 2; ++lb) {
                if (diag && lb == 1 && !(rb & 1)) continue;
                f32x16 p = {};
#pragma unroll
                for (int s = 0; s < 8; ++s) p = MFMA32(frag(Kc, LQ, 32 * lb, 16 * s, lane), qf[s], p);
                if (diag) { const int nl = 32 * (rb & 1) + l31;
#pragma unroll
                    for (int r = 0; r < 16; ++r) if (32 * lb + crow(r, hi) > nl) p[r] = 0.f; }
#pragma unroll
                for (int s2 = 0; s2 < 2; ++s2) { const s16x8 pa = pack_p(p, s2); const int kr = 32 * lb + 16 * s2 + 4 * hi;
#pragma unroll
                    for (int eb = 0; eb < 4; ++eb) acc[eb] = MFMA32(pa, frag_tr(Vc, LDT, kr, kr + 8, 32 * eb, lane), acc[eb]); }
            }
        }
        if (kb + 1 < nkb_all) R_STORE((kb + 1) & 1);
        __syncthreads();
    }
#undef R_LOAD
#undef R_STORE
    if (act) {
#pragma unroll
        for (int eb = 0; eb < 4; ++eb)
#pragma unroll
            for (int r = 0; r < 16; ++r) OS[crow(r, hi) * LQ + 32 * eb + l31] = (bf16)f2bf(acc[eb][r]);
        asm volatile("s_waitcnt lgkmcnt(0)" ::: "memory");
        const int row = lane >> 1, half = lane & 1, grow = row0 + 32 * rb + row;
        v4u ow[8]; float ss = 0.f;
#pragma unroll
        for (int c = 0; c < 8; ++c) { ow[c] = *(const LAS v4u*)(OS + row * LQ + 64 * half + 8 * c); float f[8]; unpack8(ow[c], f);
#pragma unroll
            for (int i = 0; i < 8; ++i) ss += f[i] * f[i]; }
        ss += __shfl_xor(ss, 1);
        const float inv = rsqrtf(ss * (1.0f / 128.0f) + EPS);
        const bf16* gs = Z + (size_t)grow * NIN + ZG + h * 128 + 64 * half; const float* gro = P.g_ro + h * 128 + 64 * half; bf16* dst = MIX + (size_t)grow * DM + h * 128 + 64 * half;
#pragma unroll
        for (int c = 0; c < 8; ++c) { float f[8], g[8]; unpack8(ow[c], f); unpack8(*(const v4u*)(gs + 8 * c), g);
            const f32x4 r0 = *(const f32x4*)(gro + 8 * c), r1 = *(const f32x4*)(gro + 8 * c + 4); f32x4 x0, x1;
#pragma unroll
            for (int i = 0; i < 4; ++i) { x0[i] = g[i] * __builtin_amdgcn_rcpf(1.0f + __builtin_amdgcn_exp2f(-g[i] * LOG2E)) * f[i] * inv * r0[i];
                                          x1[i] = g[4 + i] * __builtin_amdgcn_rcpf(1.0f + __builtin_amdgcn_exp2f(-g[4 + i] * LOG2E)) * f[4 + i] * inv * r1[i]; }
            *(v4u*)(dst + 8 * c) = pack8(x0, x1); }
    }
}

struct Args { const float* in[21]; float* out; unsigned char* ws; int ph_lo, ph_hi; };
template <int PHM> __global__ void __launch_bounds__(NTHR, 2) skel_fwd(Args args) {
    extern __shared__ __attribute__((aligned(16))) unsigned char lds[];
    Frame F;
    F.lds = (LAS unsigned char*)lds; F.MISC = (volatile LAS unsigned*)(F.lds + MISC_OFF);
    F.tid = threadIdx.x; F.lane = F.tid & 63; F.wave = __builtin_amdgcn_readfirstlane(F.tid >> 6);
    F.G = gridDim.x; { const int bx = blockIdx.x; F.vcu = (F.G % 8 == 0) ? (bx % 8) * (F.G / 8) + bx / 8 : bx; }
    unsigned char* ws = args.ws; F.ctl = (gu32*)(ws + WS_CTL);
    Ptrs P; P.xp = args.in[0]; P.xs = args.in[1]; P.ck = args.in[2]; P.cv = args.in[3]; P.sr = args.in[4]; P.pp = args.in[5]; P.ps = args.in[6]; P.g_mix = args.in[7]; P.w_in = args.in[8];
    P.g_ro = args.in[9]; P.g_q = args.in[10]; P.g_k = args.in[11]; P.rel_bias = args.in[12]; P.w_out = args.in[13]; P.g_ffn = args.in[14]; P.w_g = args.in[15]; P.w_u = args.in[16];
    P.w_d = args.in[17]; P.g_ple = args.in[18]; P.w_pg = args.in[19]; P.w_pp = args.in[20]; P.out = args.out; P.ws = ws;
    for (int u = F.tid; u < (LDS_BYTES - LDSCTL_OFF) / 4; u += NTHR) ((LAS unsigned*)(F.lds + LDSCTL_OFF))[u] = 0u;
    __syncthreads();
    XcdBarrier bar; bar.bar = (unsigned*)(F.ctl + CW_BAR); bar.x = 0; bar.st = nullptr;
    if (MK_ONE_LAUNCH) bar = xcd_barrier_post((unsigned*)(F.ctl + CW_BAR), F.MISC + 8);
#define GRID_BAR() do { if (MK_ONE_LAUNCH) xcd_barrier(bar); } while (0)
    const int lo = args.ph_lo, hi = args.ph_hi;
#define IN(k) (((PHM >> (k)) & 1) && lo <= (k) && (k) < hi)
#define BOTH(k) (IN(k) && IN((k) + 1))
    bf16* XB = (bf16*)(ws + WS_A); bf16* ZB = (bf16*)(ws + WS_Z); bf16* HB = (bf16*)(ws + WS_HB); bf16* TB = (bf16*)(ws + WS_T); bf16* PPB = (bf16*)(ws + WS_A);
    float* ST1 = (float*)(ws + WS_ST1); float* ST2 = (float*)(ws + WS_ST2);

    if (IN(0)) { p0_prologue(F, P); if (BOTH(0)) GRID_BAR(); }
    if (IN(1)) {
        pg8::Gemm g{XB, (const bf16*)(ws + WS_WIN), M, NIN, DM}; pg8::StaticOrder S; S.init(M, NIN, F.G, (int)blockIdx.x);
        EpiIn E{ZB, (const float*)(ws + WS_RSTDX), (const float*)(ws + WS_COS), (const float*)(ws + WS_SIN), P.g_q, P.g_k, P.out};
        pg8::gemm_phase<EpiIn, pg8::StaticOrder, true, true>(F.lds + RING_OFF, g, S, E);
        if (BOTH(1)) GRID_BAR();
    }
    if (IN(2)) {
        for (int it = F.vcu; it < 384; it += F.G) { if (it < 256) retU_item(F, P, false, it >> 2, it & 3); else retU_item(F, P, true, (it - 256) >> 2, (it - 256) & 3); }
        for (int it = F.vcu; it < 768; it += F.G) { if (it < 512) attn_unit(F, P, false, it & 63, it >> 6); else attn_unit(F, P, true, (it - 512) >> 3, (it - 512) & 7); }
        if (BOTH(2)) GRID_BAR();
    }
    if (IN(3)) { ret_scan(F, P); if (BOTH(3)) GRID_BAR(); }
    if (IN(4)) {
        for (int it = F.vcu; it < 384; it += F.G) { if (it < 256) retO_item(F, P, false, it >> 2, it & 3); else retO_item(F, P, true, (it - 256) >> 2, (it - 256) & 3); }
        __syncthreads();
        if (BOTH(4)) GRID_BAR();
    }
    if (IN(5)) {
        pg8::Gemm g{(const bf16*)(ws + WS_A), (const bf16*)(ws + WS_WOUT), M, DM, DM}; pg8::StaticOrder S; S.init(M, DM, F.G, (int)blockIdx.x);
        EpiRes E{P.xp, P.xs, P.out, HB, ST1};
        pg8::gemm_phase<EpiRes, pg8::StaticOrder, true, true>(F.lds + RING_OFF, g, S, E);
        if (BOTH(5)) GRID_BAR();
    }
    if (IN(6)) {
        pg8::Gemm g{HB, (const bf16*)(ws + WS_WGU), M, NGU, DM}; pg8::StaticOrder S; S.init(M, NGU, F.G, (int)blockIdx.x);
        EpiGU E{ST1, TB};
        pg8::gemm_phase<EpiGU, pg8::StaticOrder, true, true>(F.lds + RING_OFF, g, S, E);
        if (BOTH(6)) GRID_BAR();
    }
    if (IN(7)) {
        pg8::Gemm g{TB, (const bf16*)(ws + WS_WDN), M, DM, FF}; pg8::StaticOrder S; S.init(M, DM, F.G, (int)blockIdx.x);
        EpiRes E{P.out, P.out + (size_t)MP * DM, P.out, HB, ST2};
        pg8::gemm_phase<EpiRes, pg8::StaticOrder, true, true>(F.lds + RING_OFF, g, S, E);
        if (BOTH(7)) GRID_BAR();
    }
    if (IN(8)) {
        pg8::Gemm g{(const bf16*)(ws + WS_PB), (const bf16*)(ws + WS_WPP), M, DM, PLE}; pg8::StaticOrder S; S.init(M, DM, F.G, (int)blockIdx.x);
        EpiPP E{PPB};
        pg8::gemm_phase<EpiPP, pg8::StaticOrder, true, true>(F.lds + RING_OFF, g, S, E);
        if (BOTH(8)) GRID_BAR();
    }
    if (IN(9)) {
        pg8::Gemm g{HB, (const bf16*)(ws + WS_WPG), M, DM, DM}; pg8::StaticOrder S; S.init(M, DM, F.G, (int)blockIdx.x);
        EpiPG E{ST2, PPB, P.out};
        pg8::gemm_phase<EpiPG, pg8::StaticOrder, true, true>(F.lds + RING_OFF, g, S, E);
    }
#undef IN
#undef BOTH
}

extern "C" void kernel_launch(void* const* d_in, const int* in_sizes, int n_in, void* d_out, int out_size, void* d_ws, size_t ws_size, hipStream_t stream) {
    static int grid = 0;
    if (grid == 0) {
        if (n_in != 21 || out_size != (int)OUT_TOTAL || ws_size < WS_END) { fprintf(stderr, "kernel_launch: unexpected shapes n_in %d out %d ws %zu\n", n_in, out_size, ws_size); grid = -1; return; }
#if MK_ONE_LAUNCH
        if (hipFuncSetAttribute((const void*)skel_fwd<0x3ff>, hipFuncAttributeMaxDynamicSharedMemorySize, LDS_BYTES) != hipSuccess) { fprintf(stderr, "kernel_launch: hipFuncSetAttribute failed\n"); grid = -1; return; }
#else
#define SETATTR(ph) (void)hipFuncSetAttribute((const void*)skel_fwd<(1 << (ph))>, hipFuncAttributeMaxDynamicSharedMemorySize, LDS_BYTES)
        SETATTR(0); SETATTR(1); SETATTR(2); SETATTR(3); SETATTR(4); SETATTR(5); SETATTR(6); SETATTR(7); SETATTR(8); SETATTR(9);
#endif
        int dev = 0, cus = 0;
        if (hipGetDevice(&dev) != hipSuccess || hipDeviceGetAttribute(&cus, hipDeviceAttributeMultiprocessorCount, dev) != hipSuccess) { grid = -1; return; }
        (void)hipGetLastError();
        grid = cus;
    }
    if (grid < 0) return;
    (void)hipMemsetAsync((char*)d_ws + WS_CTL, 0, CTL_ZERO_BYTES, stream);
    Args a{};
    for (int i = 0; i < 21; ++i) a.in[i] = (const float*)d_in[i];
    a.out = (float*)d_out; a.ws = (unsigned char*)d_ws;
#if MK_ONE_LAUNCH
    a.ph_lo = 0; a.ph_hi = NPH;
    hipLaunchKernelGGL(skel_fwd<0x3ff>, dim3(grid), dim3(NTHR), LDS_BYTES, stream, a);
#else
#define LAUNCH_PH(ph) do { a.ph_lo = (ph); a.ph_hi = (ph) + 1; hipLaunchKernelGGL(skel_fwd<(1 << (ph))>, dim3(grid), dim3(NTHR), LDS_BYTES, stream, a); } while (0)
    LAUNCH_PH(0); LAUNCH_PH(1); LAUNCH_PH(2); LAUNCH_PH(3); LAUNCH_PH(4); LAUNCH_PH(5); LAUNCH_PH(6); LAUNCH_PH(7); LAUNCH_PH(8); LAUNCH_PH(9);
#endif
}
```

```cpp
#include <hip/hip_runtime.h>
#include <cstdio>
#include <cstdint>
namespace pg8 {
#define PG8_LAS __attribute__((address_space(3)))
typedef unsigned short bf16_t;
typedef short bf16x8 __attribute__((ext_vector_type(8)));
typedef float f32x4 __attribute__((ext_vector_type(4)));
typedef unsigned u32x4 __attribute__((ext_vector_type(4)));
constexpr int BM = 256, BK = 64, HALF = 128, HTB = HALF * BK * 2  , STAGE_BYTES = 8 * HTB, NXCD = 8, WGM = 8;

__host__ __device__ __forceinline__ int lds_byte(int r, int c) { const int st = (r >> 4) * 2 + (c >> 5), rr = r & 15, cc = c & 31, ob = rr * 64 + cc * 2; return st * 1024 + (ob ^ (((ob >> 9) & 1) << 5)); }
__host__ __device__ __forceinline__ void stage_rc(int b, int& R, int& C) { const int st = b / 1024, sb = b % 1024, swz = sb ^ (((sb >> 9) & 1) << 5); R = (st >> 1) * 16 + swz / 64; C = (st & 1) * 32 + (swz % 64) / 2; }
__host__ __device__ __forceinline__ int perm32(int rho) { const int n = rho >> 4, i = rho & 15; return 8 * (i >> 2) + 4 * n + (i & 3); }

struct Unit { int pm, pn; };
struct Gemm { const bf16_t* A; const bf16_t* Bt; int M, N, K; };

struct StaticOrder {
    int nM, nN, nwg, G, c;
    __host__ __device__ void init(int M, int N, int G_, int c_) { nM = M / BM; nN = N / BM; nwg = nM * nN; G = G_; c = c_; }
    __host__ __device__ bool next(int i, Unit& u) const {
        const long L = (long)i * G + c; if (L >= nwg) return false;
        int wgid = (int)L; { const int q = nwg / NXCD, r = nwg % NXCD, xcd = wgid % NXCD, off = wgid / NXCD; wgid = (xcd < r ? xcd * (q + 1) : r * (q + 1) + (xcd - r) * q) + off; }
        const int nig = WGM * nN, gid = wgid / nig, fm = gid * WGM, gsz = (nM - fm) < WGM ? (nM - fm) : WGM;
        u.pm = fm + ((wgid % nig) % gsz); u.pn = (wgid % nig) / gsz; return true;
    }
    __device__ __forceinline__ void a_ready(const Unit&) const {}
    __device__ __forceinline__ void done(const Unit&) const {}
};

__device__ __forceinline__ unsigned cvt_pk_bf16(float lo, float hi) { unsigned r; asm volatile("v_cvt_pk_bf16_f32 %0, %1, %2" : "=v"(r) : "v"(lo), "v"(hi)); return r; }
typedef float f32x2 __attribute__((ext_vector_type(2)));
template <class Epi, class Sched, bool ALIGN_EPI = false, bool SP2 = false>
__device__ __forceinline__ void gemm_phase(PG8_LAS unsigned char* lds, const Gemm g, const Sched& S, const Epi& E) {
    int tid_ = threadIdx.x; asm volatile("" : "+v"(tid_));
    const int tid = tid_, wid = __builtin_amdgcn_readfirstlane(tid >> 6), lane = tid & 63, wr = wid >> 2, wc = wid & 3, fr = lane & 15, fq = lane >> 4;
    const int K = g.K, nt = K / BK;
    unsigned voffA[2], voffB[2];
#pragma unroll
    for (int i = 0; i < 2; ++i) { int R, C; stage_rc(tid * 16 + i * 8192, R, C); const int Rb = Epi::PERM ? ((R & ~31) + perm32(R & 31)) : R;
        voffA[i] = (unsigned)(R * K + C) * 2u; voffB[i] = (unsigned)(Rb * K + C) * 2u; }
    const size_t kstep = (size_t)(BK * 2);
    const size_t hstep = (size_t)HALF * K * 2;
    const size_t tstep = 2 * hstep;
    const unsigned ldsw = (unsigned)wid * 1024u;
    const int aoff = lds_byte(wr * 64 + fr, fq * 8), boff = lds_byte(wc * 32 + fr, fq * 8);
#define PG8_SA(b, h) (((b) * 2 + (h)) * HTB)
#define PG8_SB(b, h) ((4 + (b) * 2 + (h)) * HTB)
#define PG8_STAGE(bufoff, gbase, voff) do { _Pragma("unroll") for (int _i = 0; _i < 2; ++_i) \
        __builtin_amdgcn_global_load_lds((const unsigned*)((const char*)(gbase) + (voff)[_i]), (PG8_LAS unsigned*)(lds + (bufoff) + ldsw + _i * 8192), 16, 0, 0); } while (0)
#define PG8_LDA(dst, b, h) do { _Pragma("unroll") for (int m = 0; m < 4; ++m) _Pragma("unroll") for (int k = 0; k < 2; ++k) dst[m][k] = *(const PG8_LAS bf16x8*)(lds + PG8_SA(b, h) + aoff + m * 2048 + k * 1024); } while (0)
#define PG8_LDB(dst, b, h) do { _Pragma("unroll") for (int n = 0; n < 2; ++n) _Pragma("unroll") for (int k = 0; k < 2; ++k) dst[n][k] = *(const PG8_LAS bf16x8*)(lds + PG8_SB(b, h) + boff + n * 2048 + k * 1024); } while (0)
#define PG8_MMA(ai, bj, At, Bt) do { __builtin_amdgcn_s_setprio(1); _Pragma("unroll") for (int m = 0; m < 4; ++m) _Pragma("unroll") for (int n = 0; n < 2; ++n) _Pragma("unroll") for (int k = 0; k < 2; ++k) \
        acc[ai][bj][m][n] = __builtin_amdgcn_mfma_f32_16x16x32_bf16(Bt[n][k], At[m][k], acc[ai][bj][m][n], 0, 0, 0); __builtin_amdgcn_s_setprio(0); } while (0)
#define PG8_WAIT_V(n) asm volatile("s_waitcnt vmcnt(" #n ")" ::: "memory")
#define PG8_WAIT_L(n) asm volatile("s_waitcnt lgkmcnt(" #n ")" ::: "memory")
#define PG8_BAR __builtin_amdgcn_s_barrier()
#define PG8_SCHED __builtin_amdgcn_sched_barrier(0)
    Unit cur, nxt; int ui = 0;
    if (!S.next(0, cur)) return;
    f32x4 acc[2][2][4][2];
#pragma unroll
    for (int a = 0; a < 2; ++a)
#pragma unroll
        for (int b = 0; b < 2; ++b)
#pragma unroll
            for (int m = 0; m < 4; ++m)
#pragma unroll
                for (int n = 0; n < 2; ++n) acc[a][b][m][n] = (f32x4){0.f, 0.f, 0.f, 0.f};
    bf16x8 At[4][2], B0[2][2], B1[2][2];
    const char* cA = (const char*)g.A + (size_t)cur.pm * tstep; const char* cB = (const char*)g.Bt + (size_t)cur.pn * tstep;
    S.a_ready(cur);
    if constexpr (SP2) {
        PG8_STAGE(PG8_SB(0, 0), cB, voffB); PG8_STAGE(PG8_SB(0, 1), cB + hstep, voffB); PG8_STAGE(PG8_SA(0, 0), cA, voffA); PG8_STAGE(PG8_SA(0, 1), cA + hstep, voffA);
        if (wr == 1) PG8_BAR;
        PG8_WAIT_V(2); PG8_BAR;
        PG8_STAGE(PG8_SB(1, 0), cB + kstep, voffB); PG8_STAGE(PG8_SA(1, 0), cA + kstep, voffA); PG8_STAGE(PG8_SB(1, 1), cB + hstep + kstep, voffB);
        PG8_WAIT_V(6); PG8_BAR;
    } else {
        PG8_STAGE(PG8_SB(0, 0), cB, voffB); PG8_STAGE(PG8_SA(0, 0), cA, voffA); PG8_STAGE(PG8_SB(0, 1), cB + hstep, voffB); PG8_STAGE(PG8_SA(0, 1), cA + hstep, voffA);
        if (wr == 1) PG8_BAR;
        PG8_WAIT_V(4); PG8_BAR;
        PG8_STAGE(PG8_SB(1, 0), cB + kstep, voffB); PG8_STAGE(PG8_SA(1, 0), cA + kstep, voffA); PG8_STAGE(PG8_SB(1, 1), cB + hstep + kstep, voffB);
        PG8_WAIT_V(6); PG8_BAR;
    }
    for (;;) {
        const bool has_next = S.next(ui + 1, nxt);
        const char* nA = has_next ? (const char*)g.A + (size_t)nxt.pm * tstep : cA; const char* nB = has_next ? (const char*)g.Bt + (size_t)nxt.pn * tstep : cB;
        for (int t = 0; t < nt; t += 2) {
            const bool last = (t == nt - 2);
            const char* a1 = cA + (size_t)(t + 1) * kstep;
            const char* a2 = last ? nA : cA + (size_t)(t + 2) * kstep; const char* b2 = last ? nB : cB + (size_t)(t + 2) * kstep;
            const char* a3 = a2 + kstep; const char* b3 = b2 + kstep;
            if (last && has_next) S.a_ready(nxt);
            if constexpr (SP2) {
            PG8_LDB(B0, 0, 0); PG8_LDB(B1, 0, 1); PG8_SCHED; PG8_LDA(At, 0, 0); PG8_STAGE(PG8_SA(1, 1), a1 + hstep, voffA);
            PG8_WAIT_V(8); PG8_WAIT_L(0); PG8_BAR; PG8_MMA(0, 0, At, B0); PG8_MMA(0, 1, At, B1); PG8_BAR; PG8_SCHED;
            PG8_LDA(At, 0, 1); PG8_STAGE(PG8_SB(0, 0), b2, voffB); PG8_STAGE(PG8_SB(0, 1), b2 + hstep, voffB); PG8_STAGE(PG8_SA(0, 0), a2, voffA);
            PG8_WAIT_V(8); PG8_WAIT_L(0); PG8_BAR; PG8_MMA(1, 0, At, B0); PG8_MMA(1, 1, At, B1); PG8_BAR; PG8_SCHED;
            PG8_LDB(B0, 1, 0); PG8_LDB(B1, 1, 1); PG8_SCHED; PG8_LDA(At, 1, 0); PG8_STAGE(PG8_SA(0, 1), a2 + hstep, voffA);
            PG8_WAIT_V(8); PG8_WAIT_L(0); PG8_BAR; PG8_MMA(0, 0, At, B0); PG8_MMA(0, 1, At, B1); PG8_BAR; PG8_SCHED;
            PG8_LDA(At, 1, 1); PG8_STAGE(PG8_SB(1, 0), b3, voffB); PG8_STAGE(PG8_SB(1, 1), b3 + hstep, voffB); PG8_STAGE(PG8_SA(1, 0), a3, voffA);
            PG8_WAIT_V(8); PG8_WAIT_L(0); PG8_BAR; PG8_MMA(1, 0, At, B0); PG8_MMA(1, 1, At, B1); PG8_BAR; PG8_SCHED;
            } else {
            PG8_LDB(B0, 0, 0); PG8_SCHED; PG8_LDA(At, 0, 0); PG8_STAGE(PG8_SA(1, 1), a1 + hstep, voffA);
            PG8_WAIT_L(8); PG8_BAR; PG8_WAIT_L(0); PG8_MMA(0, 0, At, B0); PG8_BAR; PG8_SCHED;
            PG8_LDB(B1, 0, 1); PG8_STAGE(PG8_SB(0, 0), b2, voffB);
            PG8_BAR; PG8_WAIT_L(0); PG8_MMA(0, 1, At, B1); PG8_BAR;
            PG8_LDA(At, 0, 1); PG8_STAGE(PG8_SA(0, 0), a2, voffA);
            PG8_BAR; PG8_WAIT_L(0); PG8_MMA(1, 0, At, B0); PG8_BAR; PG8_SCHED;
            PG8_STAGE(PG8_SB(0, 1), b2 + hstep, voffB);
            PG8_WAIT_V(6); PG8_BAR; PG8_MMA(1, 1, At, B1); PG8_BAR;
            PG8_LDB(B0, 1, 0); PG8_SCHED; PG8_LDA(At, 1, 0); PG8_STAGE(PG8_SA(0, 1), a2 + hstep, voffA);
            PG8_WAIT_L(8); PG8_BAR; PG8_WAIT_L(0); PG8_MMA(0, 0, At, B0); PG8_BAR; PG8_SCHED;
            PG8_LDB(B1, 1, 1); PG8_STAGE(PG8_SB(1, 0), b3, voffB);
            PG8_BAR; PG8_WAIT_L(0); PG8_MMA(0, 1, At, B1); PG8_BAR;
            PG8_LDA(At, 1, 1); PG8_STAGE(PG8_SA(1, 0), a3, voffA);
            PG8_BAR; PG8_WAIT_L(0); PG8_MMA(1, 0, At, B0); PG8_BAR; PG8_SCHED;
            PG8_STAGE(PG8_SB(1, 1), b3 + hstep, voffB);
            PG8_WAIT_V(6); PG8_BAR; PG8_MMA(1, 1, At, B1); PG8_BAR;
            }
        }
        if constexpr (ALIGN_EPI) { if (wr == 0) PG8_BAR; }
        if constexpr (!Epi::AFTER_DRAIN) { E(acc, cur, wr, wc, fr, fq); S.done(cur); }
        if (!has_next) break;
#pragma unroll
        for (int a = 0; a < 2; ++a)
#pragma unroll
            for (int b = 0; b < 2; ++b)
#pragma unroll
                for (int m = 0; m < 4; ++m)
#pragma unroll
                    for (int n = 0; n < 2; ++n) acc[a][b][m][n] = (f32x4){0.f, 0.f, 0.f, 0.f};
        cur = nxt; cA = nA; cB = nB; ++ui;
        if constexpr (ALIGN_EPI) { if (wr == 1) PG8_BAR; }
    }
    PG8_WAIT_V(0);
    if constexpr (!ALIGN_EPI) { if (wr == 0) PG8_BAR; }
    PG8_BAR;
    if constexpr (Epi::AFTER_DRAIN) { E.fused(acc, cur, wr, wc, fr, fq, lds, wid, lane); S.done(cur); }
#undef PG8_SA
#undef PG8_SB
#undef PG8_STAGE
#undef PG8_LDA
#undef PG8_LDB
#undef PG8_MMA
#undef PG8_WAIT_V
#undef PG8_WAIT_L
#undef PG8_BAR
#undef PG8_SCHED
}
}
namespace pg8 {
struct SUnit { int kind, pm, pn; };
struct SGeo { const char* A; const char* B; unsigned ld, hstep; int nt; };

template <class Sched>
__device__ __forceinline__ void gemm_stream(PG8_LAS unsigned char* lds, Sched& S) {
    int tid_ = threadIdx.x; asm volatile("" : "+v"(tid_));
    const int tid = tid_, wid = __builtin_amdgcn_readfirstlane(tid >> 6), lane = tid & 63, wr = wid >> 2, wc = wid & 3, fr = lane & 15, fq = lane >> 4;
    unsigned RA2[2], RB2[2], C2[2];
#pragma unroll
    for (int i = 0; i < 2; ++i) { int R, C; stage_rc(tid * 16 + i * 8192, R, C); const int Rb = (R & ~31) + perm32(R & 31); RA2[i] = 2u * R; RB2[i] = 2u * Rb; C2[i] = 2u * C; }
    const size_t kstep = (size_t)(BK * 2);
    const unsigned ldsw = (unsigned)wid * 1024u;
    const int aoff = lds_byte(wr * 64 + fr, fq * 8), boff = lds_byte(wc * 32 + fr, fq * 8);
#define PG8_SA(b, h) (((b) * 2 + (h)) * HTB)
#define PG8_SB(b, h) ((4 + (b) * 2 + (h)) * HTB)
#ifndef STA_AUX
#define STA_AUX 0
#endif
#define PG8_STA(bufoff, gbase, ld_) do { _Pragma("unroll") for (int _i = 0; _i < 2; ++_i) \
        __builtin_amdgcn_global_load_lds((const unsigned*)((const char*)(gbase) + (RA2[_i] * (ld_) + C2[_i])), (PG8_LAS unsigned*)(lds + (bufoff) + ldsw + _i * 8192), 16, 0, STA_AUX); } while (0)
#define PG8_STB(bufoff, gbase, ld_) do { _Pragma("unroll") for (int _i = 0; _i < 2; ++_i) \
        __builtin_amdgcn_global_load_lds((const unsigned*)((const char*)(gbase) + (RB2[_i] * (ld_) + C2[_i])), (PG8_LAS unsigned*)(lds + (bufoff) + ldsw + _i * 8192), 16, 0, 0); } while (0)
#define PG8_LDA(dst, b, h) do { _Pragma("unroll") for (int m = 0; m < 4; ++m) _Pragma("unroll") for (int k = 0; k < 2; ++k) dst[m][k] = *(const PG8_LAS bf16x8*)(lds + PG8_SA(b, h) + aoff + m * 2048 + k * 1024); } while (0)
#define PG8_LDB(dst, b, h) do { _Pragma("unroll") for (int n = 0; n < 2; ++n) _Pragma("unroll") for (int k = 0; k < 2; ++k) dst[n][k] = *(const PG8_LAS bf16x8*)(lds + PG8_SB(b, h) + boff + n * 2048 + k * 1024); } while (0)
#define PG8_MMA(ai, bj, At, Bt) do { __builtin_amdgcn_s_setprio(1); _Pragma("unroll") for (int m = 0; m < 4; ++m) _Pragma("unroll") for (int n = 0; n < 2; ++n) _Pragma("unroll") for (int k = 0; k < 2; ++k) \
        acc[ai][bj][m][n] = __builtin_amdgcn_mfma_f32_16x16x32_bf16(Bt[n][k], At[m][k], acc[ai][bj][m][n], 0, 0, 0); __builtin_amdgcn_s_setprio(0); } while (0)
#define PG8_WAIT_V(n) asm volatile("s_waitcnt vmcnt(" #n ")" ::: "memory")
#define PG8_WAIT_L(n) asm volatile("s_waitcnt lgkmcnt(" #n ")" ::: "memory")
#define PG8_BAR __builtin_amdgcn_s_barrier()
#define PG8_SCHED __builtin_amdgcn_sched_barrier(0)
    SUnit cur, nxt;
    if (!S.first(cur, wid, lane)) return;
    f32x4 acc[2][2][4][2];
#pragma unroll
    for (int a = 0; a < 2; ++a)
#pragma unroll
        for (int b = 0; b < 2; ++b)
#pragma unroll
            for (int m = 0; m < 4; ++m)
#pragma unroll
                for (int n = 0; n < 2; ++n) acc[a][b][m][n] = (f32x4){0.f, 0.f, 0.f, 0.f};
    bf16x8 At[4][2], B0[2][2], B1[2][2];
    for (;;) {
        S.wait_ready(cur, lane);
        SGeo gc = S.geo(cur);
        PG8_STB(PG8_SB(0, 0), gc.B, gc.ld); PG8_STB(PG8_SB(0, 1), gc.B + gc.hstep, gc.ld); PG8_STA(PG8_SA(0, 0), gc.A, gc.ld); PG8_STA(PG8_SA(0, 1), gc.A + gc.hstep, gc.ld);
        if (wr == 1) PG8_BAR;
        PG8_WAIT_V(2); PG8_BAR;
        PG8_STB(PG8_SB(1, 0), gc.B + kstep, gc.ld); PG8_STA(PG8_SA(1, 0), gc.A + kstep, gc.ld); PG8_STB(PG8_SB(1, 1), gc.B + gc.hstep + kstep, gc.ld);
        PG8_WAIT_V(6); PG8_BAR;
        bool finished = false;
        for (;;) {
            bool has_next = false, ready = false; SGeo gn = gc;
            const int nt = gc.nt, tprobe = nt >= 6 ? nt - 4 : 0;
            for (int t = 0; t < nt; t += 2) {
                const bool last = (t == nt - 2);
                if (t == tprobe) S.probe(cur, wid, lane);
                if (last) { has_next = S.peek(cur, nxt, ready); if (has_next && ready) gn = S.geo(nxt); }
                const char* a1 = gc.A + (size_t)(t + 1) * kstep;
                const char* a2 = last ? gn.A : gc.A + (size_t)(t + 2) * kstep; const char* b2 = last ? gn.B : gc.B + (size_t)(t + 2) * kstep;
                const unsigned ld2 = last ? gn.ld : gc.ld, hs2 = last ? gn.hstep : gc.hstep;
                const char* a3 = a2 + kstep; const char* b3 = b2 + kstep;
                PG8_LDB(B0, 0, 0); PG8_LDB(B1, 0, 1); PG8_SCHED; PG8_LDA(At, 0, 0); PG8_STA(PG8_SA(1, 1), a1 + gc.hstep, gc.ld);
                PG8_WAIT_V(8); PG8_WAIT_L(0); PG8_BAR; PG8_MMA(0, 0, At, B0); PG8_MMA(0, 1, At, B1); PG8_BAR; PG8_SCHED;
                PG8_LDA(At, 0, 1); PG8_STB(PG8_SB(0, 0), b2, ld2); PG8_STB(PG8_SB(0, 1), b2 + hs2, ld2); PG8_STA(PG8_SA(0, 0), a2, ld2);
                PG8_WAIT_V(8); PG8_WAIT_L(0); PG8_BAR; PG8_MMA(1, 0, At, B0); PG8_MMA(1, 1, At, B1); PG8_BAR; PG8_SCHED;
                PG8_LDB(B0, 1, 0); PG8_LDB(B1, 1, 1); PG8_SCHED; PG8_LDA(At, 1, 0); PG8_STA(PG8_SA(0, 1), a2 + hs2, ld2);
                PG8_WAIT_V(8); PG8_WAIT_L(0); PG8_BAR; PG8_MMA(0, 0, At, B0); PG8_MMA(0, 1, At, B1); PG8_BAR; PG8_SCHED;
                PG8_LDA(At, 1, 1); PG8_STB(PG8_SB(1, 0), b3, ld2); PG8_STB(PG8_SB(1, 1), b3 + hs2, ld2); PG8_STA(PG8_SA(1, 0), a3, ld2);
                PG8_WAIT_V(8); PG8_WAIT_L(0); PG8_BAR; PG8_MMA(1, 0, At, B0); PG8_MMA(1, 1, At, B1); PG8_BAR; PG8_SCHED;
            }
            if (wr == 0) PG8_BAR;
            S.epilogue(acc, cur, has_next, nxt, wr, wc, fr, fq, wid, lane);
            if (!has_next) { finished = true; break; }
#pragma unroll
            for (int a = 0; a < 2; ++a)
#pragma unroll
                for (int b = 0; b < 2; ++b)
#pragma unroll
                    for (int m = 0; m < 4; ++m)
#pragma unroll
                        for (int n = 0; n < 2; ++n) acc[a][b][m][n] = (f32x4){0.f, 0.f, 0.f, 0.f};
            cur = nxt;
            if (!ready) break;
            gc = gn;
            if (wr == 1) PG8_BAR;
        }
        PG8_WAIT_V(0); PG8_BAR;
        if (finished) break;
    }
#undef PG8_SA
#undef PG8_SB
#undef PG8_STA
#undef PG8_STB
#undef PG8_LDA
#undef PG8_LDB
#undef PG8_MMA
#undef PG8_WAIT_V
#undef PG8_WAIT_L
#undef PG8_BAR
#undef PG8_SCHED
}
}

#define GAS __attribute__((address_space(1)))
#define LAS __attribute__((address_space(3)))
typedef unsigned short bf16;
typedef unsigned v4u __attribute__((ext_vector_type(4)));
typedef float f32x4 __attribute__((ext_vector_type(4)));
typedef short bf16x8 __attribute__((ext_vector_type(8)));
typedef GAS unsigned gu32;
typedef GAS unsigned long long gu64;
#define RLX_AGENT __ATOMIC_RELAXED, __HIP_MEMORY_SCOPE_AGENT
#define LDS_WAIT() asm volatile("s_waitcnt lgkmcnt(0)" ::: "memory")
#define VM_WAIT() asm volatile("s_waitcnt vmcnt(0)" ::: "memory")
__device__ __forceinline__ unsigned long long rt() { return __builtin_amdgcn_s_memrealtime(); }
__device__ __forceinline__ unsigned f2bf(float f) { unsigned u = __builtin_bit_cast(unsigned, f); return (u + 0x7fffu + ((u >> 16) & 1u)) >> 16; }
__device__ __forceinline__ unsigned pk2(float lo, float hi) { return f2bf(lo) | (f2bf(hi) << 16); }

#define XB_TMO      128
#define XB_XCNT(j)  (256  + 64 * (j))
#define XB_XSUB(j)  (1280 + 64 * (j))
#define XB_XGEN(j)  (2304 + 64 * (j))
#define XB_TOP      3328
#define XB_TOPGEN   3392
#define XCD_BAR_WORDS 3456
#define XB_SPIN_CAP (1u << 18)

__device__ __forceinline__ unsigned xb_ld(unsigned* p)              { return __hip_atomic_load(p, __ATOMIC_RELAXED, __HIP_MEMORY_SCOPE_AGENT); }
__device__ __forceinline__ unsigned xb_add(unsigned* p, unsigned v) { return __hip_atomic_fetch_add(p, v, __ATOMIC_RELAXED, __HIP_MEMORY_SCOPE_AGENT); }
__device__ __forceinline__ unsigned xb_xcc_id() { return (unsigned)__builtin_amdgcn_s_getreg((3 << 11) | 20) & 0xFu; }
#define XB_SPIN(cond, bar) do { unsigned _sp = 0; while (cond) { __builtin_amdgcn_s_sleep(1); \
    if ((++_sp & 255u) == 0u) { if (xb_ld(&(bar)[XB_TMO])) break; if (_sp > XB_SPIN_CAP) { atomicAdd(&(bar)[XB_TMO], 1u); break; } } } } while (0)

struct XcdBarrier {
    unsigned* bar; unsigned x;
    volatile LAS unsigned* st;
};

__device__ __forceinline__ XcdBarrier xcd_barrier_post(unsigned* bar, volatile LAS unsigned* st) {
    XcdBarrier b; b.bar = bar; b.x = xb_xcc_id(); b.st = st;
    if (threadIdx.x == 0) (void)xb_add(&bar[XB_XCNT(b.x)], 1u);
    return b;
}
__device__ __forceinline__ void xcd_barrier_complete(unsigned* bar, unsigned x, unsigned& nloc, unsigned& nx) {
    const unsigned G = gridDim.x * gridDim.y * gridDim.z;
    unsigned sum, cnt, mine, sp = 0u;
    for (;;) {
        sum = 0u; cnt = 0u; mine = 0u;
#pragma unroll
        for (unsigned j = 0; j < 16; ++j) { const unsigned c = xb_ld(&bar[XB_XCNT(j)]); sum += c; cnt += (c > 0u) ? 1u : 0u; mine = (j == x) ? c : mine; }
        if (sum == G) break;
        __builtin_amdgcn_s_sleep(1);
        if ((++sp & 255u) == 0u) { if (xb_ld(&bar[XB_TMO])) break; if (sp > XB_SPIN_CAP) { atomicAdd(&bar[XB_TMO], 1u); break; } }
    }
    nloc = mine > 0u ? mine : 1u; nx = cnt > 0u ? cnt : 1u;
}

__device__ __forceinline__ void xcd_barrier(const XcdBarrier& b) {
    asm volatile("s_waitcnt vmcnt(0)" ::: "memory");
    __syncthreads();
    if (threadIdx.x == 0) {
        unsigned* bar = b.bar;
        __builtin_amdgcn_s_waitcnt(0);
        unsigned nloc = b.st[0], nx = b.st[1];
        if (nloc == 0u) { xcd_barrier_complete(bar, b.x, nloc, nx); b.st[0] = nloc; b.st[1] = nx; }
        const unsigned old = xb_add(&bar[XB_XSUB(b.x)], 1u);
        const unsigned gen = old / nloc;
        if (old + 1u == (gen + 1u) * nloc) {
            __builtin_amdgcn_fence(__ATOMIC_RELEASE, "agent");
            asm volatile("s_waitcnt vmcnt(0)" ::: "memory");
            const unsigned og = xb_add(&bar[XB_TOP], 1u);
            const unsigned tg = og / nx;
            if (og + 1u == (tg + 1u) * nx) xb_add(&bar[XB_TOPGEN], 1u);
            else XB_SPIN(xb_ld(&bar[XB_TOPGEN]) == tg, bar);
            __builtin_amdgcn_fence(__ATOMIC_ACQUIRE, "agent");
            xb_add(&bar[XB_XGEN(b.x)], 1u);
            asm volatile("s_waitcnt vmcnt(0)" ::: "memory");
        } else {
            XB_SPIN(xb_ld(&bar[XB_XGEN(b.x)]) == gen, bar);
            __builtin_amdgcn_fence(__ATOMIC_ACQUIRE, "agent");
            asm volatile("s_waitcnt vmcnt(0)" ::: "memory");
        }
    }
    __syncthreads();
}

constexpr int DM = 1024, MP = 16384, MS = 2048, M = MP + MS;
constexpr int NIN = 3584, FF = 2816, NGU = 2 * FF, PLE = 256, PAST = 2048;
constexpr int NCP = 256, NCS = 32, NCH = NCP + NCS;
constexpr int RH = 4, RD = 128, AH = 8, AD = 64;
constexpr float EPS = 1e-6f, LOG2E = 1.4426950408889634f;
constexpr int ZQ = 0, ZK = 512, ZV = 1024, ZG = 1536, ZQA = 2048, ZKA = 2560, ZVA = 3072;
constexpr size_t OFF_Y = 0, OFF_RP = (size_t)M * DM, OFF_KP = OFF_RP + 65536, OFF_VP = OFF_KP + 262144, OFF_RS = OFF_VP + 262144,
                 OFF_KS = OFF_RS + 2097152, OFF_VS = OFF_KS + 1048576, OUT_TOTAL = OFF_VS + 1048576;
static_assert(OUT_TOTAL == 23658496, "output size");

constexpr size_t MiB = 1u << 20;
constexpr size_t WS_CTL = 0, CTL_ZERO_BYTES = 1 * MiB;
constexpr size_t WS_RSTDX = 1 * MiB, WS_ST1 = 2 * MiB, WS_ST2 = 4 * MiB;
constexpr size_t WS_WIN = 6 * MiB, WS_WOUT = 13 * MiB, WS_WGU = 15 * MiB, WS_WDN = 26 * MiB, WS_WPG = 32 * MiB, WS_WPP = 34 * MiB;
constexpr size_t WS_COS = 35 * MiB, WS_SIN = 39 * MiB, WS_PB = 43 * MiB;
constexpr size_t WS_A = 52 * MiB;
constexpr size_t WS_Z = 88 * MiB;
constexpr size_t WS_UF = 214 * MiB;
constexpr size_t WS_RB = 230 * MiB;
constexpr size_t WS_HB = 88 * MiB;
constexpr size_t WS_T = 124 * MiB;
constexpr size_t WS_END = 246 * MiB;
static_assert(WS_T + (size_t)M * FF * 2 <= WS_END && WS_Z + (size_t)M * NIN * 2 <= WS_UF && WS_HB + (size_t)M * DM * 2 <= WS_T, "ws map");

constexpr int CW_TMO = 0, CW_CODE = 1, CW_BAR = 4096;

using pg8::u32x4; using pg8::bf16_t; using pg8::Unit;
__device__ __forceinline__ u32x4 pack8(f32x4 a, f32x4 b) { u32x4 w; w.x = pg8::cvt_pk_bf16(a[0], a[1]); w.y = pg8::cvt_pk_bf16(a[2], a[3]); w.z = pg8::cvt_pk_bf16(b[0], b[1]); w.w = pg8::cvt_pk_bf16(b[2], b[3]); return w; }
__device__ __forceinline__ float lg2_gamma(int h) { return log2f(1.0f - exp2f(-5.0f - (float)h)); }
__device__ __forceinline__ float bf2f(unsigned short b) { return __uint_as_float((unsigned)b << 16); }
__device__ __forceinline__ float sum4(f32x4 a) { return (a[0] + a[1]) + (a[2] + a[3]); }
__device__ __forceinline__ float rstd16(const float* st, int r) {
    const f32x4* p = (const f32x4*)(st + (size_t)r * 16); const f32x4 a = p[0], b = p[1], c = p[2], d = p[3];
    return rsqrtf(((sum4(a) + sum4(b)) + (sum4(c) + sum4(d))) * (1.0f / DM) + EPS);
}
__device__ __forceinline__ f32x4 sigmoid4(f32x4 g) { f32x4 o;
#pragma unroll
    for (int i = 0; i < 4; ++i) o[i] = __builtin_amdgcn_rcpf(1.0f + __builtin_amdgcn_exp2f(-g[i] * LOG2E));
    return o; }

struct EpiIn {
    static constexpr bool PERM = true, AFTER_DRAIN = false;
    bf16_t* Z; const float* rstd; const float* cosT; const float* sinT; const float* gq; const float* gk; float* dout;
    __device__ __forceinline__ void operator()(const f32x4 (&acc)[2][2][4][2], const Unit& u, int wr, int wc, int fr, int fq) const {
        const int pn = u.pn; const int rbase = u.pm * 256 + wr * 64 + fr;
        if (pn < 4) {
            const int sec = (pn >> 1) * 512, head = 2 * (pn & 1) + (wc >> 1), j0 = (wc & 1) * 32 + fq * 8;
            const float osc = (pn >= 2) ? 0.08838834764831845f : 1.0f; const float lgs = (pn >= 2) ? -lg2_gamma(head) : lg2_gamma(head);
#pragma unroll
            for (int ai = 0; ai < 2; ++ai)
#pragma unroll
                for (int m = 0; m < 4; ++m) {
                    const int r = rbase + ai * 128 + m * 16; const int pos = r < MP ? r : PAST + ((r - MP) & 63); const int nloc = r < MP ? (r & 255) : ((r - MP) & 63);
                    const float rs = rstd[r] * osc * exp2f((float)nloc * lgs);
                    const f32x4 c0 = *(const f32x4*)(cosT + (size_t)pos * 64 + j0), c1 = *(const f32x4*)(cosT + (size_t)pos * 64 + j0 + 4);
                    const f32x4 s0 = *(const f32x4*)(sinT + (size_t)pos * 64 + j0), s1 = *(const f32x4*)(sinT + (size_t)pos * 64 + j0 + 4);
                    const f32x4 x1a = acc[ai][0][m][0] * rs, x1b = acc[ai][0][m][1] * rs, x2a = acc[ai][1][m][0] * rs, x2b = acc[ai][1][m][1] * rs;
                    const f32x4 o1a = x1a * c0 - x2a * s0, o1b = x1b * c1 - x2b * s1, o2a = x1a * s0 + x2a * c0, o2b = x1b * s1 + x2b * c1;
                    bf16_t* dst = Z + (size_t)r * NIN + sec + head * 128 + j0;
                    *(u32x4*)dst = pack8(o1a, o1b); *(u32x4*)(dst + 64) = pack8(o2a, o2b);
                }
        } else if (pn < 8 || pn >= 12) {
#pragma unroll
            for (int ai = 0; ai < 2; ++ai)
#pragma unroll
                for (int m = 0; m < 4; ++m) {
                    const int r = rbase + ai * 128 + m * 16; const float rs = rstd[r];
#pragma unroll
                    for (int bj = 0; bj < 2; ++bj) {
                        const f32x4 v0 = acc[ai][bj][m][0] * rs, v1 = acc[ai][bj][m][1] * rs; const int t = bj * 128 + wc * 32 + fq * 8;
                        *(u32x4*)(Z + (size_t)r * NIN + pn * 256 + t) = pack8(v0, v1);
                        if (pn >= 12) { const int c5 = (pn - 12) * 256 + t;
                            if (r >= MP) { float* o = dout + OFF_VS + (size_t)(r - MP) * 512 + c5; *(f32x4*)o = v0; *(f32x4*)(o + 4) = v1; }
                            else if (r >= MP - 512) { float* o = dout + OFF_VP + (size_t)(r - (MP - 512)) * 512 + c5; *(f32x4*)o = v0; *(f32x4*)(o + 4) = v1; } }
                    }
                }
        } else {
            const float* g = pn < 10 ? gq : gk; f32x4 gv[2][2];
#pragma unroll
            for (int bj = 0; bj < 2; ++bj)
#pragma unroll
                for (int n = 0; n < 2; ++n) gv[bj][n] = *(const f32x4*)(g + bj * 32 + fq * 8 + 4 * n);
#pragma unroll
            for (int ai = 0; ai < 2; ++ai)
#pragma unroll
                for (int m = 0; m < 4; ++m) {
                    const int r = rbase + ai * 128 + m * 16; const float rs = rstd[r]; f32x4 v[2][2]; float ss = 0.f;
#pragma unroll
                    for (int bj = 0; bj < 2; ++bj)
#pragma unroll
                        for (int n = 0; n < 2; ++n) { v[bj][n] = acc[ai][bj][m][n] * rs; ss += sum4(v[bj][n] * v[bj][n]); }
                    ss += __shfl_xor(ss, 16); ss += __shfl_xor(ss, 32);
                    const float inv = rsqrtf(ss * (1.0f / 64.0f) + EPS) * (pn < 10 ? 0.125f * LOG2E : 1.0f);
#pragma unroll
                    for (int bj = 0; bj < 2; ++bj) {
                        const f32x4 o0 = v[bj][0] * inv * gv[bj][0], o1 = v[bj][1] * inv * gv[bj][1]; const int e = wc * 64 + bj * 32 + fq * 8;
                        *(u32x4*)(Z + (size_t)r * NIN + pn * 256 + e) = pack8(o0, o1);
                        if (pn >= 10) { const int c5 = (pn - 10) * 256 + e;
                            if (r >= MP) { float* o = dout + OFF_KS + (size_t)(r - MP) * 512 + c5; *(f32x4*)o = o0; *(f32x4*)(o + 4) = o1; }
                            else if (r >= MP - 512) { float* o = dout + OFF_KP + (size_t)(r - (MP - 512)) * 512 + c5; *(f32x4*)o = o0; *(f32x4*)(o + 4) = o1; } }
                    }
                }
        }
    }
};
struct EpiRes {
    static constexpr bool PERM = true, AFTER_DRAIN = false;
    const float* res_p; const float* res_s; float* out; bf16_t* hb; float* stats;
    __device__ __forceinline__ void operator()(const f32x4 (&acc)[2][2][4][2], const Unit& u, int wr, int wc, int fr, int fq) const {
        const int rbase = u.pm * 256 + wr * 64 + fr;
#pragma unroll
        for (int ai = 0; ai < 2; ++ai)
#pragma unroll
            for (int m = 0; m < 4; ++m) {
                const int r = rbase + ai * 128 + m * 16; const float* rp = r < MP ? res_p + (size_t)r * DM : res_s + (size_t)(r - MP) * DM; float ss = 0.f;
#pragma unroll
                for (int bj = 0; bj < 2; ++bj) {
                    const int c0 = u.pn * 256 + bj * 128 + wc * 32 + fq * 8;
                    const f32x4 h0 = *(const f32x4*)(rp + c0) + acc[ai][bj][m][0], h1 = *(const f32x4*)(rp + c0 + 4) + acc[ai][bj][m][1];
                    float* o = out + (size_t)r * DM + c0; *(f32x4*)o = h0; *(f32x4*)(o + 4) = h1;
                    *(u32x4*)(hb + (size_t)r * DM + c0) = pack8(h0, h1);
                    ss += sum4(h0 * h0) + sum4(h1 * h1);
                }
                ss += __shfl_xor(ss, 16); ss += __shfl_xor(ss, 32);
                if (fq == 0) stats[(size_t)r * 16 + u.pn * 4 + wc] = ss;
            }
    }
};
struct EpiGU {
    static constexpr bool PERM = true, AFTER_DRAIN = false;
    const float* stats; bf16_t* T;
    __device__ __forceinline__ void operator()(const f32x4 (&acc)[2][2][4][2], const Unit& u, int wr, int wc, int fr, int fq) const {
        const int rbase = u.pm * 256 + wr * 64 + fr;
#pragma unroll
        for (int ai = 0; ai < 2; ++ai)
#pragma unroll
            for (int m = 0; m < 4; ++m) {
                const int r = rbase + ai * 128 + m * 16; const float rs = rstd16(stats, r);
                const f32x4 g0 = acc[ai][0][m][0] * rs, g1 = acc[ai][0][m][1] * rs, u0 = acc[ai][1][m][0] * rs, u1 = acc[ai][1][m][1] * rs;
                const f32x4 t0 = g0 * sigmoid4(g0) * u0, t1 = g1 * sigmoid4(g1) * u1;
                *(u32x4*)(T + (size_t)r * FF + u.pn * 128 + wc * 32 + fq * 8) = pack8(t0, t1);
            }
    }
};
struct EpiPP {
    static constexpr bool PERM = true, AFTER_DRAIN = false;
    bf16_t* O;
    __device__ __forceinline__ void operator()(const f32x4 (&acc)[2][2][4][2], const Unit& u, int wr, int wc, int fr, int fq) const {
        const unsigned boff = (unsigned)((u.pm * 256 + wr * 64 + fr) * DM + u.pn * 256 + wc * 32 + fq * 8) * 2u;
#pragma unroll
        for (int ai = 0; ai < 2; ++ai)
#pragma unroll
            for (int m = 0; m < 4; ++m) {
#pragma unroll
                for (int bj = 0; bj < 2; ++bj) *(u32x4*)((char*)O + (boff + (unsigned)((ai * 128 + m * 16) * DM + bj * 128) * 2u)) = pack8(acc[ai][bj][m][0], acc[ai][bj][m][1]);
                asm volatile("" ::: "memory"); }
    }
};
struct EpiPG {
    static constexpr bool PERM = true, AFTER_DRAIN = false;
    const float* stats; const bf16_t* PP; float* y;
    __device__ __forceinline__ void operator()(const f32x4 (&acc)[2][2][4][2], const Unit& u, int wr, int wc, int fr, int fq) const {
        const int rbase = u.pm * 256 + wr * 64 + fr;
#pragma unroll
        for (int ai = 0; ai < 2; ++ai)
#pragma unroll
            for (int m = 0; m < 4; ++m) {
                const int r = rbase + ai * 128 + m * 16; const float rs = rstd16(stats, r);
#pragma unroll
                for (int bj = 0; bj < 2; ++bj) {
                    const int c0 = u.pn * 256 + bj * 128 + wc * 32 + fq * 8; float* o = y + (size_t)r * DM + c0;
                    const u32x4 pw = *(const u32x4*)(PP + (size_t)r * DM + c0);
                    const f32x4 p0 = {__uint_as_float(pw.x << 16), __uint_as_float(pw.x & 0xffff0000u), __uint_as_float(pw.y << 16), __uint_as_float(pw.y & 0xffff0000u)};
                    const f32x4 p1 = {__uint_as_float(pw.z << 16), __uint_as_float(pw.z & 0xffff0000u), __uint_as_float(pw.w << 16), __uint_as_float(pw.w & 0xffff0000u)};
                    const f32x4 y0 = *(const f32x4*)o + p0 * sigmoid4(acc[ai][bj][m][0] * rs), y1 = *(const f32x4*)(o + 4) + p1 * sigmoid4(acc[ai][bj][m][1] * rs);
                    *(f32x4*)o = y0; *(f32x4*)(o + 4) = y1;
                }
            }
    }
};

constexpr int NWAVES = 8, NTHR = 512;
#ifndef MK_ONE_LAUNCH
#define MK_ONE_LAUNCH 1
#endif
constexpr int NPH = 6;
constexpr int RING_OFF = 0, RING_BYTES = 131072, LDSCTL_OFF = RING_BYTES, MISC_OFF = LDSCTL_OFF + 320, LDS_BYTES = 147456;
typedef short s16x8 __attribute__((ext_vector_type(8)));
typedef short s16x4 __attribute__((ext_vector_type(4)));
typedef float f32x16 __attribute__((ext_vector_type(16)));
typedef unsigned u32x2v __attribute__((ext_vector_type(2)));

struct Frame {
    LAS unsigned char* lds; volatile LAS unsigned* MISC; gu32* ctl;
    int tid, lane, wave, vcu, G;
};
__device__ __forceinline__ float wave_sum(float v) {
#pragma unroll
    for (int o = 1; o < 64; o <<= 1) v += __shfl_xor(v, o);
    return v;
}
__device__ __forceinline__ int crow(int r, int hi) { return (r & 3) + 8 * (r >> 2) + 4 * hi; }
__device__ __forceinline__ s16x8 frag(const LAS bf16* X, int ld, int row0, int k0, int lane) { return *(const LAS s16x8*)(X + (row0 + (lane & 31)) * ld + k0 + 8 * (lane >> 5)); }
#define MFMA32(a, b, c) __builtin_amdgcn_mfma_f32_32x32x16_bf16((a), (b), (c), 0, 0, 0)

constexpr int NQ = 306, TK_NONE = 0xffff;
constexpr int CW_TKT = 2048;
constexpr int CW_DEP = 32768;
constexpr size_t WS_TAB = 1 * MiB + 512 * 1024;
__device__ __forceinline__ unsigned enc_unit(int kind, int q, int pn) { return (unsigned)((kind << 12) | (q << 5) | pn); }
__device__ __forceinline__ void build_ticket_table(unsigned short* tab) {
    int o = 0;
    for (int pn = 0; pn < 4; ++pn) for (int q = 0; q < 9; ++q) tab[o++] = (unsigned short)enc_unit(0, q, pn);
    for (int pn = 0; pn < 22; ++pn) tab[o++] = (unsigned short)enc_unit(1, 0, pn);
    int body = 0;
    for (int g = 0; g < 2; ++g) for (int pn = 0; pn < 22; ++pn) for (int j = 0; j < 4; ++j) {
        if (body == 40) for (int c = 0; c < 4; ++c) tab[o++] = (unsigned short)enc_unit(2, 0, c);
        if (body == 126) for (int c = 0; c < 4; ++c) tab[o++] = (unsigned short)enc_unit(3, 0, c);
        tab[o++] = (unsigned short)enc_unit(1, 1 + 4 * g + j, pn); ++body; }
    for (int pn = 0; pn < 4; ++pn) for (int q = 1; q < 9; ++q) tab[o++] = (unsigned short)enc_unit(2, q, pn);
    for (int pn = 0; pn < 4; ++pn) for (int q = 1; q < 9; ++q) tab[o++] = (unsigned short)enc_unit(3, q, pn);
}
__device__ __forceinline__ void tr_item(const float* W, int ldw, int K, int k0, int c0, bf16* WT, int d0, const float* g, LAS float* scr, int lane) {
#pragma unroll 8
    for (int i = 0; i < 32; ++i) { const int kk = 2 * i + (lane >> 5); float v = W[(size_t)(k0 + kk) * ldw + c0 + (lane & 31)]; if (g) v *= g[k0 + kk]; scr[kk * 33 + (lane & 31)] = v; }
    LDS_WAIT(); asm volatile("" ::: "memory");
    const int c = lane & 7;
#pragma unroll
    for (int j = 0; j < 4; ++j) { const int n = (lane >> 3) + 8 * j; const LAS float* s = scr + (8 * c) * 33 + n;
        v4u o; o.x = pk2(s[0 * 33], s[1 * 33]); o.y = pk2(s[2 * 33], s[3 * 33]); o.z = pk2(s[4 * 33], s[5 * 33]); o.w = pk2(s[6 * 33], s[7 * 33]);
        *(GAS v4u*)(WT + (size_t)(d0 + n) * K + k0 + 8 * c) = o; }
    LDS_WAIT(); asm volatile("" ::: "memory");
}
__device__ __forceinline__ int sigma_in(int np) {
    const int pn = np >> 8, t = np & 255;
    if (pn < 4) { const int base = (pn >> 1) * 512 + (pn & 1) * 256, tt = t & 127; return base + (tt >> 6) * 128 + (t >> 7) * 64 + (tt & 63); }
    if (pn >= 8 && pn < 12) return pn * 256 + ((t >> 5) & 3) * 64 + (t >> 7) * 32 + (t & 31);
    return np;
}
struct Ptrs {
    const float *xp, *xs, *ck, *cv, *sr, *pp, *ps, *g_mix, *w_in, *g_ro, *g_q, *g_k, *rel_bias, *w_out, *g_ffn, *w_g, *w_u, *w_d, *g_ple, *w_pg, *w_pp;
    float* out; unsigned char* ws;
};
__device__ __forceinline__ void p0_prologue(Frame& F, const Ptrs& P) {
    LAS float* scr = (LAS float*)(F.lds + RING_OFF + F.wave * 16384);
    const int gw = F.vcu * NWAVES + F.wave, NGW = F.G * NWAVES;
    bf16* Wt_in = (bf16*)(P.ws + WS_WIN); bf16* Wt_out = (bf16*)(P.ws + WS_WOUT); bf16* Wt_gu = (bf16*)(P.ws + WS_WGU);
    bf16* Wt_dn = (bf16*)(P.ws + WS_WDN); bf16* Wt_pg = (bf16*)(P.ws + WS_WPG); bf16* Wt_pp = (bf16*)(P.ws + WS_WPP);
    constexpr int I_IN = 16 * (NIN / 32), I_OUT = 16 * 32, I_GU = 16 * (NGU / 32), I_DN = (FF / 64) * 32, I_PG = 16 * 32, I_PP = 4 * 32;
    constexpr int NITEMS = I_IN + I_OUT + I_GU + I_DN + I_PG + I_PP;
    for (int it = gw; it < NITEMS; it += NGW) {
        int r = it;
        if (r < I_IN) { const int nb = r % (NIN / 32), kb = r / (NIN / 32); tr_item(P.w_in, NIN, DM, 64 * kb, sigma_in(32 * nb), Wt_in, 32 * nb, P.g_mix, scr, F.lane); continue; } r -= I_IN;
        if (r < I_OUT) { const int nb = r % 32, kb = r / 32; tr_item(P.w_out, DM, DM, 64 * kb, 32 * nb, Wt_out, 32 * nb, nullptr, scr, F.lane); continue; } r -= I_OUT;
        if (r < I_GU) { const int nb = r % (NGU / 32), kb = r / (NGU / 32); const int np = 32 * nb, pn = np >> 8, t = np & 255;
            tr_item(t < 128 ? P.w_g : P.w_u, FF, DM, 64 * kb, 128 * pn + (t & 127), Wt_gu, np, P.g_ffn, scr, F.lane); continue; } r -= I_GU;
        if (r < I_DN) { const int nb = r % 32, kb = r / 32; tr_item(P.w_d, DM, FF, 64 * kb, 32 * nb, Wt_dn, 32 * nb, nullptr, scr, F.lane); continue; } r -= I_DN;
        if (r < I_PG) { const int nb = r % 32, kb = r / 32; tr_item(P.w_pg, DM, DM, 64 * kb, 32 * nb, Wt_pg, 32 * nb, P.g_ple, scr, F.lane); continue; } r -= I_PG;
        { const int nb = r % 32, kb = r / 32; tr_item(P.w_pp, DM, PLE, 64 * kb, 32 * nb, Wt_pp, 32 * nb, nullptr, scr, F.lane); }
    }
    bf16* xb = (bf16*)(P.ws + WS_A); float* rstdx = (float*)(P.ws + WS_RSTDX);
    for (int m = gw; m < M; m += NGW) {
        const float* xr = m < MP ? P.xp + (size_t)m * DM : P.xs + (size_t)(m - MP) * DM;
        const GAS f32x4* x4 = (const GAS f32x4*)xr + F.lane; f32x4 v[4]; float s = 0.f;
#pragma unroll
        for (int j = 0; j < 4; ++j) { v[j] = x4[64 * j]; s += sum4(v[j] * v[j]); }
        s = wave_sum(s);
        GAS unsigned long long* o8 = (GAS unsigned long long*)(xb + (size_t)m * DM) + F.lane;
#pragma unroll
        for (int j = 0; j < 4; ++j) o8[64 * j] = (unsigned long long)pk2(v[j].x, v[j].y) | ((unsigned long long)pk2(v[j].z, v[j].w) << 32);
        if (F.lane == 0) rstdx[m] = rsqrtf(s * (1.0f / DM) + EPS);
    }
    bf16* pb = (bf16*)(P.ws + WS_PB);
    for (int m = gw; m < M; m += NGW) {
        const float* pr = m < MP ? P.pp + (size_t)m * PLE : P.ps + (size_t)(m - MP) * PLE;
        const f32x4 v = ((const GAS f32x4*)pr)[F.lane];
        ((GAS unsigned long long*)(pb + (size_t)m * PLE))[F.lane] = (unsigned long long)pk2(v.x, v.y) | ((unsigned long long)pk2(v.z, v.w) << 32);
    }
    if (F.vcu == 0 && F.tid == 0) build_ticket_table((unsigned short*)(P.ws + WS_TAB));
    float* cosT = (float*)(P.ws + WS_COS); float* sinT = (float*)(P.ws + WS_SIN);
    for (int i = (F.vcu * NTHR + F.tid); i < MP * 64; i += F.G * NTHR) {
        const int pos = i >> 6, j = i & 63;
        const float inv = exp2f(-(float)j * (13.287712379549449f / 64.0f));
        const float ang = (float)pos * inv;
        const float k = rintf(ang * 0.15915494309189535f);
        float r = fmaf(-k, 6.28125f, ang); r = fmaf(-k, 1.9353071795864769e-3f, r);
        cosT[i] = __cosf(r); sinT[i] = __sinf(r);
    }
}

typedef short v4i16_t __attribute__((ext_vector_type(4)));
__device__ __forceinline__ s16x4 trrd(const LAS bf16* p) { return __builtin_bit_cast(s16x4, __builtin_amdgcn_ds_read_tr16_b64_v4i16((LAS v4i16_t*)p)); }
__device__ __forceinline__ s16x8 frag_tr(const LAS bf16* X, int ld, int rA, int rB, int c0, int lane) {
    const int i = lane & 15, co = c0 + 16 * ((lane >> 4) & 1) + 4 * (i & 3);
    const s16x4 lo = trrd(X + (rA + (i >> 2)) * ld + co), hh = trrd(X + (rB + (i >> 2)) * ld + co);
    return (s16x8){lo[0], lo[1], lo[2], lo[3], hh[0], hh[1], hh[2], hh[3]};
}
__device__ __forceinline__ s16x8 pack_p(const f32x16& p, int s2) { u32x4 w;
    w.x = pg8::cvt_pk_bf16(p[8 * s2 + 0], p[8 * s2 + 1]); w.y = pg8::cvt_pk_bf16(p[8 * s2 + 2], p[8 * s2 + 3]); w.z = pg8::cvt_pk_bf16(p[8 * s2 + 4], p[8 * s2 + 5]); w.w = pg8::cvt_pk_bf16(p[8 * s2 + 6], p[8 * s2 + 7]);
    return __builtin_bit_cast(s16x8, w); }
__device__ __forceinline__ void unpack8(v4u w, float* f) {
    f[0] = __uint_as_float(w.x << 16); f[1] = __uint_as_float(w.x & 0xffff0000u); f[2] = __uint_as_float(w.y << 16); f[3] = __uint_as_float(w.y & 0xffff0000u);
    f[4] = __uint_as_float(w.z << 16); f[5] = __uint_as_float(w.z & 0xffff0000u); f[6] = __uint_as_float(w.w << 16); f[7] = __uint_as_float(w.w & 0xffff0000u); }
constexpr int LDT = 160;
constexpr int LQ = 136;

constexpr int LKA = 72, LVA = 96;
__device__ __forceinline__ void attn_unit(Frame& F, const Ptrs& P, const bool samp, const int idx, const int h) {
    const bf16* Z = (const bf16*)(P.ws + WS_Z); bf16* MIX = (bf16*)(P.ws + WS_A);
    const int tid = F.tid, lane = F.lane, wave = F.wave, hi = lane >> 5, l31 = lane & 31, wp = wave >> 1, qb = wave & 1;
    LAS bf16* Kb = (LAS bf16*)F.lds; LAS bf16* Vb = Kb + 2 * 64 * LKA; LAS float* BTX = (LAS float*)(F.lds + 43008); LAS float* SC = (LAS float*)(F.lds + 46336) + wave * 32;
    LAS bf16* OS = (LAS bf16*)(F.lds + 47360) + wave * (32 * LKA);
    const int nsteps = samp ? 9 : 12, t0 = samp ? 0 : (idx >= 2 ? 0 : 8 - 4 * idx);
    const int rowq = samp ? MP + 64 * idx + 32 * qb : 256 * idx + 64 * wp + 32 * qb;
    const bool wact = samp ? (wp == 0) : true;
    __syncthreads();
    { const float* rb = P.rel_bias + (size_t)h * 513; const float rb512 = rb[512];
      for (int i = tid; i < 832; i += NTHR) BTX[i] = i <= 512 ? (rb[i] - rb512) * LOG2E : 0.f; }
    s16x8 qf[4];
    { const bf16* qs = Z + (size_t)(rowq + l31) * NIN + ZQA + h * 64 + 8 * hi;
#pragma unroll
      for (int s = 0; s < 4; ++s) qf[s] = wact ? *(const s16x8*)(qs + 16 * s) : (s16x8){0, 0, 0, 0, 0, 0, 0, 0}; }
    const int srow = tid >> 3, sch = tid & 7; v4u kreg, vreg;
#define A_LOAD(t) do { if (samp && (t) < 8) { \
            const float* ks_ = P.ck + ((size_t)(idx * 512 + 64 * (t) + srow) * 8 + h) * 64 + sch * 8; const float* vs_ = P.cv + ((size_t)(idx * 512 + 64 * (t) + srow) * 8 + h) * 64 + sch * 8; \
            const f32x4 a_ = *(const f32x4*)ks_, b_ = *(const f32x4*)(ks_ + 4), c_ = *(const f32x4*)vs_, d_ = *(const f32x4*)(vs_ + 4); \
            kreg = pack8(a_, b_); vreg = pack8(c_, d_); \
        } else { const int kr_ = samp ? MP + 64 * idx + srow : 64 * (4 * idx - 8 + (t)) + srow; const bf16* s_ = Z + (size_t)kr_ * NIN + h * 64 + sch * 8; \
            kreg = *(const v4u*)(s_ + ZKA); vreg = *(const v4u*)(s_ + ZVA); } } while (0)
#define A_STORE(buf) do { *(LAS v4u*)(Kb + (buf) * 64 * LKA + srow * LKA + sch * 8) = kreg; *(LAS v4u*)(Vb + (buf) * 64 * LVA + srow * LVA + sch * 8) = vreg; } while (0)
    f32x16 o0 = {}, o1 = {}; float m_run = 0.f, l_run = 0.f; bool first = true;
    const int b0 = 768 + 32 * qb + l31 - 4 * hi;
    A_LOAD(t0); A_STORE(0); __syncthreads();
    for (int t = t0, it = 0; t < nsteps; ++t, ++it) {
        if (t + 1 < nsteps) A_LOAD(t + 1);
        const int j = samp ? t : t - wp;
        if (wact && j >= 0 && j <= 8) {
            const LAS bf16* Kc = Kb + (it & 1) * 64 * LKA; const LAS bf16* Vc = Vb + (it & 1) * 64 * LVA;
            f32x16 p[2];
#pragma unroll
            for (int lb = 0; lb < 2; ++lb) { f32x16 c;
                if (j >= 4) { const LAS float* bp = BTX + (b0 - 64 * j - 32 * lb);
#pragma unroll
                    for (int r = 0; r < 16; ++r) c[r] = bp[-((r & 3) + 8 * (r >> 2))] - m_run;
                } else {
#pragma unroll
                    for (int r = 0; r < 16; ++r) c[r] = -m_run; }
#pragma unroll
                for (int s = 0; s < 4; ++s) c = MFMA32(frag(Kc, LKA, 32 * lb, 16 * s, lane), qf[s], c);
                p[lb] = c; }
            float mx = p[0][0];
#pragma unroll
            for (int r = 0; r < 16; ++r) { mx = fmaxf(mx, p[0][r]); mx = fmaxf(mx, p[1][r]); }
            mx = fmaxf(mx, __shfl_xor(mx, 32));
            if (first || __any(mx > 8.0f)) {
                const float d = first ? mx : fmaxf(mx, 0.f); m_run += d;
#pragma unroll
                for (int r = 0; r < 16; ++r) { p[0][r] -= d; p[1][r] -= d; }
                if (!first) { const float alpha = exp2f(-d); l_run *= alpha;
                    if (hi == 0) SC[l31] = alpha;
                    asm volatile("s_waitcnt lgkmcnt(0)" ::: "memory");
#pragma unroll
                    for (int r = 0; r < 16; ++r) { const float f = SC[crow(r, hi)]; o0[r] *= f; o1[r] *= f; }
                    asm volatile("s_waitcnt lgkmcnt(0)" ::: "memory"); }
                first = false;
            }
            float ls = 0.f;
#pragma unroll
            for (int r = 0; r < 16; ++r) { p[0][r] = __builtin_amdgcn_exp2f(p[0][r]); p[1][r] = __builtin_amdgcn_exp2f(p[1][r]); ls += p[0][r] + p[1][r]; }
            l_run += ls;
#pragma unroll
            for (int lb = 0; lb < 2; ++lb)
#pragma unroll
                for (int s2 = 0; s2 < 2; ++s2) { const s16x8 pa = pack_p(p[lb], s2); const int kb = 32 * lb + 16 * s2 + 4 * hi;
                    o0 = MFMA32(pa, frag_tr(Vc, LVA, kb, kb + 8, 0, lane), o0); o1 = MFMA32(pa, frag_tr(Vc, LVA, kb, kb + 8, 32, lane), o1); }
        }
        if (t + 1 < nsteps) A_STORE((it + 1) & 1);
        __syncthreads();
    }
#undef A_LOAD
#undef A_STORE
    if (wact) {
        l_run += __shfl_xor(l_run, 32);
        if (hi == 0) SC[l31] = 1.0f / l_run;
        asm volatile("s_waitcnt lgkmcnt(0)" ::: "memory");
#pragma unroll
        for (int r = 0; r < 16; ++r) { const int n = crow(r, hi); const float f = SC[n]; OS[n * LKA + l31] = (bf16)f2bf(o0[r] * f); OS[n * LKA + 32 + l31] = (bf16)f2bf(o1[r] * f); }
        asm volatile("s_waitcnt lgkmcnt(0)" ::: "memory");
        const int row = lane >> 1, half = lane & 1; bf16* dst = MIX + (size_t)(rowq + row) * DM + 512 + h * 64 + 32 * half;
#pragma unroll
        for (int c = 0; c < 4; ++c) *(v4u*)(dst + 8 * c) = *(const LAS v4u*)(OS + row * LKA + 32 * half + 8 * c);
    }
}

__device__ __forceinline__ void retU_item(Frame& F, const Ptrs& P, const bool samp, const int idx, const int h) {
    const bf16* Z = (const bf16*)(P.ws + WS_Z);
    const int tid = F.tid, lane = F.lane, wave = F.wave, hi = lane >> 5, l31 = lane & 31;
    LAS bf16* Vi = (LAS bf16*)F.lds; LAS bf16* Ki = Vi + 128 * LDT;
    const int T = samp ? 64 : 256, row0 = samp ? MP + 64 * idx : 256 * idx;
    const LAS bf16* X = samp ? Ki : Vi; const LAS bf16* Y = samp ? Vi : Ki;
    const int ib = wave >> 1, jb0 = 2 * (wave & 1);
    f32x16 a0 = {}, a1 = {};
    for (int p0 = 0; p0 < T; p0 += 128) {
        const int rows = (T - p0) < 128 ? (T - p0) : 128;
        __syncthreads();
        for (int c = tid; c < rows * 16; c += NTHR) { const int row = c >> 4, ch = c & 15;
            const bf16* src = Z + (size_t)(row0 + p0 + row) * NIN + h * 128 + ch * 8;
            *(LAS v4u*)(Vi + row * LDT + ch * 8) = *(const v4u*)(src + ZV); *(LAS v4u*)(Ki + row * LDT + ch * 8) = *(const v4u*)(src + ZK); }
        __syncthreads();
        for (int s = 0; s < rows / 16; ++s) { const int rA = 16 * s + 8 * hi;
            const s16x8 a = frag_tr(X, LDT, rA, rA + 4, 32 * ib, lane);
            a0 = MFMA32(a, frag_tr(Y, LDT, rA, rA + 4, 32 * jb0, lane), a0); a1 = MFMA32(a, frag_tr(Y, LDT, rA, rA + 4, 32 * jb0 + 32, lane), a1); }
    }
    const float lg2 = lg2_gamma(h), gT1 = exp2f((float)(T - 1) * lg2);
    if (!samp) {
        float* UF = (float*)(P.ws + WS_UF) + (size_t)(idx * 4 + h) * 16384;
#pragma unroll
        for (int r = 0; r < 16; ++r) { const int e = 32 * ib + crow(r, hi); UF[e * 128 + 32 * jb0 + l31] = gT1 * a0[r]; UF[e * 128 + 32 * jb0 + 32 + l31] = gT1 * a1[r]; }
    } else {
        const float g64 = exp2f(64.0f * lg2);
        const float* R0 = P.sr + (size_t)(idx * 4 + h) * 16384; float* RO = P.out + OFF_RS + (size_t)(idx * 4 + h) * 16384;
#pragma unroll
        for (int r = 0; r < 16; ++r) { const int d = 32 * ib + crow(r, hi); const int e0 = 32 * jb0 + l31;
            RO[d * 128 + e0] = g64 * R0[d * 128 + e0] + gT1 * a0[r]; RO[d * 128 + e0 + 32] = g64 * R0[d * 128 + e0 + 32] + gT1 * a1[r]; }
    }
}
__device__ __forceinline__ void ret_scan(Frame& F, const Ptrs& P) {
    const int gid = F.vcu * NTHR + F.tid;
    if (gid < 32768) {
        typedef float f32x2v __attribute__((ext_vector_type(2)));
        const f32x2v* uf = (const f32x2v*)(P.ws + WS_UF) + gid; unsigned* rb = (unsigned*)(P.ws + WS_RB) + gid; const int h = gid >> 13;
        const float g = exp2f(256.0f * lg2_gamma(h)); float R0 = 0.f, R1 = 0.f;
        f32x2v u[64];
#pragma unroll
        for (int c = 0; c < 64; ++c) u[c] = uf[(size_t)c * 32768];
#pragma unroll
        for (int c = 0; c < 64; ++c) { rb[(size_t)c * 32768] = pk2(R0, R1); R0 = g * R0 + u[c].x; R1 = g * R1 + u[c].y; }
        const int el = (2 * gid) & 16383, e = el >> 7, d = el & 127;
        float* o = P.out + OFF_RP + (size_t)h * 16384; o[d * 128 + e] = R0; o[(d + 1) * 128 + e] = R1;
    }
}
__device__ __forceinline__ void retO_item(Frame& F, const Ptrs& P, const bool samp, const int idx, const int h) {
    const bf16* Z = (const bf16*)(P.ws + WS_Z); bf16* MIX = (bf16*)(P.ws + WS_A);
    const int tid = F.tid, lane = F.lane, wave = F.wave, hi = lane >> 5, l31 = lane & 31;
    LAS bf16* RT = (LAS bf16*)F.lds; LAS bf16* Kb = RT + 128 * LQ; LAS bf16* Vb = Kb + 2 * 64 * LQ; LAS bf16* OS = Kb + wave * (32 * LQ);
    const int T = samp ? 64 : 256, row0 = samp ? MP + 64 * idx : 256 * idx, nkb_all = T / 64;
    const int rb = wave < 4 ? wave : 11 - wave; const bool act = rb * 32 < T; const int nkb = act ? (rb >> 1) + 1 : 0;
    const float gam = exp2f(lg2_gamma(h));
    __syncthreads();
    if (!samp) { const bf16* rs = (const bf16*)(P.ws + WS_RB) + (size_t)(idx * 4 + h) * 16384;
#pragma unroll
        for (int i = 0; i < 4; ++i) { const int c = tid + NTHR * i, e = c >> 4, ch = c & 15; *(LAS v4u*)(RT + e * LQ + ch * 8) = *(const v4u*)(rs + e * 128 + ch * 8); }
    } else { const float* rs = P.sr + (size_t)(idx * 4 + h) * 16384;
#pragma unroll
        for (int i = 0; i < 8; ++i) { const int id = i * NTHR + tid, d = id >> 5, e0 = (id & 31) * 4; const f32x4 v = *(const f32x4*)(rs + d * 128 + e0);
            RT[(e0 + 0) * LQ + d] = (bf16)f2bf(v.x); RT[(e0 + 1) * LQ + d] = (bf16)f2bf(v.y); RT[(e0 + 2) * LQ + d] = (bf16)f2bf(v.z); RT[(e0 + 3) * LQ + d] = (bf16)f2bf(v.w); } }
    s16x8 qf[8];
    { const bf16* qs = Z + (size_t)(row0 + (act ? 32 * rb : 0) + l31) * NIN + ZQ + h * 128 + 8 * hi;
#pragma unroll
      for (int s = 0; s < 8; ++s) qf[s] = *(const s16x8*)(qs + 16 * s); }
    v4u kreg[2], vreg[2];
#define R_LOAD(kb) do { _Pragma("unroll") for (int i_ = 0; i_ < 2; ++i_) { const int c_ = tid + NTHR * i_; const bf16* s_ = Z + (size_t)(row0 + 64 * (kb) + (c_ >> 4)) * NIN + h * 128 + (c_ & 15) * 8; \
        kreg[i_] = *(const v4u*)(s_ + ZK); vreg[i_] = *(const v4u*)(s_ + ZV); } } while (0)
#define R_STORE(buf) do { _Pragma("unroll") for (int i_ = 0; i_ < 2; ++i_) { const int c_ = tid + NTHR * i_; \
        *(LAS v4u*)(Kb + (buf) * 64 * LQ + (c_ >> 4) * LQ + (c_ & 15) * 8) = kreg[i_]; *(LAS v4u*)(Vb + (buf) * 64 * LDT + (c_ >> 4) * LDT + (c_ & 15) * 8) = vreg[i_]; } } while (0)
    R_LOAD(0); R_STORE(0); __syncthreads();
    f32x16 acc[4];
#pragma unroll
    for (int eb = 0; eb < 4; ++eb) { f32x16 a = {};
        if (act) {
#pragma unroll
            for (int s = 0; s < 8; ++s) a = MFMA32(qf[s], frag(RT, LQ, 32 * eb, 16 * s, lane), a); }
        acc[eb] = a * gam; }
    for (int kb = 0; kb < nkb_all; ++kb) {
        if (kb + 1 < nkb_all) R_LOAD(kb + 1);
        if (kb < nkb) {
            const LAS bf16* Kc = Kb + (kb & 1) * 64 * LQ; const LAS bf16* Vc = Vb + (kb & 1) * 64 * LDT; const bool diag = (kb == nkb - 1);
#pragma unroll
            for (int lb = 0; lb < 2; ++lb) {
                if (diag && lb == 1 && !(rb & 1)) continue;
                f32x16 p = {};
#pragma unroll
                for (int s = 0; s < 8; ++s) p = MFMA32(frag(Kc, LQ, 32 * lb, 16 * s, lane), qf[s], p);
                if (diag) { const int nl = 32 * (rb & 1) + l31;
#pragma unroll
                    for (int r = 0; r < 16; ++r) if (32 * lb + crow(r, hi) > nl) p[r] = 0.f; }
#pragma unroll
                for (int s2 = 0; s2 < 2; ++s2) { const s16x8 pa = pack_p(p, s2); const int kr = 32 * lb + 16 * s2 + 4 * hi;
#pragma unroll
                    for (int eb = 0; eb < 4; ++eb) acc[eb] = MFMA32(pa, frag_tr(Vc, LDT, kr, kr + 8, 32 * eb, lane), acc[eb]); }
            }
        }
        if (kb + 1 < nkb_all) R_STORE((kb + 1) & 1);
        __syncthreads();
    }
#undef R_LOAD
#undef R_STORE
    if (act) {
#pragma unroll
        for (int eb = 0; eb < 4; ++eb)
#pragma unroll
            for (int r = 0; r < 16; ++r) OS[crow(r, hi) * LQ + 32 * eb + l31] = (bf16)f2bf(acc[eb][r]);
        asm volatile("s_waitcnt lgkmcnt(0)" ::: "memory");
        const int row = lane >> 1, half = lane & 1, grow = row0 + 32 * rb + row;
        v4u ow[8]; float ss = 0.f;
#pragma unroll
        for (int c = 0; c < 8; ++c) { ow[c] = *(const LAS v4u*)(OS + row * LQ + 64 * half + 8 * c); float f[8]; unpack8(ow[c], f);
#pragma unroll
            for (int i = 0; i < 8; ++i) ss += f[i] * f[i]; }
        ss += __shfl_xor(ss, 1);
        const float inv = rsqrtf(ss * (1.0f / 128.0f) + EPS);
        const bf16* gs = Z + (size_t)grow * NIN + ZG + h * 128 + 64 * half; const float* gro = P.g_ro + h * 128 + 64 * half; bf16* dst = MIX + (size_t)grow * DM + h * 128 + 64 * half;
#pragma unroll
        for (int c = 0; c < 8; ++c) { float f[8], g[8]; unpack8(ow[c], f); unpack8(*(const v4u*)(gs + 8 * c), g);
            const f32x4 r0 = *(const f32x4*)(gro + 8 * c), r1 = *(const f32x4*)(gro + 8 * c + 4); f32x4 x0, x1;
#pragma unroll
            for (int i = 0; i < 4; ++i) { x0[i] = g[i] * __builtin_amdgcn_rcpf(1.0f + __builtin_amdgcn_exp2f(-g[i] * LOG2E)) * f[i] * inv * r0[i];
                                          x1[i] = g[4 + i] * __builtin_amdgcn_rcpf(1.0f + __builtin_amdgcn_exp2f(-g[4 + i] * LOG2E)) * f[4 + i] * inv * r1[i]; }
            *(v4u*)(dst + 8 * c) = pack8(x0, x1); }
    }
}

typedef __amdgpu_buffer_rsrc_t rsrc_t;
__device__ __forceinline__ rsrc_t mk_rsrc(const void* p, unsigned bytes) { return __builtin_amdgcn_make_buffer_rsrc((void*)p, 0, (int)bytes, 0x00020000); }
__device__ __forceinline__ f32x4 ld_sc1_f4(rsrc_t r, unsigned off) { return __builtin_bit_cast(f32x4, __builtin_amdgcn_raw_buffer_load_b128(r, (int)off, 0, 16)); }
__device__ __forceinline__ void st_sc1_f4(rsrc_t r, unsigned off, f32x4 v) { __builtin_amdgcn_raw_buffer_store_b128(__builtin_bit_cast(v4u, v), r, (int)off, 0, 16); }
__device__ __forceinline__ void st_sc1_u4(rsrc_t r, unsigned off, v4u v) { __builtin_amdgcn_raw_buffer_store_b128(v, r, (int)off, 0, 16); }
__device__ __forceinline__ float rstd16_sc1(rsrc_t r, int row) {
    const f32x4 a = ld_sc1_f4(r, (unsigned)row * 64u), b = ld_sc1_f4(r, (unsigned)row * 64u + 16u), c = ld_sc1_f4(r, (unsigned)row * 64u + 32u), d = ld_sc1_f4(r, (unsigned)row * 64u + 48u);
    return rsqrtf(((sum4(a) + sum4(b)) + (sum4(c) + sum4(d))) * (1.0f / DM) + EPS);
}
struct TailSched {
    const Ptrs& P; gu32* ctl; volatile LAS unsigned* LW;
    int tk_read, tk_fetched, par; unsigned tkv, myq;
    __device__ __forceinline__ gu32* dep(int stage, int pm) const { return ctl + CW_DEP + (stage * 72 + pm) * 64; }
    __device__ __forceinline__ static pg8::SUnit dec(unsigned e) { pg8::SUnit u; u.kind = (int)((e >> 12) & 7u); u.pm = (int)(((e >> 5) & 15u) * 8u + (e >> 16)); u.pn = (int)(e & 31u); return u; }
    __device__ __forceinline__ unsigned tab_entry(unsigned tk) const { const unsigned short* tab = (const unsigned short*)(P.ws + WS_TAB); return (unsigned)__builtin_amdgcn_readfirstlane((int)tab[tk & 511u]) | ((tk >> 9) << 16); }
    __device__ __forceinline__ unsigned fetch_ticket() const {
        for (unsigned k = 0; k < 8u; ++k) { const unsigned qx = (myq + k) & 7u; const unsigned i = __hip_atomic_fetch_add(ctl + CW_TKT + 64 * qx, 1u, __ATOMIC_RELAXED, __HIP_MEMORY_SCOPE_AGENT); if (i < (unsigned)NQ) return (qx << 9) | i; }
        return (unsigned)TK_NONE;
    }
    __device__ __forceinline__ void need_of(const pg8::SUnit& u, int& stage, unsigned& need) const {
        stage = -1; need = 0u;
        if (u.kind == 1) { stage = 0; need = 32u; } else if (u.kind == 2) { stage = 1; need = 176u; } else if (u.kind == 3) { stage = 2; need = 32u; }
    }
    __device__ __forceinline__ bool first(pg8::SUnit& cur, int wid, int lane) {
        tk_read = 1; tk_fetched = 2; par = 0; tkv = 0u; myq = xb_xcc_id() & 7u;
        if (wid == 0 && lane == 0) { const unsigned t0 = fetch_ticket(); const unsigned t1 = (t0 == (unsigned)TK_NONE) ? t0 : fetch_ticket(); LW[0] = t0; LW[1] = t1; }
        __syncthreads();
        const unsigned t0 = LW[0];
        if (t0 == (unsigned)TK_NONE) return false;
        cur = dec(tab_entry(t0)); return true;
    }
    __device__ __forceinline__ void wait_ready(const pg8::SUnit& u, int lane) const {
        int stage; unsigned need; need_of(u, stage, need);
        if (stage < 0) return;
        gu32* p = dep(stage, u.pm); unsigned spins = 0;
        while ((unsigned)__builtin_amdgcn_readfirstlane((int)__hip_atomic_load(p, __ATOMIC_RELAXED, __HIP_MEMORY_SCOPE_AGENT)) < need) {
            __builtin_amdgcn_s_sleep(8);
            if (++spins > (1u << 22)) { if (lane == 0) __hip_atomic_store(ctl + CW_TMO, 1u, __ATOMIC_RELAXED, __HIP_MEMORY_SCOPE_AGENT); break; }
        }
    }
    __device__ __forceinline__ void probe(const pg8::SUnit& cur, int wid, int lane) {
        par ^= 1;
        if (cur.kind == 3) return;
        if (wid == 0) {
            const unsigned tk = LW[tk_read & 1]; unsigned e = TK_NONE, ok = 1u;
            if (tk != (unsigned)TK_NONE) { e = tab_entry(tk); const pg8::SUnit u = dec(e); int stage; unsigned need; need_of(u, stage, need);
                if (stage >= 0) ok = ((unsigned)__builtin_amdgcn_readfirstlane((int)__hip_atomic_load(dep(stage, u.pm), __ATOMIC_RELAXED, __HIP_MEMORY_SCOPE_AGENT)) >= need) ? 1u : 0u; }
            if (lane == 0) { LW[2 + par] = e; LW[4 + par] = ok; }
        }
    }
    __device__ __forceinline__ bool peek(const pg8::SUnit& cur, pg8::SUnit& nxt, bool& ready) {
        if (cur.kind == 3) { nxt.kind = 4; nxt.pm = cur.pm; nxt.pn = cur.pn; ready = true; return true; }
        const unsigned e = LW[2 + par], ok = LW[4 + par]; ++tk_read;
        if ((e & 0xffffu) == (unsigned)TK_NONE) { ready = false; return false; }
        nxt = dec(e); ready = ok != 0u; return true;
    }
    __device__ __forceinline__ pg8::SGeo geo(const pg8::SUnit& u) const {
        pg8::SGeo g; const char* ws = (const char*)P.ws;
        if (u.kind == 0)      { g.ld = DM;  g.nt = 16; g.A = ws + WS_A;  g.B = ws + WS_WOUT; }
        else if (u.kind == 1) { g.ld = DM;  g.nt = 16; g.A = ws + WS_HB; g.B = ws + WS_WGU; }
        else if (u.kind == 2) { g.ld = FF;  g.nt = 44; g.A = ws + WS_T;  g.B = ws + WS_WDN; }
        else if (u.kind == 3) { g.ld = PLE; g.nt = 4;  g.A = ws + WS_PB; g.B = ws + WS_WPP; }
        else                  { g.ld = DM;  g.nt = 16; g.A = ws + WS_HB; g.B = ws + WS_WPG; }
        g.hstep = 128u * g.ld * 2u; g.A += (size_t)u.pm * 2u * g.hstep; g.B += (size_t)u.pn * 2u * g.hstep; return g;
    }
    __device__ __forceinline__ void epilogue(const f32x4 (&acc)[2][2][4][2], const pg8::SUnit& u, bool has_next, const pg8::SUnit& nxt, int wr, int wc, int fr, int fq, int wid, int lane) {
        const bool fetch = has_next && nxt.kind != 3;
        if (fetch && wid == 0 && lane == 0) tkv = fetch_ticket();
        const int rbase = u.pm * 256 + wr * 64 + fr;
        if (u.kind == 0 || u.kind == 2) {
            const rsrc_t rH = mk_rsrc(P.ws + WS_HB, (unsigned)M * DM * 2u), rS = mk_rsrc(P.ws + (u.kind == 0 ? WS_ST1 : WS_ST2), (unsigned)M * 64u);
#pragma unroll
            for (int ai = 0; ai < 2; ++ai)
#pragma unroll
                for (int m = 0; m < 4; ++m) {
                    const int r = rbase + ai * 128 + m * 16; float ss = 0.f;
#pragma unroll
                    for (int bj = 0; bj < 2; ++bj) {
                        const unsigned c0 = (unsigned)(u.pn * 256 + bj * 128 + wc * 32 + fq * 8), eo = (unsigned)r * DM + c0; f32x4 r0, r1;
                        if (u.kind == 0) { const float* xr = r < MP ? P.xp + (size_t)r * DM : P.xs + (size_t)(r - MP) * DM; r0 = *(const f32x4*)(xr + c0); r1 = *(const f32x4*)(xr + c0 + 4); }
                        else { const v4u w = __builtin_amdgcn_raw_buffer_load_b128(rH, (int)(eo * 2u), 0, 16); float f[8]; unpack8(w, f); r0 = (f32x4){f[0], f[1], f[2], f[3]}; r1 = (f32x4){f[4], f[5], f[6], f[7]}; }
                        const f32x4 h0 = r0 + acc[ai][bj][m][0], h1 = r1 + acc[ai][bj][m][1];
                        st_sc1_u4(rH, eo * 2u, pack8(h0, h1));
                        ss += sum4(h0 * h0) + sum4(h1 * h1);
                    }
                    ss += __shfl_xor(ss, 16); ss += __shfl_xor(ss, 32);
                    if (fq == 0) __builtin_amdgcn_raw_buffer_store_b32(__float_as_uint(ss), rS, (int)(((unsigned)r * 16u + (unsigned)(u.pn * 4 + wc)) * 4u), 0, 16);
                }
        } else if (u.kind == 1) {
            const rsrc_t rS = mk_rsrc(P.ws + WS_ST1, (unsigned)M * 64u), rT = mk_rsrc(P.ws + WS_T, (unsigned)M * FF * 2u);
#pragma unroll
            for (int ai = 0; ai < 2; ++ai)
#pragma unroll
                for (int m = 0; m < 4; ++m) {
                    const int r = rbase + ai * 128 + m * 16; const float rs = rstd16_sc1(rS, r);
                    const f32x4 g0 = acc[ai][0][m][0] * rs, g1 = acc[ai][0][m][1] * rs, u0 = acc[ai][1][m][0] * rs, u1 = acc[ai][1][m][1] * rs;
                    const f32x4 t0 = g0 * sigmoid4(g0) * u0, t1 = g1 * sigmoid4(g1) * u1;
                    st_sc1_u4(rT, ((unsigned)r * FF + (unsigned)(u.pn * 128 + wc * 32 + fq * 8)) * 2u, pack8(t0, t1));
                }
        } else if (u.kind == 3) {
            const rsrc_t rP = mk_rsrc(P.ws + WS_A, (unsigned)M * DM * 2u);
#pragma unroll
            for (int ai = 0; ai < 2; ++ai)
#pragma unroll
                for (int m = 0; m < 4; ++m) { const int r = rbase + ai * 128 + m * 16;
#pragma unroll
                    for (int bj = 0; bj < 2; ++bj) st_sc1_u4(rP, ((unsigned)r * DM + (unsigned)(u.pn * 256 + bj * 128 + wc * 32 + fq * 8)) * 2u, pack8(acc[ai][bj][m][0], acc[ai][bj][m][1]));
                    asm volatile("" ::: "memory"); }
        } else {
            const rsrc_t rH = mk_rsrc(P.ws + WS_HB, (unsigned)M * DM * 2u), rS = mk_rsrc(P.ws + WS_ST2, (unsigned)M * 64u), rP = mk_rsrc(P.ws + WS_A, (unsigned)M * DM * 2u);
#pragma unroll
            for (int ai = 0; ai < 2; ++ai)
#pragma unroll
                for (int m = 0; m < 4; ++m) {
                    const int r = rbase + ai * 128 + m * 16; const float rs = rstd16_sc1(rS, r);
#pragma unroll
                    for (int bj = 0; bj < 2; ++bj) {
                        const unsigned eo = (unsigned)r * DM + (unsigned)(u.pn * 256 + bj * 128 + wc * 32 + fq * 8);
                        const u32x4 pw = __builtin_amdgcn_raw_buffer_load_b128(rP, (int)(eo * 2u), 0, 16);
                        const f32x4 p0 = {__uint_as_float(pw.x << 16), __uint_as_float(pw.x & 0xffff0000u), __uint_as_float(pw.y << 16), __uint_as_float(pw.y & 0xffff0000u)};
                        const f32x4 p1 = {__uint_as_float(pw.z << 16), __uint_as_float(pw.z & 0xffff0000u), __uint_as_float(pw.w << 16), __uint_as_float(pw.w & 0xffff0000u)};
                        const v4u hw = __builtin_amdgcn_raw_buffer_load_b128(rH, (int)(eo * 2u), 0, 16); float hf[8]; unpack8(hw, hf);
                        const f32x4 y0 = (f32x4){hf[0], hf[1], hf[2], hf[3]} + p0 * sigmoid4(acc[ai][bj][m][0] * rs), y1 = (f32x4){hf[4], hf[5], hf[6], hf[7]} + p1 * sigmoid4(acc[ai][bj][m][1] * rs);
                        float* o = P.out + eo; *(f32x4*)o = y0; *(f32x4*)(o + 4) = y1;
                    }
                }
        }
        asm volatile("s_waitcnt vmcnt(0)" ::: "memory");
        if (u.kind <= 2 && lane == 0) __hip_atomic_fetch_add(dep(u.kind, u.pm), 1u, __ATOMIC_RELAXED, __HIP_MEMORY_SCOPE_AGENT);
        if (fetch) { if (wid == 0 && lane == 0) LW[tk_fetched & 1] = tkv; ++tk_fetched; }
    }
};

struct Args { const float* in[21]; float* out; unsigned char* ws; int ph_lo, ph_hi; };
template <int PHM> __global__ void __launch_bounds__(NTHR, 2) skel_fwd(Args args) {
    extern __shared__ __attribute__((aligned(16))) unsigned char lds[];
    Frame F;
    F.lds = (LAS unsigned char*)lds; F.MISC = (volatile LAS unsigned*)(F.lds + MISC_OFF);
    F.tid = threadIdx.x; F.lane = F.tid & 63; F.wave = __builtin_amdgcn_readfirstlane(F.tid >> 6);
    F.G = gridDim.x; { const int bx = blockIdx.x; F.vcu = (F.G % 8 == 0) ? (bx % 8) * (F.G / 8) + bx / 8 : bx; }
    unsigned char* ws = args.ws; F.ctl = (gu32*)(ws + WS_CTL);
    Ptrs P; P.xp = args.in[0]; P.xs = args.in[1]; P.ck = args.in[2]; P.cv = args.in[3]; P.sr = args.in[4]; P.pp = args.in[5]; P.ps = args.in[6]; P.g_mix = args.in[7]; P.w_in = args.in[8];
    P.g_ro = args.in[9]; P.g_q = args.in[10]; P.g_k = args.in[11]; P.rel_bias = args.in[12]; P.w_out = args.in[13]; P.g_ffn = args.in[14]; P.w_g = args.in[15]; P.w_u = args.in[16];
    P.w_d = args.in[17]; P.g_ple = args.in[18]; P.w_pg = args.in[19]; P.w_pp = args.in[20]; P.out = args.out; P.ws = ws;
    for (int u = F.tid; u < (LDS_BYTES - LDSCTL_OFF) / 4; u += NTHR) ((LAS unsigned*)(F.lds + LDSCTL_OFF))[u] = 0u;
    __syncthreads();
    XcdBarrier bar; bar.bar = (unsigned*)(F.ctl + CW_BAR); bar.x = 0; bar.st = nullptr;
    if (MK_ONE_LAUNCH) bar = xcd_barrier_post((unsigned*)(F.ctl + CW_BAR), F.MISC + 8);
#define GRID_BAR() do { if (MK_ONE_LAUNCH) xcd_barrier(bar); } while (0)
    const int lo = args.ph_lo, hi = args.ph_hi;
#define IN(k) (((PHM >> (k)) & 1) && lo <= (k) && (k) < hi)
#define BOTH(k) (IN(k) && IN((k) + 1))
    bf16* XB = (bf16*)(ws + WS_A); bf16* ZB = (bf16*)(ws + WS_Z); bf16* HB = (bf16*)(ws + WS_HB); bf16* TB = (bf16*)(ws + WS_T); bf16* PPB = (bf16*)(ws + WS_A);
    float* ST1 = (float*)(ws + WS_ST1); float* ST2 = (float*)(ws + WS_ST2);

    if (IN(0)) { p0_prologue(F, P); if (BOTH(0)) GRID_BAR(); }
    if (IN(1)) {
        pg8::Gemm g{XB, (const bf16*)(ws + WS_WIN), M, NIN, DM}; pg8::StaticOrder S; S.init(M, NIN, F.G, (int)blockIdx.x);
        EpiIn E{ZB, (const float*)(ws + WS_RSTDX), (const float*)(ws + WS_COS), (const float*)(ws + WS_SIN), P.g_q, P.g_k, P.out};
        pg8::gemm_phase<EpiIn, pg8::StaticOrder, true, true>(F.lds + RING_OFF, g, S, E);
        if (BOTH(1)) GRID_BAR();
    }
    if (IN(2)) {
        for (int it = F.vcu; it < 384; it += F.G) { if (it < 256) retU_item(F, P, false, it >> 2, it & 3); else retU_item(F, P, true, (it - 256) >> 2, (it - 256) & 3); }
        for (int it = F.vcu; it < 768; it += F.G) { if (it < 512) attn_unit(F, P, false, it & 63, it >> 6); else attn_unit(F, P, true, (it - 512) >> 3, (it - 512) & 7); }
        if (BOTH(2)) GRID_BAR();
    }
    if (IN(3)) { ret_scan(F, P); if (BOTH(3)) GRID_BAR(); }
    if (IN(4)) {
        for (int it = F.vcu; it < 384; it += F.G) { if (it < 256) retO_item(F, P, false, it >> 2, it & 3); else retO_item(F, P, true, (it - 256) >> 2, (it - 256) & 3); }
        __syncthreads();
        if (BOTH(4)) GRID_BAR();
    }
    if (IN(5)) {
        TailSched S{P, F.ctl, F.MISC + 16, 0, 0, 0, 0u, 0u};
        pg8::gemm_stream<TailSched>(F.lds + RING_OFF, S);
    }
#undef IN
#undef BOTH
}

extern "C" void kernel_launch(void* const* d_in, const int* in_sizes, int n_in, void* d_out, int out_size, void* d_ws, size_t ws_size, hipStream_t stream) {
    static int grid = 0;
    if (grid == 0) {
        if (n_in != 21 || out_size != (int)OUT_TOTAL || ws_size < WS_END) { fprintf(stderr, "kernel_launch: unexpected shapes n_in %d out %d ws %zu\n", n_in, out_size, ws_size); grid = -1; return; }
#if MK_ONE_LAUNCH
        if (hipFuncSetAttribute((const void*)skel_fwd<0x3f>, hipFuncAttributeMaxDynamicSharedMemorySize, LDS_BYTES) != hipSuccess) { fprintf(stderr, "kernel_launch: hipFuncSetAttribute failed\n"); grid = -1; return; }
#else
#define SETATTR(ph) (void)hipFuncSetAttribute((const void*)skel_fwd<(1 << (ph))>, hipFuncAttributeMaxDynamicSharedMemorySize, LDS_BYTES)
        SETATTR(0); SETATTR(1); SETATTR(2); SETATTR(3); SETATTR(4); SETATTR(5); SETATTR(6); SETATTR(7); SETATTR(8); SETATTR(9);
#endif
        int dev = 0, cus = 0;
        if (hipGetDevice(&dev) != hipSuccess || hipDeviceGetAttribute(&cus, hipDeviceAttributeMultiprocessorCount, dev) != hipSuccess) { grid = -1; return; }
        (void)hipGetLastError();
        grid = cus;
    }
    if (grid < 0) return;
    (void)hipMemsetAsync((char*)d_ws + WS_CTL, 0, CTL_ZERO_BYTES, stream);
    Args a{};
    for (int i = 0; i < 21; ++i) a.in[i] = (const float*)d_in[i];
    a.out = (float*)d_out; a.ws = (unsigned char*)d_ws;
#if MK_ONE_LAUNCH
    a.ph_lo = 0; a.ph_hi = NPH;
    hipLaunchKernelGGL(skel_fwd<0x3f>, dim3(grid), dim3(NTHR), LDS_BYTES, stream, a);
#else
#define LAUNCH_PH(ph) do { a.ph_lo = (ph); a.ph_hi = (ph) + 1; hipLaunchKernelGGL(skel_fwd<(1 << (ph))>, dim3(grid), dim3(NTHR), LDS_BYTES, stream, a); } while (0)
    LAUNCH_PH(0); LAUNCH_PH(1); LAUNCH_PH(2); LAUNCH_PH(3); LAUNCH_PH(4); LAUNCH_PH(5); LAUNCH_PH(6); LAUNCH_PH(7); LAUNCH_PH(8); LAUNCH_PH(9);
#endif
}
```

```cpp
#include <hip/hip_runtime.h>
#include <cstdio>
#include <cstdint>
namespace pg8 {
#define PG8_LAS __attribute__((address_space(3)))
typedef unsigned short bf16_t;
typedef short bf16x8 __attribute__((ext_vector_type(8)));
typedef float f32x4 __attribute__((ext_vector_type(4)));
typedef unsigned u32x4 __attribute__((ext_vector_type(4)));
constexpr int BM = 256, BK = 64, HALF = 128, HTB = HALF * BK * 2  , STAGE_BYTES = 8 * HTB, NXCD = 8, WGM = 8;

__host__ __device__ __forceinline__ int lds_byte(int r, int c) { const int st = (r >> 4) * 2 + (c >> 5), rr = r & 15, cc = c & 31, ob = rr * 64 + cc * 2; return st * 1024 + (ob ^ (((ob >> 9) & 1) << 5)); }
__host__ __device__ __forceinline__ void stage_rc(int b, int& R, int& C) { const int st = b / 1024, sb = b % 1024, swz = sb ^ (((sb >> 9) & 1) << 5); R = (st >> 1) * 16 + swz / 64; C = (st & 1) * 32 + (swz % 64) / 2; }
__host__ __device__ __forceinline__ int perm32(int rho) { const int n = rho >> 4, i = rho & 15; return 8 * (i >> 2) + 4 * n + (i & 3); }

struct Unit { int pm, pn; };
struct Gemm { const bf16_t* A; const bf16_t* Bt; int M, N, K; };

struct StaticOrder {
    int nM, nN, nwg, G, c;
    __host__ __device__ void init(int M, int N, int G_, int c_) { nM = M / BM; nN = N / BM; nwg = nM * nN; G = G_; c = c_; }
    __host__ __device__ bool next(int i, Unit& u) const {
        const long L = (long)i * G + c; if (L >= nwg) return false;
        int wgid = (int)L; { const int q = nwg / NXCD, r = nwg % NXCD, xcd = wgid % NXCD, off = wgid / NXCD; wgid = (xcd < r ? xcd * (q + 1) : r * (q + 1) + (xcd - r) * q) + off; }
        const int nig = WGM * nN, gid = wgid / nig, fm = gid * WGM, gsz = (nM - fm) < WGM ? (nM - fm) : WGM;
        u.pm = fm + ((wgid % nig) % gsz); u.pn = (wgid % nig) / gsz; return true;
    }
    __device__ __forceinline__ void a_ready(const Unit&) const {}
    __device__ __forceinline__ void done(const Unit&) const {}
};

__device__ __forceinline__ unsigned cvt_pk_bf16(float lo, float hi) { unsigned r; asm volatile("v_cvt_pk_bf16_f32 %0, %1, %2" : "=v"(r) : "v"(lo), "v"(hi)); return r; }
typedef float f32x2 __attribute__((ext_vector_type(2)));
template <class Epi, class Sched, bool ALIGN_EPI = false, bool SP2 = false>
__device__ __forceinline__ void gemm_phase(PG8_LAS unsigned char* lds, const Gemm g, const Sched& S, const Epi& E) {
    int tid_ = threadIdx.x; asm volatile("" : "+v"(tid_));
    const int tid = tid_, wid = __builtin_amdgcn_readfirstlane(tid >> 6), lane = tid & 63, wr = wid >> 2, wc = wid & 3, fr = lane & 15, fq = lane >> 4;
    const int K = g.K, nt = K / BK;
    unsigned voffA[2], voffB[2];
#pragma unroll
    for (int i = 0; i < 2; ++i) { int R, C; stage_rc(tid * 16 + i * 8192, R, C); const int Rb = Epi::PERM ? ((R & ~31) + perm32(R & 31)) : R;
        voffA[i] = (unsigned)(R * K + C) * 2u; voffB[i] = (unsigned)(Rb * K + C) * 2u; }
    const size_t kstep = (size_t)(BK * 2);
    const size_t hstep = (size_t)HALF * K * 2;
    const size_t tstep = 2 * hstep;
    const unsigned ldsw = (unsigned)wid * 1024u;
    const int aoff = lds_byte(wr * 64 + fr, fq * 8), boff = lds_byte(wc * 32 + fr, fq * 8);
#define PG8_SA(b, h) (((b) * 2 + (h)) * HTB)
#define PG8_SB(b, h) ((4 + (b) * 2 + (h)) * HTB)
#define PG8_STAGE(bufoff, gbase, voff) do { _Pragma("unroll") for (int _i = 0; _i < 2; ++_i) \
        __builtin_amdgcn_global_load_lds((const unsigned*)((const char*)(gbase) + (voff)[_i]), (PG8_LAS unsigned*)(lds + (bufoff) + ldsw + _i * 8192), 16, 0, 0); } while (0)
#define PG8_LDA(dst, b, h) do { _Pragma("unroll") for (int m = 0; m < 4; ++m) _Pragma("unroll") for (int k = 0; k < 2; ++k) dst[m][k] = *(const PG8_LAS bf16x8*)(lds + PG8_SA(b, h) + aoff + m * 2048 + k * 1024); } while (0)
#define PG8_LDB(dst, b, h) do { _Pragma("unroll") for (int n = 0; n < 2; ++n) _Pragma("unroll") for (int k = 0; k < 2; ++k) dst[n][k] = *(const PG8_LAS bf16x8*)(lds + PG8_SB(b, h) + boff + n * 2048 + k * 1024); } while (0)
#define PG8_MMA(ai, bj, At, Bt) do { __builtin_amdgcn_s_setprio(1); _Pragma("unroll") for (int m = 0; m < 4; ++m) _Pragma("unroll") for (int n = 0; n < 2; ++n) _Pragma("unroll") for (int k = 0; k < 2; ++k) \
        acc[ai][bj][m][n] = __builtin_amdgcn_mfma_f32_16x16x32_bf16(Bt[n][k], At[m][k], acc[ai][bj][m][n], 0, 0, 0); __builtin_amdgcn_s_setprio(0); } while (0)
#define PG8_WAIT_V(n) asm volatile("s_waitcnt vmcnt(" #n ")" ::: "memory")
#define PG8_WAIT_L(n) asm volatile("s_waitcnt lgkmcnt(" #n ")" ::: "memory")
#define PG8_BAR __builtin_amdgcn_s_barrier()
#define PG8_SCHED __builtin_amdgcn_sched_barrier(0)
    Unit cur, nxt; int ui = 0;
    if (!S.next(0, cur)) return;
    f32x4 acc[2][2][4][2];
#pragma unroll
    for (int a = 0; a < 2; ++a)
#pragma unroll
        for (int b = 0; b < 2; ++b)
#pragma unroll
            for (int m = 0; m < 4; ++m)
#pragma unroll
                for (int n = 0; n < 2; ++n) acc[a][b][m][n] = (f32x4){0.f, 0.f, 0.f, 0.f};
    bf16x8 At[4][2], B0[2][2], B1[2][2];
    const char* cA = (const char*)g.A + (size_t)cur.pm * tstep; const char* cB = (const char*)g.Bt + (size_t)cur.pn * tstep;
    S.a_ready(cur);
    if constexpr (SP2) {
        PG8_STAGE(PG8_SB(0, 0), cB, voffB); PG8_STAGE(PG8_SB(0, 1), cB + hstep, voffB); PG8_STAGE(PG8_SA(0, 0), cA, voffA); PG8_STAGE(PG8_SA(0, 1), cA + hstep, voffA);
        if (wr == 1) PG8_BAR;
        PG8_WAIT_V(2); PG8_BAR;
        PG8_STAGE(PG8_SB(1, 0), cB + kstep, voffB); PG8_STAGE(PG8_SA(1, 0), cA + kstep, voffA); PG8_STAGE(PG8_SB(1, 1), cB + hstep + kstep, voffB);
        PG8_WAIT_V(6); PG8_BAR;
    } else {
        PG8_STAGE(PG8_SB(0, 0), cB, voffB); PG8_STAGE(PG8_SA(0, 0), cA, voffA); PG8_STAGE(PG8_SB(0, 1), cB + hstep, voffB); PG8_STAGE(PG8_SA(0, 1), cA + hstep, voffA);
        if (wr == 1) PG8_BAR;
        PG8_WAIT_V(4); PG8_BAR;
        PG8_STAGE(PG8_SB(1, 0), cB + kstep, voffB); PG8_STAGE(PG8_SA(1, 0), cA + kstep, voffA); PG8_STAGE(PG8_SB(1, 1), cB + hstep + kstep, voffB);
        PG8_WAIT_V(6); PG8_BAR;
    }
    for (;;) {
        const bool has_next = S.next(ui + 1, nxt);
        const char* nA = has_next ? (const char*)g.A + (size_t)nxt.pm * tstep : cA; const char* nB = has_next ? (const char*)g.Bt + (size_t)nxt.pn * tstep : cB;
        for (int t = 0; t < nt; t += 2) {
            const bool last = (t == nt - 2);
            const char* a1 = cA + (size_t)(t + 1) * kstep;
            const char* a2 = last ? nA : cA + (size_t)(t + 2) * kstep; const char* b2 = last ? nB : cB + (size_t)(t + 2) * kstep;
            const char* a3 = a2 + kstep; const char* b3 = b2 + kstep;
            if (last && has_next) S.a_ready(nxt);
            if constexpr (SP2) {
            PG8_LDB(B0, 0, 0); PG8_LDB(B1, 0, 1); PG8_SCHED; PG8_LDA(At, 0, 0); PG8_STAGE(PG8_SA(1, 1), a1 + hstep, voffA);
            PG8_WAIT_V(8); PG8_WAIT_L(0); PG8_BAR; PG8_MMA(0, 0, At, B0); PG8_MMA(0, 1, At, B1); PG8_BAR; PG8_SCHED;
            PG8_LDA(At, 0, 1); PG8_STAGE(PG8_SB(0, 0), b2, voffB); PG8_STAGE(PG8_SB(0, 1), b2 + hstep, voffB); PG8_STAGE(PG8_SA(0, 0), a2, voffA);
            PG8_WAIT_V(8); PG8_WAIT_L(0); PG8_BAR; PG8_MMA(1, 0, At, B0); PG8_MMA(1, 1, At, B1); PG8_BAR; PG8_SCHED;
            PG8_LDB(B0, 1, 0); PG8_LDB(B1, 1, 1); PG8_SCHED; PG8_LDA(At, 1, 0); PG8_STAGE(PG8_SA(0, 1), a2 + hstep, voffA);
            PG8_WAIT_V(8); PG8_WAIT_L(0); PG8_BAR; PG8_MMA(0, 0, At, B0); PG8_MMA(0, 1, At, B1); PG8_BAR; PG8_SCHED;
            PG8_LDA(At, 1, 1); PG8_STAGE(PG8_SB(1, 0), b3, voffB); PG8_STAGE(PG8_SB(1, 1), b3 + hstep, voffB); PG8_STAGE(PG8_SA(1, 0), a3, voffA);
            PG8_WAIT_V(8); PG8_WAIT_L(0); PG8_BAR; PG8_MMA(1, 0, At, B0); PG8_MMA(1, 1, At, B1); PG8_BAR; PG8_SCHED;
            } else {
            PG8_LDB(B0, 0, 0); PG8_SCHED; PG8_LDA(At, 0, 0); PG8_STAGE(PG8_SA(1, 1), a1 + hstep, voffA);
            PG8_WAIT_L(8); PG8_BAR; PG8_WAIT_L(0); PG8_MMA(0, 0, At, B0); PG8_BAR; PG8_SCHED;
            PG8_LDB(B1, 0, 1); PG8_STAGE(PG8_SB(0, 0), b2, voffB);
            PG8_BAR; PG8_WAIT_L(0); PG8_MMA(0, 1, At, B1); PG8_BAR;
            PG8_LDA(At, 0, 1); PG8_STAGE(PG8_SA(0, 0), a2, voffA);
            PG8_BAR; PG8_WAIT_L(0); PG8_MMA(1, 0, At, B0); PG8_BAR; PG8_SCHED;
            PG8_STAGE(PG8_SB(0, 1), b2 + hstep, voffB);
            PG8_WAIT_V(6); PG8_BAR; PG8_MMA(1, 1, At, B1); PG8_BAR;
            PG8_LDB(B0, 1, 0); PG8_SCHED; PG8_LDA(At, 1, 0); PG8_STAGE(PG8_SA(0, 1), a2 + hstep, voffA);
            PG8_WAIT_L(8); PG8_BAR; PG8_WAIT_L(0); PG8_MMA(0, 0, At, B0); PG8_BAR; PG8_SCHED;
            PG8_LDB(B1, 1, 1); PG8_STAGE(PG8_SB(1, 0), b3, voffB);
            PG8_BAR; PG8_WAIT_L(0); PG8_MMA(0, 1, At, B1); PG8_BAR;
            PG8_LDA(At, 1, 1); PG8_STAGE(PG8_SA(1, 0), a3, voffA);
            PG8_BAR; PG8_WAIT_L(0); PG8_MMA(1, 0, At, B0); PG8_BAR; PG8_SCHED;
            PG8_STAGE(PG8_SB(1, 1), b3 + hstep, voffB);
            PG8_WAIT_V(6); PG8_BAR; PG8_MMA(1, 1, At, B1); PG8_BAR;
            }
        }
        if constexpr (ALIGN_EPI) { if (wr == 0) PG8_BAR; }
        if constexpr (!Epi::AFTER_DRAIN) { E(acc, cur, wr, wc, fr, fq); S.done(cur); }
        if (!has_next) break;
#pragma unroll
        for (int a = 0; a < 2; ++a)
#pragma unroll
            for (int b = 0; b < 2; ++b)
#pragma unroll
                for (int m = 0; m < 4; ++m)
#pragma unroll
                    for (int n = 0; n < 2; ++n) acc[a][b][m][n] = (f32x4){0.f, 0.f, 0.f, 0.f};
        cur = nxt; cA = nA; cB = nB; ++ui;
        if constexpr (ALIGN_EPI) { if (wr == 1) PG8_BAR; }
    }
    PG8_WAIT_V(0);
    if constexpr (!ALIGN_EPI) { if (wr == 0) PG8_BAR; }
    PG8_BAR;
    if constexpr (Epi::AFTER_DRAIN) { E.fused(acc, cur, wr, wc, fr, fq, lds, wid, lane); S.done(cur); }
#undef PG8_SA
#undef PG8_SB
#undef PG8_STAGE
#undef PG8_LDA
#undef PG8_LDB
#undef PG8_MMA
#undef PG8_WAIT_V
#undef PG8_WAIT_L
#undef PG8_BAR
#undef PG8_SCHED
}
}
namespace pg8 {
struct SUnit { int kind, pm, pn; };
struct SGeo { const char* A; const char* B; unsigned ld, hstep; int nt; };

template <class Sched>
__device__ __forceinline__ void gemm_stream(PG8_LAS unsigned char* lds, Sched& S) {
    int tid_ = threadIdx.x; asm volatile("" : "+v"(tid_));
    const int tid = tid_, wid = __builtin_amdgcn_readfirstlane(tid >> 6), lane = tid & 63, wr = wid >> 2, wc = wid & 3, fr = lane & 15, fq = lane >> 4;
    unsigned RA2[2], RB2[2], C2[2];
#pragma unroll
    for (int i = 0; i < 2; ++i) { int R, C; stage_rc(tid * 16 + i * 8192, R, C); const int Rb = (R & ~31) + perm32(R & 31); RA2[i] = 2u * R; RB2[i] = 2u * Rb; C2[i] = 2u * C; }
    const size_t kstep = (size_t)(BK * 2);
    const unsigned ldsw = (unsigned)wid * 1024u;
    const int aoff = lds_byte(wr * 64 + fr, fq * 8), boff = lds_byte(wc * 32 + fr, fq * 8);
#define PG8_SA(b, h) (((b) * 2 + (h)) * HTB)
#define PG8_SB(b, h) ((4 + (b) * 2 + (h)) * HTB)
#ifndef STA_AUX
#define STA_AUX 0
#endif
#define PG8_STA(bufoff, gbase, ld_) do { _Pragma("unroll") for (int _i = 0; _i < 2; ++_i) \
        __builtin_amdgcn_global_load_lds((const unsigned*)((const char*)(gbase) + (RA2[_i] * (ld_) + C2[_i])), (PG8_LAS unsigned*)(lds + (bufoff) + ldsw + _i * 8192), 16, 0, STA_AUX); } while (0)
#define PG8_STB(bufoff, gbase, ld_) do { _Pragma("unroll") for (int _i = 0; _i < 2; ++_i) \
        __builtin_amdgcn_global_load_lds((const unsigned*)((const char*)(gbase) + (RB2[_i] * (ld_) + C2[_i])), (PG8_LAS unsigned*)(lds + (bufoff) + ldsw + _i * 8192), 16, 0, 0); } while (0)
#define PG8_LDA(dst, b, h) do { _Pragma("unroll") for (int m = 0; m < 4; ++m) _Pragma("unroll") for (int k = 0; k < 2; ++k) dst[m][k] = *(const PG8_LAS bf16x8*)(lds + PG8_SA(b, h) + aoff + m * 2048 + k * 1024); } while (0)
#define PG8_LDB(dst, b, h) do { _Pragma("unroll") for (int n = 0; n < 2; ++n) _Pragma("unroll") for (int k = 0; k < 2; ++k) dst[n][k] = *(const PG8_LAS bf16x8*)(lds + PG8_SB(b, h) + boff + n * 2048 + k * 1024); } while (0)
#define PG8_MMA(ai, bj, At, Bt) do { __builtin_amdgcn_s_setprio(1); _Pragma("unroll") for (int m = 0; m < 4; ++m) _Pragma("unroll") for (int n = 0; n < 2; ++n) _Pragma("unroll") for (int k = 0; k < 2; ++k) \
        acc[ai][bj][m][n] = __builtin_amdgcn_mfma_f32_16x16x32_bf16(Bt[n][k], At[m][k], acc[ai][bj][m][n], 0, 0, 0); __builtin_amdgcn_s_setprio(0); } while (0)
#define PG8_WAIT_V(n) asm volatile("s_waitcnt vmcnt(" #n ")" ::: "memory")
#define PG8_WAIT_L(n) asm volatile("s_waitcnt lgkmcnt(" #n ")" ::: "memory")
#define PG8_BAR __builtin_amdgcn_s_barrier()
#define PG8_SCHED __builtin_amdgcn_sched_barrier(0)
    SUnit cur, nxt;
    if (!S.first(cur, wid, lane)) return;
    f32x4 acc[2][2][4][2];
#pragma unroll
    for (int a = 0; a < 2; ++a)
#pragma unroll
        for (int b = 0; b < 2; ++b)
#pragma unroll
            for (int m = 0; m < 4; ++m)
#pragma unroll
                for (int n = 0; n < 2; ++n) acc[a][b][m][n] = (f32x4){0.f, 0.f, 0.f, 0.f};
    bf16x8 At[4][2], B0[2][2], B1[2][2];
    for (;;) {
        S.wait_ready(cur, lane);
        SGeo gc = S.geo(cur);
        PG8_STB(PG8_SB(0, 0), gc.B, gc.ld); PG8_STB(PG8_SB(0, 1), gc.B + gc.hstep, gc.ld); PG8_STA(PG8_SA(0, 0), gc.A, gc.ld); PG8_STA(PG8_SA(0, 1), gc.A + gc.hstep, gc.ld);
        if (wr == 1) PG8_BAR;
        PG8_WAIT_V(2); PG8_BAR;
        PG8_STB(PG8_SB(1, 0), gc.B + kstep, gc.ld); PG8_STA(PG8_SA(1, 0), gc.A + kstep, gc.ld); PG8_STB(PG8_SB(1, 1), gc.B + gc.hstep + kstep, gc.ld);
        PG8_WAIT_V(6); PG8_BAR;
        bool finished = false;
        for (;;) {
            bool has_next = false, ready = false; SGeo gn = gc;
            const int nt = gc.nt, tprobe = nt >= 6 ? nt - 4 : 0;
            for (int t = 0; t < nt; t += 2) {
                const bool last = (t == nt - 2);
                if (t == tprobe) S.probe(cur, wid, lane);
                if (last) { has_next = S.peek(cur, nxt, ready); if (has_next && ready) gn = S.geo(nxt); }
                const char* a1 = gc.A + (size_t)(t + 1) * kstep;
                const char* a2 = last ? gn.A : gc.A + (size_t)(t + 2) * kstep; const char* b2 = last ? gn.B : gc.B + (size_t)(t + 2) * kstep;
                const unsigned ld2 = last ? gn.ld : gc.ld, hs2 = last ? gn.hstep : gc.hstep;
                const char* a3 = a2 + kstep; const char* b3 = b2 + kstep;
                PG8_LDB(B0, 0, 0); PG8_LDB(B1, 0, 1); PG8_SCHED; PG8_LDA(At, 0, 0); PG8_STA(PG8_SA(1, 1), a1 + gc.hstep, gc.ld);
                PG8_WAIT_V(8); PG8_WAIT_L(0); PG8_BAR; PG8_MMA(0, 0, At, B0); PG8_MMA(0, 1, At, B1); PG8_BAR; PG8_SCHED;
                PG8_LDA(At, 0, 1); PG8_STB(PG8_SB(0, 0), b2, ld2); PG8_STB(PG8_SB(0, 1), b2 + hs2, ld2); PG8_STA(PG8_SA(0, 0), a2, ld2);
                PG8_WAIT_V(8); PG8_WAIT_L(0); PG8_BAR; PG8_MMA(1, 0, At, B0); PG8_MMA(1, 1, At, B1); PG8_BAR; PG8_SCHED;
                PG8_LDB(B0, 1, 0); PG8_LDB(B1, 1, 1); PG8_SCHED; PG8_LDA(At, 1, 0); PG8_STA(PG8_SA(0, 1), a2 + hs2, ld2);
                PG8_WAIT_V(8); PG8_WAIT_L(0); PG8_BAR; PG8_MMA(0, 0, At, B0); PG8_MMA(0, 1, At, B1); PG8_BAR; PG8_SCHED;
                PG8_LDA(At, 1, 1); PG8_STB(PG8_SB(1, 0), b3, ld2); PG8_STB(PG8_SB(1, 1), b3 + hs2, ld2); PG8_STA(PG8_SA(1, 0), a3, ld2);
                PG8_WAIT_V(8); PG8_WAIT_L(0); PG8_BAR; PG8_MMA(1, 0, At, B0); PG8_MMA(1, 1, At, B1); PG8_BAR; PG8_SCHED;
            }
            if (wr == 0) PG8_BAR;
            S.epilogue(acc, cur, has_next, nxt, wr, wc, fr, fq, wid, lane);
            if (!has_next) { finished = true; break; }
#pragma unroll
            for (int a = 0; a < 2; ++a)
#pragma unroll
                for (int b = 0; b < 2; ++b)
#pragma unroll
                    for (int m = 0; m < 4; ++m)
#pragma unroll
                        for (int n = 0; n < 2; ++n) acc[a][b][m][n] = (f32x4){0.f, 0.f, 0.f, 0.f};
            cur = nxt;
            if (!ready) break;
            gc = gn;
            if (wr == 1) PG8_BAR;
        }
        PG8_WAIT_V(0); PG8_BAR;
        if (finished) break;
    }
#undef PG8_SA
#undef PG8_SB
#undef PG8_STA
#undef PG8_STB
#undef PG8_LDA
#undef PG8_LDB
#undef PG8_MMA
#undef PG8_WAIT_V
#undef PG8_WAIT_L
#undef PG8_BAR
#undef PG8_SCHED
}
}

#define GAS __attribute__((address_space(1)))
#define LAS __attribute__((address_space(3)))
typedef unsigned short bf16;
typedef unsigned v4u __attribute__((ext_vector_type(4)));
typedef float f32x4 __attribute__((ext_vector_type(4)));
typedef short bf16x8 __attribute__((ext_vector_type(8)));
typedef GAS unsigned gu32;
typedef GAS unsigned long long gu64;
#define RLX_AGENT __ATOMIC_RELAXED, __HIP_MEMORY_SCOPE_AGENT
#define LDS_WAIT() asm volatile("s_waitcnt lgkmcnt(0)" ::: "memory")
#define VM_WAIT() asm volatile("s_waitcnt vmcnt(0)" ::: "memory")
__device__ __forceinline__ unsigned long long rt() { return __builtin_amdgcn_s_memrealtime(); }
__device__ __forceinline__ unsigned f2bf(float f) { unsigned u = __builtin_bit_cast(unsigned, f); return (u + 0x7fffu + ((u >> 16) & 1u)) >> 16; }
__device__ __forceinline__ unsigned pk2(float lo, float hi) { return f2bf(lo) | (f2bf(hi) << 16); }

#define XB_TMO      128
#define XB_XCNT(j)  (256  + 64 * (j))
#define XB_XSUB(j)  (1280 + 64 * (j))
#define XB_XGEN(j)  (2304 + 64 * (j))
#define XB_TOP      3328
#define XB_TOPGEN   3392
#define XCD_BAR_WORDS 3456
#define XB_SPIN_CAP (1u << 18)

__device__ __forceinline__ unsigned xb_ld(unsigned* p)              { return __hip_atomic_load(p, __ATOMIC_RELAXED, __HIP_MEMORY_SCOPE_AGENT); }
__device__ __forceinline__ unsigned xb_add(unsigned* p, unsigned v) { return __hip_atomic_fetch_add(p, v, __ATOMIC_RELAXED, __HIP_MEMORY_SCOPE_AGENT); }
__device__ __forceinline__ unsigned xb_xcc_id() { return (unsigned)__builtin_amdgcn_s_getreg((3 << 11) | 20) & 0xFu; }
#define XB_SPIN(cond, bar) do { unsigned _sp = 0; while (cond) { __builtin_amdgcn_s_sleep(1); \
    if ((++_sp & 255u) == 0u) { if (xb_ld(&(bar)[XB_TMO])) break; if (_sp > XB_SPIN_CAP) { atomicAdd(&(bar)[XB_TMO], 1u); break; } } } } while (0)

struct XcdBarrier {
    unsigned* bar; unsigned x;
    volatile LAS unsigned* st;
};

__device__ __forceinline__ XcdBarrier xcd_barrier_post(unsigned* bar, volatile LAS unsigned* st) {
    XcdBarrier b; b.bar = bar; b.x = xb_xcc_id(); b.st = st;
    if (threadIdx.x == 0) (void)xb_add(&bar[XB_XCNT(b.x)], 1u);
    return b;
}
__device__ __forceinline__ void xcd_barrier_complete(unsigned* bar, unsigned x, unsigned& nloc, unsigned& nx) {
    const unsigned G = gridDim.x * gridDim.y * gridDim.z;
    unsigned sum, cnt, mine, sp = 0u;
    for (;;) {
        sum = 0u; cnt = 0u; mine = 0u;
#pragma unroll
        for (unsigned j = 0; j < 16; ++j) { const unsigned c = xb_ld(&bar[XB_XCNT(j)]); sum += c; cnt += (c > 0u) ? 1u : 0u; mine = (j == x) ? c : mine; }
        if (sum == G) break;
        __builtin_amdgcn_s_sleep(1);
        if ((++sp & 255u) == 0u) { if (xb_ld(&bar[XB_TMO])) break; if (sp > XB_SPIN_CAP) { atomicAdd(&bar[XB_TMO], 1u); break; } }
    }
    nloc = mine > 0u ? mine : 1u; nx = cnt > 0u ? cnt : 1u;
}

__device__ __forceinline__ void xcd_barrier(const XcdBarrier& b) {
    asm volatile("s_waitcnt vmcnt(0)" ::: "memory");
    __syncthreads();
    if (threadIdx.x == 0) {
        unsigned* bar = b.bar;
        __builtin_amdgcn_s_waitcnt(0);
        unsigned nloc = b.st[0], nx = b.st[1];
        if (nloc == 0u) { xcd_barrier_complete(bar, b.x, nloc, nx); b.st[0] = nloc; b.st[1] = nx; }
        const unsigned old = xb_add(&bar[XB_XSUB(b.x)], 1u);
        const unsigned gen = old / nloc;
        if (old + 1u == (gen + 1u) * nloc) {
            __builtin_amdgcn_fence(__ATOMIC_RELEASE, "agent");
            asm volatile("s_waitcnt vmcnt(0)" ::: "memory");
            const unsigned og = xb_add(&bar[XB_TOP], 1u);
            const unsigned tg = og / nx;
            if (og + 1u == (tg + 1u) * nx) xb_add(&bar[XB_TOPGEN], 1u);
            else XB_SPIN(xb_ld(&bar[XB_TOPGEN]) == tg, bar);
            __builtin_amdgcn_fence(__ATOMIC_ACQUIRE, "agent");
            xb_add(&bar[XB_XGEN(b.x)], 1u);
            asm volatile("s_waitcnt vmcnt(0)" ::: "memory");
        } else {
            XB_SPIN(xb_ld(&bar[XB_XGEN(b.x)]) == gen, bar);
            __builtin_amdgcn_fence(__ATOMIC_ACQUIRE, "agent");
            asm volatile("s_waitcnt vmcnt(0)" ::: "memory");
        }
    }
    __syncthreads();
}

constexpr int DM = 1024, MP = 16384, MS = 2048, M = MP + MS;
constexpr int NIN = 3584, FF = 2816, NGU = 2 * FF, PLE = 256, PAST = 2048;
constexpr int NCP = 256, NCS = 32, NCH = NCP + NCS;
constexpr int RH = 4, RD = 128, AH = 8, AD = 64;
constexpr float EPS = 1e-6f, LOG2E = 1.4426950408889634f;
constexpr int ZQ = 0, ZK = 512, ZV = 1024, ZG = 1536, ZQA = 2048, ZKA = 2560, ZVA = 3072;
constexpr size_t OFF_Y = 0, OFF_RP = (size_t)M * DM, OFF_KP = OFF_RP + 65536, OFF_VP = OFF_KP + 262144, OFF_RS = OFF_VP + 262144,
                 OFF_KS = OFF_RS + 2097152, OFF_VS = OFF_KS + 1048576, OUT_TOTAL = OFF_VS + 1048576;
static_assert(OUT_TOTAL == 23658496, "output size");

constexpr size_t MiB = 1u << 20;
constexpr size_t WS_CTL = 0, CTL_ZERO_BYTES = 1 * MiB;
constexpr size_t WS_RSTDX = 1 * MiB, WS_ST1 = 2 * MiB, WS_ST2 = 4 * MiB;
constexpr size_t WS_WIN = 6 * MiB, WS_WOUT = 13 * MiB, WS_WGU = 15 * MiB, WS_WDN = 26 * MiB, WS_WPG = 32 * MiB, WS_WPP = 34 * MiB;
constexpr size_t WS_COS = 35 * MiB, WS_SIN = 39 * MiB, WS_PB = 43 * MiB;
constexpr size_t WS_A = 52 * MiB;
constexpr size_t WS_Z = 88 * MiB;
constexpr size_t WS_UF = 214 * MiB;
constexpr size_t WS_RB = 230 * MiB;
constexpr size_t WS_HB = 88 * MiB;
constexpr size_t WS_T = 124 * MiB;
constexpr size_t WS_END = 246 * MiB;
static_assert(WS_T + (size_t)M * FF * 2 <= WS_END && WS_Z + (size_t)M * NIN * 2 <= WS_UF && WS_HB + (size_t)M * DM * 2 <= WS_T, "ws map");

constexpr int CW_TMO = 0, CW_CODE = 1, CW_BAR = 4096;

using pg8::u32x4; using pg8::bf16_t; using pg8::Unit;
__device__ __forceinline__ u32x4 pack8(f32x4 a, f32x4 b) { u32x4 w; w.x = pg8::cvt_pk_bf16(a[0], a[1]); w.y = pg8::cvt_pk_bf16(a[2], a[3]); w.z = pg8::cvt_pk_bf16(b[0], b[1]); w.w = pg8::cvt_pk_bf16(b[2], b[3]); return w; }
__device__ __forceinline__ float lg2_gamma(int h) { return log2f(1.0f - exp2f(-5.0f - (float)h)); }
__device__ __forceinline__ float bf2f(unsigned short b) { return __uint_as_float((unsigned)b << 16); }
__device__ __forceinline__ float sum4(f32x4 a) { return (a[0] + a[1]) + (a[2] + a[3]); }
__device__ __forceinline__ float rstd16(const float* st, int r) {
    const f32x4* p = (const f32x4*)(st + (size_t)r * 16); const f32x4 a = p[0], b = p[1], c = p[2], d = p[3];
    return rsqrtf(((sum4(a) + sum4(b)) + (sum4(c) + sum4(d))) * (1.0f / DM) + EPS);
}
__device__ __forceinline__ f32x4 sigmoid4(f32x4 g) { f32x4 o;
#pragma unroll
    for (int i = 0; i < 4; ++i) o[i] = __builtin_amdgcn_rcpf(1.0f + __builtin_amdgcn_exp2f(-g[i] * LOG2E));
    return o; }

struct EpiIn {
    static constexpr bool PERM = true, AFTER_DRAIN = false;
    bf16_t* Z; const float* rstd; const float* cosT; const float* sinT; const float* gq; const float* gk; float* dout;
    __device__ __forceinline__ void operator()(const f32x4 (&acc)[2][2][4][2], const Unit& u, int wr, int wc, int fr, int fq) const {
        const int pn = u.pn; const int rbase = u.pm * 256 + wr * 64 + fr;
        if (pn < 4) {
            const int sec = (pn >> 1) * 512, head = 2 * (pn & 1) + (wc >> 1), j0 = (wc & 1) * 32 + fq * 8;
            const float osc = (pn >= 2) ? 0.08838834764831845f : 1.0f; const float lgs = (pn >= 2) ? -lg2_gamma(head) : lg2_gamma(head);
#pragma unroll
            for (int ai = 0; ai < 2; ++ai)
#pragma unroll
                for (int m = 0; m < 4; ++m) {
                    const int r = rbase + ai * 128 + m * 16; const int pos = r < MP ? r : PAST + ((r - MP) & 63); const int nloc = r < MP ? (r & 255) : ((r - MP) & 63);
                    const float rs = rstd[r] * osc * exp2f((float)nloc * lgs);
                    const f32x4 c0 = *(const f32x4*)(cosT + (size_t)pos * 64 + j0), c1 = *(const f32x4*)(cosT + (size_t)pos * 64 + j0 + 4);
                    const f32x4 s0 = *(const f32x4*)(sinT + (size_t)pos * 64 + j0), s1 = *(const f32x4*)(sinT + (size_t)pos * 64 + j0 + 4);
                    const f32x4 x1a = acc[ai][0][m][0] * rs, x1b = acc[ai][0][m][1] * rs, x2a = acc[ai][1][m][0] * rs, x2b = acc[ai][1][m][1] * rs;
                    const f32x4 o1a = x1a * c0 - x2a * s0, o1b = x1b * c1 - x2b * s1, o2a = x1a * s0 + x2a * c0, o2b = x1b * s1 + x2b * c1;
                    bf16_t* dst = Z + (size_t)r * NIN + sec + head * 128 + j0;
                    *(u32x4*)dst = pack8(o1a, o1b); *(u32x4*)(dst + 64) = pack8(o2a, o2b);
                }
        } else if (pn < 8 || pn >= 12) {
#pragma unroll
            for (int ai = 0; ai < 2; ++ai)
#pragma unroll
                for (int m = 0; m < 4; ++m) {
                    const int r = rbase + ai * 128 + m * 16; const float rs = rstd[r];
#pragma unroll
                    for (int bj = 0; bj < 2; ++bj) {
                        const f32x4 v0 = acc[ai][bj][m][0] * rs, v1 = acc[ai][bj][m][1] * rs; const int t = bj * 128 + wc * 32 + fq * 8;
                        *(u32x4*)(Z + (size_t)r * NIN + pn * 256 + t) = pack8(v0, v1);
                        if (pn >= 12) { const int c5 = (pn - 12) * 256 + t;
                            if (r >= MP) { float* o = dout + OFF_VS + (size_t)(r - MP) * 512 + c5; *(f32x4*)o = v0; *(f32x4*)(o + 4) = v1; }
                            else if (r >= MP - 512) { float* o = dout + OFF_VP + (size_t)(r - (MP - 512)) * 512 + c5; *(f32x4*)o = v0; *(f32x4*)(o + 4) = v1; } }
                    }
                }
        } else {
            const float* g = pn < 10 ? gq : gk; f32x4 gv[2][2];
#pragma unroll
            for (int bj = 0; bj < 2; ++bj)
#pragma unroll
                for (int n = 0; n < 2; ++n) gv[bj][n] = *(const f32x4*)(g + bj * 32 + fq * 8 + 4 * n);
#pragma unroll
            for (int ai = 0; ai < 2; ++ai)
#pragma unroll
                for (int m = 0; m < 4; ++m) {
                    const int r = rbase + ai * 128 + m * 16; const float rs = rstd[r]; f32x4 v[2][2]; float ss = 0.f;
#pragma unroll
                    for (int bj = 0; bj < 2; ++bj)
#pragma unroll
                        for (int n = 0; n < 2; ++n) { v[bj][n] = acc[ai][bj][m][n] * rs; ss += sum4(v[bj][n] * v[bj][n]); }
                    ss += __shfl_xor(ss, 16); ss += __shfl_xor(ss, 32);
                    const float inv = rsqrtf(ss * (1.0f / 64.0f) + EPS) * (pn < 10 ? 0.125f * LOG2E : 1.0f);
#pragma unroll
                    for (int bj = 0; bj < 2; ++bj) {
                        const f32x4 o0 = v[bj][0] * inv * gv[bj][0], o1 = v[bj][1] * inv * gv[bj][1]; const int e = wc * 64 + bj * 32 + fq * 8;
                        *(u32x4*)(Z + (size_t)r * NIN + pn * 256 + e) = pack8(o0, o1);
                        if (pn >= 10) { const int c5 = (pn - 10) * 256 + e;
                            if (r >= MP) { float* o = dout + OFF_KS + (size_t)(r - MP) * 512 + c5; *(f32x4*)o = o0; *(f32x4*)(o + 4) = o1; }
                            else if (r >= MP - 512) { float* o = dout + OFF_KP + (size_t)(r - (MP - 512)) * 512 + c5; *(f32x4*)o = o0; *(f32x4*)(o + 4) = o1; } }
                    }
                }
        }
    }
};
struct EpiRes {
    static constexpr bool PERM = true, AFTER_DRAIN = false;
    const float* res_p; const float* res_s; float* out; bf16_t* hb; float* stats;
    __device__ __forceinline__ void operator()(const f32x4 (&acc)[2][2][4][2], const Unit& u, int wr, int wc, int fr, int fq) const {
        const int rbase = u.pm * 256 + wr * 64 + fr;
#pragma unroll
        for (int ai = 0; ai < 2; ++ai)
#pragma unroll
            for (int m = 0; m < 4; ++m) {
                const int r = rbase + ai * 128 + m * 16; const float* rp = r < MP ? res_p + (size_t)r * DM : res_s + (size_t)(r - MP) * DM; float ss = 0.f;
#pragma unroll
                for (int bj = 0; bj < 2; ++bj) {
                    const int c0 = u.pn * 256 + bj * 128 + wc * 32 + fq * 8;
                    const f32x4 h0 = *(const f32x4*)(rp + c0) + acc[ai][bj][m][0], h1 = *(const f32x4*)(rp + c0 + 4) + acc[ai][bj][m][1];
                    float* o = out + (size_t)r * DM + c0; *(f32x4*)o = h0; *(f32x4*)(o + 4) = h1;
                    *(u32x4*)(hb + (size_t)r * DM + c0) = pack8(h0, h1);
                    ss += sum4(h0 * h0) + sum4(h1 * h1);
                }
                ss += __shfl_xor(ss, 16); ss += __shfl_xor(ss, 32);
                if (fq == 0) stats[(size_t)r * 16 + u.pn * 4 + wc] = ss;
            }
    }
};
struct EpiGU {
    static constexpr bool PERM = true, AFTER_DRAIN = false;
    const float* stats; bf16_t* T;
    __device__ __forceinline__ void operator()(const f32x4 (&acc)[2][2][4][2], const Unit& u, int wr, int wc, int fr, int fq) const {
        const int rbase = u.pm * 256 + wr * 64 + fr;
#pragma unroll
        for (int ai = 0; ai < 2; ++ai)
#pragma unroll
            for (int m = 0; m < 4; ++m) {
                const int r = rbase + ai * 128 + m * 16; const float rs = rstd16(stats, r);
                const f32x4 g0 = acc[ai][0][m][0] * rs, g1 = acc[ai][0][m][1] * rs, u0 = acc[ai][1][m][0] * rs, u1 = acc[ai][1][m][1] * rs;
                const f32x4 t0 = g0 * sigmoid4(g0) * u0, t1 = g1 * sigmoid4(g1) * u1;
                *(u32x4*)(T + (size_t)r * FF + u.pn * 128 + wc * 32 + fq * 8) = pack8(t0, t1);
            }
    }
};
struct EpiPP {
    static constexpr bool PERM = true, AFTER_DRAIN = false;
    bf16_t* O;
    __device__ __forceinline__ void operator()(const f32x4 (&acc)[2][2][4][2], const Unit& u, int wr, int wc, int fr, int fq) const {
        const unsigned boff = (unsigned)((u.pm * 256 + wr * 64 + fr) * DM + u.pn * 256 + wc * 32 + fq * 8) * 2u;
#pragma unroll
        for (int ai = 0; ai < 2; ++ai)
#pragma unroll
            for (int m = 0; m < 4; ++m) {
#pragma unroll
                for (int bj = 0; bj < 2; ++bj) *(u32x4*)((char*)O + (boff + (unsigned)((ai * 128 + m * 16) * DM + bj * 128) * 2u)) = pack8(acc[ai][bj][m][0], acc[ai][bj][m][1]);
                asm volatile("" ::: "memory"); }
    }
};
struct EpiPG {
    static constexpr bool PERM = true, AFTER_DRAIN = false;
    const float* stats; const bf16_t* PP; float* y;
    __device__ __forceinline__ void operator()(const f32x4 (&acc)[2][2][4][2], const Unit& u, int wr, int wc, int fr, int fq) const {
        const int rbase = u.pm * 256 + wr * 64 + fr;
#pragma unroll
        for (int ai = 0; ai < 2; ++ai)
#pragma unroll
            for (int m = 0; m < 4; ++m) {
                const int r = rbase + ai * 128 + m * 16; const float rs = rstd16(stats, r);
#pragma unroll
                for (int bj = 0; bj < 2; ++bj) {
                    const int c0 = u.pn * 256 + bj * 128 + wc * 32 + fq * 8; float* o = y + (size_t)r * DM + c0;
                    const u32x4 pw = *(const u32x4*)(PP + (size_t)r * DM + c0);
                    const f32x4 p0 = {__uint_as_float(pw.x << 16), __uint_as_float(pw.x & 0xffff0000u), __uint_as_float(pw.y << 16), __uint_as_float(pw.y & 0xffff0000u)};
                    const f32x4 p1 = {__uint_as_float(pw.z << 16), __uint_as_float(pw.z & 0xffff0000u), __uint_as_float(pw.w << 16), __uint_as_float(pw.w & 0xffff0000u)};
                    const f32x4 y0 = *(const f32x4*)o + p0 * sigmoid4(acc[ai][bj][m][0] * rs), y1 = *(const f32x4*)(o + 4) + p1 * sigmoid4(acc[ai][bj][m][1] * rs);
                    *(f32x4*)o = y0; *(f32x4*)(o + 4) = y1;
                }
            }
    }
};

constexpr int NWAVES = 8, NTHR = 512;
#ifndef MK_ONE_LAUNCH
#define MK_ONE_LAUNCH 1
#endif
constexpr int NPH = 6;
constexpr int RING_OFF = 0, RING_BYTES = 131072, LDSCTL_OFF = RING_BYTES, MISC_OFF = LDSCTL_OFF + 320, LDS_BYTES = 147456;
typedef short s16x8 __attribute__((ext_vector_type(8)));
typedef short s16x4 __attribute__((ext_vector_type(4)));
typedef float f32x16 __attribute__((ext_vector_type(16)));
typedef unsigned u32x2v __attribute__((ext_vector_type(2)));

struct Frame {
    LAS unsigned char* lds; volatile LAS unsigned* MISC; gu32* ctl;
    int tid, lane, wave, vcu, G;
};
__device__ __forceinline__ float wave_sum(float v) {
#pragma unroll
    for (int o = 1; o < 64; o <<= 1) v += __shfl_xor(v, o);
    return v;
}
__device__ __forceinline__ int crow(int r, int hi) { return (r & 3) + 8 * (r >> 2) + 4 * hi; }
__device__ __forceinline__ s16x8 frag(const LAS bf16* X, int ld, int row0, int k0, int lane) { return *(const LAS s16x8*)(X + (row0 + (lane & 31)) * ld + k0 + 8 * (lane >> 5)); }
#define MFMA32(a, b, c) __builtin_amdgcn_mfma_f32_32x32x16_bf16((a), (b), (c), 0, 0, 0)

constexpr int NQ = 306, TK_NONE = 0xffff;
constexpr int CW_TKT = 2048;
constexpr int CW_DEP = 32768;
constexpr size_t WS_TAB = 1 * MiB + 512 * 1024;
__device__ __forceinline__ unsigned enc_unit(int kind, int q, int pn) { return (unsigned)((kind << 12) | (q << 5) | pn); }
__device__ __forceinline__ void build_ticket_table(unsigned short* tab) {
    int o = 0;
    for (int pn = 0; pn < 4; ++pn) for (int q = 0; q < 9; ++q) tab[o++] = (unsigned short)enc_unit(0, q, pn);
    for (int pn = 0; pn < 22; ++pn) tab[o++] = (unsigned short)enc_unit(1, 0, pn);
    int body = 0;
    for (int g = 0; g < 2; ++g) for (int pn = 0; pn < 22; ++pn) for (int j = 0; j < 4; ++j) {
        if (body == 40) for (int c = 0; c < 4; ++c) tab[o++] = (unsigned short)enc_unit(2, 0, c);
        if (body == 126) for (int c = 0; c < 4; ++c) tab[o++] = (unsigned short)enc_unit(3, 0, c);
        tab[o++] = (unsigned short)enc_unit(1, 1 + 4 * g + j, pn); ++body; }
    for (int pn = 0; pn < 4; ++pn) for (int q = 1; q < 9; ++q) tab[o++] = (unsigned short)enc_unit(2, q, pn);
    for (int pn = 0; pn < 4; ++pn) for (int q = 1; q < 9; ++q) tab[o++] = (unsigned short)enc_unit(3, q, pn);
}
__device__ __forceinline__ void tr_item(const float* W, int ldw, int K, int k0, int c0, bf16* WT, int d0, const float* g, LAS float* scr, int lane) {
#pragma unroll 8
    for (int i = 0; i < 32; ++i) { const int kk = 2 * i + (lane >> 5); float v = W[(size_t)(k0 + kk) * ldw + c0 + (lane & 31)]; if (g) v *= g[k0 + kk]; scr[kk * 33 + (lane & 31)] = v; }
    LDS_WAIT(); asm volatile("" ::: "memory");
    const int c = lane & 7;
#pragma unroll
    for (int j = 0; j < 4; ++j) { const int n = (lane >> 3) + 8 * j; const LAS float* s = scr + (8 * c) * 33 + n;
        v4u o; o.x = pk2(s[0 * 33], s[1 * 33]); o.y = pk2(s[2 * 33], s[3 * 33]); o.z = pk2(s[4 * 33], s[5 * 33]); o.w = pk2(s[6 * 33], s[7 * 33]);
        *(GAS v4u*)(WT + (size_t)(d0 + n) * K + k0 + 8 * c) = o; }
    LDS_WAIT(); asm volatile("" ::: "memory");
}
__device__ __forceinline__ int sigma_in(int np) {
    const int pn = np >> 8, t = np & 255;
    if (pn < 4) { const int base = (pn >> 1) * 512 + (pn & 1) * 256, tt = t & 127; return base + (tt >> 6) * 128 + (t >> 7) * 64 + (tt & 63); }
    if (pn >= 8 && pn < 12) return pn * 256 + ((t >> 5) & 3) * 64 + (t >> 7) * 32 + (t & 31);
    return np;
}
struct Ptrs {
    const float *xp, *xs, *ck, *cv, *sr, *pp, *ps, *g_mix, *w_in, *g_ro, *g_q, *g_k, *rel_bias, *w_out, *g_ffn, *w_g, *w_u, *w_d, *g_ple, *w_pg, *w_pp;
    float* out; unsigned char* ws;
};
__device__ __forceinline__ void p0_prologue(Frame& F, const Ptrs& P) {
    LAS float* scr = (LAS float*)(F.lds + RING_OFF + F.wave * 16384);
    const int gw = F.vcu * NWAVES + F.wave, NGW = F.G * NWAVES;
    bf16* Wt_in = (bf16*)(P.ws + WS_WIN); bf16* Wt_out = (bf16*)(P.ws + WS_WOUT); bf16* Wt_gu = (bf16*)(P.ws + WS_WGU);
    bf16* Wt_dn = (bf16*)(P.ws + WS_WDN); bf16* Wt_pg = (bf16*)(P.ws + WS_WPG); bf16* Wt_pp = (bf16*)(P.ws + WS_WPP);
    constexpr int I_IN = 16 * (NIN / 32), I_OUT = 16 * 32, I_GU = 16 * (NGU / 32), I_DN = (FF / 64) * 32, I_PG = 16 * 32, I_PP = 4 * 32;
    constexpr int NITEMS = I_IN + I_OUT + I_GU + I_DN + I_PG + I_PP;
    for (int it = gw; it < NITEMS; it += NGW) {
        int r = it;
        if (r < I_IN) { const int nb = r % (NIN / 32), kb = r / (NIN / 32); tr_item(P.w_in, NIN, DM, 64 * kb, sigma_in(32 * nb), Wt_in, 32 * nb, P.g_mix, scr, F.lane); continue; } r -= I_IN;
        if (r < I_OUT) { const int nb = r % 32, kb = r / 32; tr_item(P.w_out, DM, DM, 64 * kb, 32 * nb, Wt_out, 32 * nb, nullptr, scr, F.lane); continue; } r -= I_OUT;
        if (r < I_GU) { const int nb = r % (NGU / 32), kb = r / (NGU / 32); const int np = 32 * nb, pn = np >> 8, t = np & 255;
            tr_item(t < 128 ? P.w_g : P.w_u, FF, DM, 64 * kb, 128 * pn + (t & 127), Wt_gu, np, P.g_ffn, scr, F.lane); continue; } r -= I_GU;
        if (r < I_DN) { const int nb = r % 32, kb = r / 32; tr_item(P.w_d, DM, FF, 64 * kb, 32 * nb, Wt_dn, 32 * nb, nullptr, scr, F.lane); continue; } r -= I_DN;
        if (r < I_PG) { const int nb = r % 32, kb = r / 32; tr_item(P.w_pg, DM, DM, 64 * kb, 32 * nb, Wt_pg, 32 * nb, P.g_ple, scr, F.lane); continue; } r -= I_PG;
        { const int nb = r % 32, kb = r / 32; tr_item(P.w_pp, DM, PLE, 64 * kb, 32 * nb, Wt_pp, 32 * nb, nullptr, scr, F.lane); }
    }
    bf16* xb = (bf16*)(P.ws + WS_A); float* rstdx = (float*)(P.ws + WS_RSTDX);
    for (int m = gw; m < M; m += NGW) {
        const float* xr = m < MP ? P.xp + (size_t)m * DM : P.xs + (size_t)(m - MP) * DM;
        const GAS f32x4* x4 = (const GAS f32x4*)xr + F.lane; f32x4 v[4]; float s = 0.f;
#pragma unroll
        for (int j = 0; j < 4; ++j) { v[j] = x4[64 * j]; s += sum4(v[j] * v[j]); }
        s = wave_sum(s);
        GAS unsigned long long* o8 = (GAS unsigned long long*)(xb + (size_t)m * DM) + F.lane;
#pragma unroll
        for (int j = 0; j < 4; ++j) o8[64 * j] = (unsigned long long)pk2(v[j].x, v[j].y) | ((unsigned long long)pk2(v[j].z, v[j].w) << 32);
        if (F.lane == 0) rstdx[m] = rsqrtf(s * (1.0f / DM) + EPS);
    }
    bf16* pb = (bf16*)(P.ws + WS_PB);
    for (int m = gw; m < M; m += NGW) {
        const float* pr = m < MP ? P.pp + (size_t)m * PLE : P.ps + (size_t)(m - MP) * PLE;
        const f32x4 v = ((const GAS f32x4*)pr)[F.lane];
        ((GAS unsigned long long*)(pb + (size_t)m * PLE))[F.lane] = (unsigned long long)pk2(v.x, v.y) | ((unsigned long long)pk2(v.z, v.w) << 32);
    }
    if (F.vcu == 0 && F.tid == 0) build_ticket_table((unsigned short*)(P.ws + WS_TAB));
    float* cosT = (float*)(P.ws + WS_COS); float* sinT = (float*)(P.ws + WS_SIN);
    for (int i = (F.vcu * NTHR + F.tid); i < MP * 64; i += F.G * NTHR) {
        const int pos = i >> 6, j = i & 63;
        const float inv = exp2f(-(float)j * (13.287712379549449f / 64.0f));
        const float ang = (float)pos * inv;
        const float k = rintf(ang * 0.15915494309189535f);
        float r = fmaf(-k, 6.28125f, ang); r = fmaf(-k, 1.9353071795864769e-3f, r);
        cosT[i] = __cosf(r); sinT[i] = __sinf(r);
    }
}

typedef short v4i16_t __attribute__((ext_vector_type(4)));
__device__ __forceinline__ s16x4 trrd(const LAS bf16* p) { return __builtin_bit_cast(s16x4, __builtin_amdgcn_ds_read_tr16_b64_v4i16((LAS v4i16_t*)p)); }
__device__ __forceinline__ s16x8 frag_tr(const LAS bf16* X, int ld, int rA, int rB, int c0, int lane) {
    const int i = lane & 15, co = c0 + 16 * ((lane >> 4) & 1) + 4 * (i & 3);
    const s16x4 lo = trrd(X + (rA + (i >> 2)) * ld + co), hh = trrd(X + (rB + (i >> 2)) * ld + co);
    return (s16x8){lo[0], lo[1], lo[2], lo[3], hh[0], hh[1], hh[2], hh[3]};
}
__device__ __forceinline__ s16x8 pack_p(const f32x16& p, int s2) { u32x4 w;
    w.x = pg8::cvt_pk_bf16(p[8 * s2 + 0], p[8 * s2 + 1]); w.y = pg8::cvt_pk_bf16(p[8 * s2 + 2], p[8 * s2 + 3]); w.z = pg8::cvt_pk_bf16(p[8 * s2 + 4], p[8 * s2 + 5]); w.w = pg8::cvt_pk_bf16(p[8 * s2 + 6], p[8 * s2 + 7]);
    return __builtin_bit_cast(s16x8, w); }
__device__ __forceinline__ void unpack8(v4u w, float* f) {
    f[0] = __uint_as_float(w.x << 16); f[1] = __uint_as_float(w.x & 0xffff0000u); f[2] = __uint_as_float(w.y << 16); f[3] = __uint_as_float(w.y & 0xffff0000u);
    f[4] = __uint_as_float(w.z << 16); f[5] = __uint_as_float(w.z & 0xffff0000u); f[6] = __uint_as_float(w.w << 16); f[7] = __uint_as_float(w.w & 0xffff0000u); }
constexpr int LDT = 160;
constexpr int LQ = 136;

constexpr int LKA = 72, LVA = 96;
__device__ __forceinline__ void attn_unit(Frame& F, const Ptrs& P, const bool samp, const int idx, const int h) {
    const bf16* Z = (const bf16*)(P.ws + WS_Z); bf16* MIX = (bf16*)(P.ws + WS_A);
    const int tid = F.tid, lane = F.lane, wave = F.wave, hi = lane >> 5, l31 = lane & 31, wp = wave >> 1, qb = wave & 1;
    LAS bf16* Kb = (LAS bf16*)F.lds; LAS bf16* Vb = Kb + 2 * 64 * LKA; LAS float* BTX = (LAS float*)(F.lds + 43008); LAS float* SC = (LAS float*)(F.lds + 46336) + wave * 32;
    LAS bf16* OS = (LAS bf16*)(F.lds + 47360) + wave * (32 * LKA);
    const int nsteps = samp ? 9 : 12, t0 = samp ? 0 : (idx >= 2 ? 0 : 8 - 4 * idx);
    const int rowq = samp ? MP + 64 * idx + 32 * qb : 256 * idx + 64 * wp + 32 * qb;
    const bool wact = samp ? (wp == 0) : true;
    __syncthreads();
    { const float* rb = P.rel_bias + (size_t)h * 513; const float rb512 = rb[512];
      for (int i = tid; i < 832; i += NTHR) BTX[i] = i <= 512 ? (rb[i] - rb512) * LOG2E : 0.f; }
    s16x8 qf[4];
    { const bf16* qs = Z + (size_t)(rowq + l31) * NIN + ZQA + h * 64 + 8 * hi;
#pragma unroll
      for (int s = 0; s < 4; ++s) qf[s] = wact ? *(const s16x8*)(qs + 16 * s) : (s16x8){0, 0, 0, 0, 0, 0, 0, 0}; }
    const int srow = tid >> 3, sch = tid & 7; v4u kreg, vreg;
#define A_LOAD(t) do { if (samp && (t) < 8) { \
            const float* ks_ = P.ck + ((size_t)(idx * 512 + 64 * (t) + srow) * 8 + h) * 64 + sch * 8; const float* vs_ = P.cv + ((size_t)(idx * 512 + 64 * (t) + srow) * 8 + h) * 64 + sch * 8; \
            const f32x4 a_ = *(const f32x4*)ks_, b_ = *(const f32x4*)(ks_ + 4), c_ = *(const f32x4*)vs_, d_ = *(const f32x4*)(vs_ + 4); \
            kreg = pack8(a_, b_); vreg = pack8(c_, d_); \
        } else { const int kr_ = samp ? MP + 64 * idx + srow : 64 * (4 * idx - 8 + (t)) + srow; const bf16* s_ = Z + (size_t)kr_ * NIN + h * 64 + sch * 8; \
            kreg = *(const v4u*)(s_ + ZKA); vreg = *(const v4u*)(s_ + ZVA); } } while (0)
#define A_STORE(buf) do { *(LAS v4u*)(Kb + (buf) * 64 * LKA + srow * LKA + sch * 8) = kreg; *(LAS v4u*)(Vb + (buf) * 64 * LVA + srow * LVA + sch * 8) = vreg; } while (0)
    f32x16 o0 = {}, o1 = {}; float m_run = 0.f, l_run = 0.f; bool first = true;
    const int b0 = 768 + 32 * qb + l31 - 4 * hi;
    A_LOAD(t0); A_STORE(0); __syncthreads();
    for (int t = t0, it = 0; t < nsteps; ++t, ++it) {
        if (t + 1 < nsteps) A_LOAD(t + 1);
        const int j = samp ? t : t - wp;
        if (wact && j >= 0 && j <= 8) {
            const LAS bf16* Kc = Kb + (it & 1) * 64 * LKA; const LAS bf16* Vc = Vb + (it & 1) * 64 * LVA;
            f32x16 p[2];
#pragma unroll
            for (int lb = 0; lb < 2; ++lb) { f32x16 c;
                if (j >= 4) { const LAS float* bp = BTX + (b0 - 64 * j - 32 * lb);
#pragma unroll
                    for (int r = 0; r < 16; ++r) c[r] = bp[-((r & 3) + 8 * (r >> 2))] - m_run;
                } else {
#pragma unroll
                    for (int r = 0; r < 16; ++r) c[r] = -m_run; }
#pragma unroll
                for (int s = 0; s < 4; ++s) c = MFMA32(frag(Kc, LKA, 32 * lb, 16 * s, lane), qf[s], c);
                p[lb] = c; }
            float mx = p[0][0];
#pragma unroll
            for (int r = 0; r < 16; ++r) { mx = fmaxf(mx, p[0][r]); mx = fmaxf(mx, p[1][r]); }
            mx = fmaxf(mx, __shfl_xor(mx, 32));
            if (first || __any(mx > 8.0f)) {
                const float d = first ? mx : fmaxf(mx, 0.f); m_run += d;
#pragma unroll
                for (int r = 0; r < 16; ++r) { p[0][r] -= d; p[1][r] -= d; }
                if (!first) { const float alpha = exp2f(-d); l_run *= alpha;
                    if (hi == 0) SC[l31] = alpha;
                    asm volatile("s_waitcnt lgkmcnt(0)" ::: "memory");
#pragma unroll
                    for (int r = 0; r < 16; ++r) { const float f = SC[crow(r, hi)]; o0[r] *= f; o1[r] *= f; }
                    asm volatile("s_waitcnt lgkmcnt(0)" ::: "memory"); }
                first = false;
            }
            float ls = 0.f;
#pragma unroll
            for (int r = 0; r < 16; ++r) { p[0][r] = __builtin_amdgcn_exp2f(p[0][r]); p[1][r] = __builtin_amdgcn_exp2f(p[1][r]); ls += p[0][r] + p[1][r]; }
            l_run += ls;
#pragma unroll
            for (int lb = 0; lb < 2; ++lb)
#pragma unroll
                for (int s2 = 0; s2 < 2; ++s2) { const s16x8 pa = pack_p(p[lb], s2); const int kb = 32 * lb + 16 * s2 + 4 * hi;
                    o0 = MFMA32(pa, frag_tr(Vc, LVA, kb, kb + 8, 0, lane), o0); o1 = MFMA32(pa, frag_tr(Vc, LVA, kb, kb + 8, 32, lane), o1); }
        }
        if (t + 1 < nsteps) A_STORE((it + 1) & 1);
        __syncthreads();
    }
#undef A_LOAD
#undef A_STORE
    if (wact) {
        l_run += __shfl_xor(l_run, 32);
        if (hi == 0) SC[l31] = 1.0f / l_run;
        asm volatile("s_waitcnt lgkmcnt(0)" ::: "memory");
#pragma unroll
        for (int r = 0; r < 16; ++r) { const int n = crow(r, hi); const float f = SC[n]; OS[n * LKA + l31] = (bf16)f2bf(o0[r] * f); OS[n * LKA + 32 + l31] = (bf16)f2bf(o1[r] * f); }
        asm volatile("s_waitcnt lgkmcnt(0)" ::: "memory");
        const int row = lane >> 1, half = lane & 1; bf16* dst = MIX + (size_t)(rowq + row) * DM + 512 + h * 64 + 32 * half;
#pragma unroll
        for (int c = 0; c < 4; ++c) *(v4u*)(dst + 8 * c) = *(const LAS v4u*)(OS + row * LKA + 32 * half + 8 * c);
    }
}

__device__ __forceinline__ void retU_item(Frame& F, const Ptrs& P, const bool samp, const int idx, const int h) {
    const bf16* Z = (const bf16*)(P.ws + WS_Z);
    const int tid = F.tid, lane = F.lane, wave = F.wave, hi = lane >> 5, l31 = lane & 31;
    LAS bf16* Vi = (LAS bf16*)F.lds; LAS bf16* Ki = Vi + 128 * LDT;
    const int T = samp ? 64 : 256, row0 = samp ? MP + 64 * idx : 256 * idx;
    const LAS bf16* X = samp ? Ki : Vi; const LAS bf16* Y = samp ? Vi : Ki;
    const int ib = wave >> 1, jb0 = 2 * (wave & 1);
    f32x16 a0 = {}, a1 = {};
    for (int p0 = 0; p0 < T; p0 += 128) {
        const int rows = (T - p0) < 128 ? (T - p0) : 128;
        __syncthreads();
        for (int c = tid; c < rows * 16; c += NTHR) { const int row = c >> 4, ch = c & 15;
            const bf16* src = Z + (size_t)(row0 + p0 + row) * NIN + h * 128 + ch * 8;
            *(LAS v4u*)(Vi + row * LDT + ch * 8) = *(const v4u*)(src + ZV); *(LAS v4u*)(Ki + row * LDT + ch * 8) = *(const v4u*)(src + ZK); }
        __syncthreads();
        for (int s = 0; s < rows / 16; ++s) { const int rA = 16 * s + 8 * hi;
            const s16x8 a = frag_tr(X, LDT, rA, rA + 4, 32 * ib, lane);
            a0 = MFMA32(a, frag_tr(Y, LDT, rA, rA + 4, 32 * jb0, lane), a0); a1 = MFMA32(a, frag_tr(Y, LDT, rA, rA + 4, 32 * jb0 + 32, lane), a1); }
    }
    const float lg2 = lg2_gamma(h), gT1 = exp2f((float)(T - 1) * lg2);
    if (!samp) {
        float* UF = (float*)(P.ws + WS_UF) + (size_t)(idx * 4 + h) * 16384;
#pragma unroll
        for (int r = 0; r < 16; ++r) { const int e = 32 * ib + crow(r, hi); UF[e * 128 + 32 * jb0 + l31] = gT1 * a0[r]; UF[e * 128 + 32 * jb0 + 32 + l31] = gT1 * a1[r]; }
    } else {
        const float g64 = exp2f(64.0f * lg2);
        const float* R0 = P.sr + (size_t)(idx * 4 + h) * 16384; float* RO = P.out + OFF_RS + (size_t)(idx * 4 + h) * 16384;
#pragma unroll
        for (int r = 0; r < 16; ++r) { const int d = 32 * ib + crow(r, hi); const int e0 = 32 * jb0 + l31;
            RO[d * 128 + e0] = g64 * R0[d * 128 + e0] + gT1 * a0[r]; RO[d * 128 + e0 + 32] = g64 * R0[d * 128 + e0 + 32] + gT1 * a1[r]; }
    }
}
__device__ __forceinline__ void ret_scan(Frame& F, const Ptrs& P) {
    const int gid = F.vcu * NTHR + F.tid;
    if (gid < 32768) {
        typedef float f32x2v __attribute__((ext_vector_type(2)));
        const f32x2v* uf = (const f32x2v*)(P.ws + WS_UF) + gid; unsigned* rb = (unsigned*)(P.ws + WS_RB) + gid; const int h = gid >> 13;
        const float g = exp2f(256.0f * lg2_gamma(h)); float R0 = 0.f, R1 = 0.f;
        f32x2v u[64];
#pragma unroll
        for (int c = 0; c < 64; ++c) u[c] = uf[(size_t)c * 32768];
#pragma unroll
        for (int c = 0; c < 64; ++c) { rb[(size_t)c * 32768] = pk2(R0, R1); R0 = g * R0 + u[c].x; R1 = g * R1 + u[c].y; }
        const int el = (2 * gid) & 16383, e = el >> 7, d = el & 127;
        float* o = P.out + OFF_RP + (size_t)h * 16384; o[d * 128 + e] = R0; o[(d + 1) * 128 + e] = R1;
    }
}
__device__ __forceinline__ void retO_item(Frame& F, const Ptrs& P, const bool samp, const int idx, const int h) {
    const bf16* Z = (const bf16*)(P.ws + WS_Z); bf16* MIX = (bf16*)(P.ws + WS_A);
    const int tid = F.tid, lane = F.lane, wave = F.wave, hi = lane >> 5, l31 = lane & 31;
    LAS bf16* RT = (LAS bf16*)F.lds; LAS bf16* Kb = RT + 128 * LQ; LAS bf16* Vb = Kb + 2 * 64 * LQ; LAS bf16* OS = Kb + wave * (32 * LQ);
    const int T = samp ? 64 : 256, row0 = samp ? MP + 64 * idx : 256 * idx, nkb_all = T / 64;
    const int rb = wave < 4 ? wave : 11 - wave; const bool act = rb * 32 < T; const int nkb = act ? (rb >> 1) + 1 : 0;
    const float gam = exp2f(lg2_gamma(h));
    __syncthreads();
    if (!samp) { const bf16* rs = (const bf16*)(P.ws + WS_RB) + (size_t)(idx * 4 + h) * 16384;
#pragma unroll
        for (int i = 0; i < 4; ++i) { const int c = tid + NTHR * i, e = c >> 4, ch = c & 15; *(LAS v4u*)(RT + e * LQ + ch * 8) = *(const v4u*)(rs + e * 128 + ch * 8); }
    } else { const float* rs = P.sr + (size_t)(idx * 4 + h) * 16384;
#pragma unroll
        for (int i = 0; i < 8; ++i) { const int id = i * NTHR + tid, d = id >> 5, e0 = (id & 31) * 4; const f32x4 v = *(const f32x4*)(rs + d * 128 + e0);
            RT[(e0 + 0) * LQ + d] = (bf16)f2bf(v.x); RT[(e0 + 1) * LQ + d] = (bf16)f2bf(v.y); RT[(e0 + 2) * LQ + d] = (bf16)f2bf(v.z); RT[(e0 + 3) * LQ + d] = (bf16)f2bf(v.w); } }
    s16x8 qf[8];
    { const bf16* qs = Z + (size_t)(row0 + (act ? 32 * rb : 0) + l31) * NIN + ZQ + h * 128 + 8 * hi;
#pragma unroll
      for (int s = 0; s < 8; ++s) qf[s] = *(const s16x8*)(qs + 16 * s); }
    v4u kreg[2], vreg[2];
#define R_LOAD(kb) do { _Pragma("unroll") for (int i_ = 0; i_ < 2; ++i_) { const int c_ = tid + NTHR * i_; const bf16* s_ = Z + (size_t)(row0 + 64 * (kb) + (c_ >> 4)) * NIN + h * 128 + (c_ & 15) * 8; \
        kreg[i_] = *(const v4u*)(s_ + ZK); vreg[i_] = *(const v4u*)(s_ + ZV); } } while (0)
#define R_STORE(buf) do { _Pragma("unroll") for (int i_ = 0; i_ < 2; ++i_) { const int c_ = tid + NTHR * i_; \
        *(LAS v4u*)(Kb + (buf) * 64 * LQ + (c_ >> 4) * LQ + (c_ & 15) * 8) = kreg[i_]; *(LAS v4u*)(Vb + (buf) * 64 * LDT + (c_ >> 4) * LDT + (c_ & 15) * 8) = vreg[i_]; } } while (0)
    R_LOAD(0); R_STORE(0); __syncthreads();
    f32x16 acc[4];
#pragma unroll
    for (int eb = 0; eb < 4; ++eb) { f32x16 a = {};
        if (act) {
#pragma unroll
            for (int s = 0; s < 8; ++s) a = MFMA32(qf[s], frag(RT, LQ, 32 * eb, 16 * s, lane), a); }
        acc[eb] = a * gam; }
    for (int kb = 0; kb < nkb_all; ++kb) {
        if (kb + 1 < nkb_all) R_LOAD(kb + 1);
        if (kb < nkb) {
            const LAS bf16* Kc = Kb + (kb & 1) * 64 * LQ; const LAS bf16* Vc = Vb + (kb & 1) * 64 * LDT; const bool diag = (kb == nkb - 1);
#pragma unroll
            for (int lb = 0; lb < 2; ++lb) {
                if (diag && lb == 1 && !(rb & 1)) continue;
                f32x16 p = {};
#pragma unroll
                for (int s = 0; s < 8; ++s) p = MFMA32(frag(Kc, LQ, 32 * lb, 16 * s, lane), qf[s], p);
                if (diag) { const int nl = 32 * (rb & 1) + l31;
#pragma unroll
                    for (int r = 0; r < 16; ++r) if (32 * lb + crow(r, hi) > nl) p[r] = 0.f; }
#pragma unroll
                for (int s2 = 0; s2 < 2; ++s2) { const s16x8 pa = pack_p(p, s2); const int kr = 32 * lb + 16 * s2 + 4 * hi;
#pragma unroll
                    for (int eb = 0; eb < 4; ++eb) acc[eb] = MFMA32(pa, frag_tr(Vc, LDT, kr, kr + 8, 32 * eb, lane), acc[eb]); }
            }
        }
        if (kb + 1 < nkb_all) R_STORE((kb + 1) & 1);
        __syncthreads();
    }
#undef R_LOAD
#undef R_STORE
    if (act) {
#pragma unroll
        for (int eb = 0; eb < 4; ++eb)
#pragma unroll
            for (int r = 0; r < 16; ++r) OS[crow(r, hi) * LQ + 32 * eb + l31] = (bf16)f2bf(acc[eb][r]);
        asm volatile("s_waitcnt lgkmcnt(0)" ::: "memory");
        const int row = lane >> 1, half = lane & 1, grow = row0 + 32 * rb + row;
        v4u ow[8]; float ss = 0.f;
#pragma unroll
        for (int c = 0; c < 8; ++c) { ow[c] = *(const LAS v4u*)(OS + row * LQ + 64 * half + 8 * c); float f[8]; unpack8(ow[c], f);
#pragma unroll
            for (int i = 0; i < 8; ++i) ss += f[i] * f[i]; }
        ss += __shfl_xor(ss, 1);
        const float inv = rsqrtf(ss * (1.0f / 128.0f) + EPS);
        const bf16* gs = Z + (size_t)grow * NIN + ZG + h * 128 + 64 * half; const float* gro = P.g_ro + h * 128 + 64 * half; bf16* dst = MIX + (size_t)grow * DM + h * 128 + 64 * half;
#pragma unroll
        for (int c = 0; c < 8; ++c) { float f[8], g[8]; unpack8(ow[c], f); unpack8(*(const v4u*)(gs + 8 * c), g);
            const f32x4 r0 = *(const f32x4*)(gro + 8 * c), r1 = *(const f32x4*)(gro + 8 * c + 4); f32x4 x0, x1;
#pragma unroll
            for (int i = 0; i < 4; ++i) { x0[i] = g[i] * __builtin_amdgcn_rcpf(1.0f + __builtin_amdgcn_exp2f(-g[i] * LOG2E)) * f[i] * inv * r0[i];
                                          x1[i] = g[4 + i] * __builtin_amdgcn_rcpf(1.0f + __builtin_amdgcn_exp2f(-g[4 + i] * LOG2E)) * f[4 + i] * inv * r1[i]; }
            *(v4u*)(dst + 8 * c) = pack8(x0, x1); }
    }
}

#ifndef ST_AUX
#define ST_AUX 0
#endif
typedef __amdgpu_buffer_rsrc_t rsrc_t;
__device__ __forceinline__ rsrc_t mk_rsrc(const void* p, unsigned bytes) { return __builtin_amdgcn_make_buffer_rsrc((void*)p, 0, (int)bytes, 0x00020000); }
__device__ __forceinline__ f32x4 ld_sc1_f4(rsrc_t r, unsigned off) { return __builtin_bit_cast(f32x4, __builtin_amdgcn_raw_buffer_load_b128(r, (int)off, 0, 16)); }
__device__ __forceinline__ void st_sc1_f4(rsrc_t r, unsigned off, f32x4 v) { __builtin_amdgcn_raw_buffer_store_b128(__builtin_bit_cast(v4u, v), r, (int)off, 0, ST_AUX); }
__device__ __forceinline__ void st_sc1_u4(rsrc_t r, unsigned off, v4u v) { __builtin_amdgcn_raw_buffer_store_b128(v, r, (int)off, 0, ST_AUX); }
__device__ __forceinline__ float rstd16_sc1(rsrc_t r, int row) {
    const f32x4 a = ld_sc1_f4(r, (unsigned)row * 64u), b = ld_sc1_f4(r, (unsigned)row * 64u + 16u), c = ld_sc1_f4(r, (unsigned)row * 64u + 32u), d = ld_sc1_f4(r, (unsigned)row * 64u + 48u);
    return rsqrtf(((sum4(a) + sum4(b)) + (sum4(c) + sum4(d))) * (1.0f / DM) + EPS);
}
struct TailSched {
    const Ptrs& P; gu32* ctl; volatile LAS unsigned* LW;
    int tk_read, tk_fetched, par; unsigned tkv, myq;
    __device__ __forceinline__ gu32* dep(int stage, int pm) const { return ctl + CW_DEP + (stage * 72 + pm) * 64; }
    __device__ __forceinline__ static pg8::SUnit dec(unsigned e) { pg8::SUnit u; u.kind = (int)((e >> 12) & 7u); u.pm = (int)(((e >> 5) & 15u) * 8u + (e >> 16)); u.pn = (int)(e & 31u); return u; }
    __device__ __forceinline__ unsigned tab_entry(unsigned tk) const { const unsigned short* tab = (const unsigned short*)(P.ws + WS_TAB); return (unsigned)__builtin_amdgcn_readfirstlane((int)tab[tk & 511u]) | ((tk >> 9) << 16); }
    __device__ __forceinline__ unsigned fetch_ticket() const {
        const unsigned i = __hip_atomic_fetch_add(ctl + CW_TKT + 64 * myq, 1u, __ATOMIC_RELAXED, __HIP_MEMORY_SCOPE_AGENT);
        return i < (unsigned)NQ ? ((myq << 9) | i) : (unsigned)TK_NONE;
    }
    __device__ __forceinline__ void need_of(const pg8::SUnit& u, int& stage, unsigned& need) const {
        stage = -1; need = 0u;
        if (u.kind == 1) { stage = 0; need = 32u; } else if (u.kind == 2) { stage = 1; need = 176u; } else if (u.kind == 3) { stage = 2; need = 32u; }
    }
    __device__ __forceinline__ bool first(pg8::SUnit& cur, int wid, int lane) {
        tk_read = 1; tk_fetched = 2; par = 0; tkv = 0u; myq = xb_xcc_id() & 7u;
        if (wid == 0 && lane == 0) { const unsigned t0 = fetch_ticket(); const unsigned t1 = (t0 == (unsigned)TK_NONE) ? t0 : fetch_ticket(); LW[0] = t0; LW[1] = t1; }
        __syncthreads();
        const unsigned t0 = LW[0];
        if (t0 == (unsigned)TK_NONE) return false;
        cur = dec(tab_entry(t0)); return true;
    }
    __device__ __forceinline__ void wait_ready(const pg8::SUnit& u, int lane) const {
        int stage; unsigned need; need_of(u, stage, need);
        if (stage < 0) return;
        gu32* p = dep(stage, u.pm); unsigned spins = 0;
        while ((unsigned)__builtin_amdgcn_readfirstlane((int)__hip_atomic_load(p, __ATOMIC_RELAXED, __HIP_MEMORY_SCOPE_AGENT)) < need) {
            __builtin_amdgcn_s_sleep(8);
            if (++spins > (1u << 22)) { if (lane == 0) __hip_atomic_store(ctl + CW_TMO, 1u, __ATOMIC_RELAXED, __HIP_MEMORY_SCOPE_AGENT); break; }
        }
    }
    __device__ __forceinline__ void probe(const pg8::SUnit& cur, int wid, int lane) {
        par ^= 1;
        if (cur.kind == 3) return;
        if (wid == 0) {
            const unsigned tk = LW[tk_read & 1]; unsigned e = TK_NONE, ok = 1u;
            if (tk != (unsigned)TK_NONE) { e = tab_entry(tk); const pg8::SUnit u = dec(e); int stage; unsigned need; need_of(u, stage, need);
                if (stage >= 0) ok = ((unsigned)__builtin_amdgcn_readfirstlane((int)__hip_atomic_load(dep(stage, u.pm), __ATOMIC_RELAXED, __HIP_MEMORY_SCOPE_AGENT)) >= need) ? 1u : 0u; }
            if (lane == 0) { LW[2 + par] = e; LW[4 + par] = ok; }
        }
    }
    __device__ __forceinline__ bool peek(const pg8::SUnit& cur, pg8::SUnit& nxt, bool& ready) {
        if (cur.kind == 3) { nxt.kind = 4; nxt.pm = cur.pm; nxt.pn = cur.pn; ready = true; return true; }
        const unsigned e = LW[2 + par], ok = LW[4 + par]; ++tk_read;
        if ((e & 0xffffu) == (unsigned)TK_NONE) { ready = false; return false; }
        nxt = dec(e); ready = ok != 0u; return true;
    }
    __device__ __forceinline__ pg8::SGeo geo(const pg8::SUnit& u) const {
        pg8::SGeo g; const char* ws = (const char*)P.ws;
        if (u.kind == 0)      { g.ld = DM;  g.nt = 16; g.A = ws + WS_A;  g.B = ws + WS_WOUT; }
        else if (u.kind == 1) { g.ld = DM;  g.nt = 16; g.A = ws + WS_HB; g.B = ws + WS_WGU; }
        else if (u.kind == 2) { g.ld = FF;  g.nt = 44; g.A = ws + WS_T;  g.B = ws + WS_WDN; }
        else if (u.kind == 3) { g.ld = PLE; g.nt = 4;  g.A = ws + WS_PB; g.B = ws + WS_WPP; }
        else                  { g.ld = DM;  g.nt = 16; g.A = ws + WS_HB; g.B = ws + WS_WPG; }
        g.hstep = 128u * g.ld * 2u; g.A += (size_t)u.pm * 2u * g.hstep; g.B += (size_t)u.pn * 2u * g.hstep; return g;
    }
    __device__ __forceinline__ void epilogue(const f32x4 (&acc)[2][2][4][2], const pg8::SUnit& u, bool has_next, const pg8::SUnit& nxt, int wr, int wc, int fr, int fq, int wid, int lane) {
        const bool fetch = has_next && nxt.kind != 3;
        if (fetch && wid == 0 && lane == 0) tkv = fetch_ticket();
        const int rbase = u.pm * 256 + wr * 64 + fr;
        if (u.kind == 0 || u.kind == 2) {
            const rsrc_t rH = mk_rsrc(P.ws + WS_HB, (unsigned)M * DM * 2u), rS = mk_rsrc(P.ws + (u.kind == 0 ? WS_ST1 : WS_ST2), (unsigned)M * 64u);
#pragma unroll
            for (int ai = 0; ai < 2; ++ai)
#pragma unroll
                for (int m = 0; m < 4; ++m) {
                    const int r = rbase + ai * 128 + m * 16; float ss = 0.f;
#pragma unroll
                    for (int bj = 0; bj < 2; ++bj) {
                        const unsigned c0 = (unsigned)(u.pn * 256 + bj * 128 + wc * 32 + fq * 8), eo = (unsigned)r * DM + c0; f32x4 r0, r1;
                        if (u.kind == 0) { const float* xr = r < MP ? P.xp + (size_t)r * DM : P.xs + (size_t)(r - MP) * DM; r0 = *(const f32x4*)(xr + c0); r1 = *(const f32x4*)(xr + c0 + 4); }
                        else { const v4u w = __builtin_amdgcn_raw_buffer_load_b128(rH, (int)(eo * 2u), 0, 16); float f[8]; unpack8(w, f); r0 = (f32x4){f[0], f[1], f[2], f[3]}; r1 = (f32x4){f[4], f[5], f[6], f[7]}; }
                        const f32x4 h0 = r0 + acc[ai][bj][m][0], h1 = r1 + acc[ai][bj][m][1];
                        st_sc1_u4(rH, eo * 2u, pack8(h0, h1));
                        ss += sum4(h0 * h0) + sum4(h1 * h1);
                    }
                    ss += __shfl_xor(ss, 16); ss += __shfl_xor(ss, 32);
                    if (fq == 0) __builtin_amdgcn_raw_buffer_store_b32(__float_as_uint(ss), rS, (int)(((unsigned)r * 16u + (unsigned)(u.pn * 4 + wc)) * 4u), 0, ST_AUX);
                }
        } else if (u.kind == 1) {
            const rsrc_t rS = mk_rsrc(P.ws + WS_ST1, (unsigned)M * 64u), rT = mk_rsrc(P.ws + WS_T, (unsigned)M * FF * 2u);
#pragma unroll
            for (int ai = 0; ai < 2; ++ai)
#pragma unroll
                for (int m = 0; m < 4; ++m) {
                    const int r = rbase + ai * 128 + m * 16; const float rs = rstd16_sc1(rS, r);
                    const f32x4 g0 = acc[ai][0][m][0] * rs, g1 = acc[ai][0][m][1] * rs, u0 = acc[ai][1][m][0] * rs, u1 = acc[ai][1][m][1] * rs;
                    const f32x4 t0 = g0 * sigmoid4(g0) * u0, t1 = g1 * sigmoid4(g1) * u1;
                    st_sc1_u4(rT, ((unsigned)r * FF + (unsigned)(u.pn * 128 + wc * 32 + fq * 8)) * 2u, pack8(t0, t1));
                }
        } else if (u.kind == 3) {
            const rsrc_t rP = mk_rsrc(P.ws + WS_A, (unsigned)M * DM * 2u);
#pragma unroll
            for (int ai = 0; ai < 2; ++ai)
#pragma unroll
                for (int m = 0; m < 4; ++m) { const int r = rbase + ai * 128 + m * 16;
#pragma unroll
                    for (int bj = 0; bj < 2; ++bj) st_sc1_u4(rP, ((unsigned)r * DM + (unsigned)(u.pn * 256 + bj * 128 + wc * 32 + fq * 8)) * 2u, pack8(acc[ai][bj][m][0], acc[ai][bj][m][1]));
                    asm volatile("" ::: "memory"); }
        } else {
            const rsrc_t rH = mk_rsrc(P.ws + WS_HB, (unsigned)M * DM * 2u), rS = mk_rsrc(P.ws + WS_ST2, (unsigned)M * 64u), rP = mk_rsrc(P.ws + WS_A, (unsigned)M * DM * 2u);
#pragma unroll
            for (int ai = 0; ai < 2; ++ai)
#pragma unroll
                for (int m = 0; m < 4; ++m) {
                    const int r = rbase + ai * 128 + m * 16; const float rs = rstd16_sc1(rS, r);
#pragma unroll
                    for (int bj = 0; bj < 2; ++bj) {
                        const unsigned eo = (unsigned)r * DM + (unsigned)(u.pn * 256 + bj * 128 + wc * 32 + fq * 8);
                        const u32x4 pw = __builtin_amdgcn_raw_buffer_load_b128(rP, (int)(eo * 2u), 0, 16);
                        const f32x4 p0 = {__uint_as_float(pw.x << 16), __uint_as_float(pw.x & 0xffff0000u), __uint_as_float(pw.y << 16), __uint_as_float(pw.y & 0xffff0000u)};
                        const f32x4 p1 = {__uint_as_float(pw.z << 16), __uint_as_float(pw.z & 0xffff0000u), __uint_as_float(pw.w << 16), __uint_as_float(pw.w & 0xffff0000u)};
                        const v4u hw = __builtin_amdgcn_raw_buffer_load_b128(rH, (int)(eo * 2u), 0, 16); float hf[8]; unpack8(hw, hf);
                        const f32x4 y0 = (f32x4){hf[0], hf[1], hf[2], hf[3]} + p0 * sigmoid4(acc[ai][bj][m][0] * rs), y1 = (f32x4){hf[4], hf[5], hf[6], hf[7]} + p1 * sigmoid4(acc[ai][bj][m][1] * rs);
                        float* o = P.out + eo; *(f32x4*)o = y0; *(f32x4*)(o + 4) = y1;
                    }
                }
        }
        asm volatile("s_waitcnt vmcnt(0)" ::: "memory");
        if (u.kind <= 2 && lane == 0) __hip_atomic_fetch_add(dep(u.kind, u.pm), 1u, __ATOMIC_RELAXED, __HIP_MEMORY_SCOPE_AGENT);
        if (fetch) { if (wid == 0 && lane == 0) LW[tk_fetched & 1] = tkv; ++tk_fetched; }
    }
};

struct Args { const float* in[21]; float* out; unsigned char* ws; int ph_lo, ph_hi; };
template <int PHM> __global__ void __launch_bounds__(NTHR, 2) skel_fwd(Args args) {
    extern __shared__ __attribute__((aligned(16))) unsigned char lds[];
    Frame F;
    F.lds = (LAS unsigned char*)lds; F.MISC = (volatile LAS unsigned*)(F.lds + MISC_OFF);
    F.tid = threadIdx.x; F.lane = F.tid & 63; F.wave = __builtin_amdgcn_readfirstlane(F.tid >> 6);
    F.G = gridDim.x; { const int bx = blockIdx.x; F.vcu = (F.G % 8 == 0) ? (bx % 8) * (F.G / 8) + bx / 8 : bx; }
    unsigned char* ws = args.ws; F.ctl = (gu32*)(ws + WS_CTL);
    Ptrs P; P.xp = args.in[0]; P.xs = args.in[1]; P.ck = args.in[2]; P.cv = args.in[3]; P.sr = args.in[4]; P.pp = args.in[5]; P.ps = args.in[6]; P.g_mix = args.in[7]; P.w_in = args.in[8];
    P.g_ro = args.in[9]; P.g_q = args.in[10]; P.g_k = args.in[11]; P.rel_bias = args.in[12]; P.w_out = args.in[13]; P.g_ffn = args.in[14]; P.w_g = args.in[15]; P.w_u = args.in[16];
    P.w_d = args.in[17]; P.g_ple = args.in[18]; P.w_pg = args.in[19]; P.w_pp = args.in[20]; P.out = args.out; P.ws = ws;
    for (int u = F.tid; u < (LDS_BYTES - LDSCTL_OFF) / 4; u += NTHR) ((LAS unsigned*)(F.lds + LDSCTL_OFF))[u] = 0u;
    __syncthreads();
    XcdBarrier bar; bar.bar = (unsigned*)(F.ctl + CW_BAR); bar.x = 0; bar.st = nullptr;
    if (MK_ONE_LAUNCH) bar = xcd_barrier_post((unsigned*)(F.ctl + CW_BAR), F.MISC + 8);
#define GRID_BAR() do { if (MK_ONE_LAUNCH) xcd_barrier(bar); } while (0)
    const int lo = args.ph_lo, hi = args.ph_hi;
#define IN(k) (((PHM >> (k)) & 1) && lo <= (k) && (k) < hi)
#define BOTH(k) (IN(k) && IN((k) + 1))
    bf16* XB = (bf16*)(ws + WS_A); bf16* ZB = (bf16*)(ws + WS_Z); bf16* HB = (bf16*)(ws + WS_HB); bf16* TB = (bf16*)(ws + WS_T); bf16* PPB = (bf16*)(ws + WS_A);
    float* ST1 = (float*)(ws + WS_ST1); float* ST2 = (float*)(ws + WS_ST2);

    if (IN(0)) { p0_prologue(F, P); if (BOTH(0)) GRID_BAR(); }
    if (IN(1)) {
        pg8::Gemm g{XB, (const bf16*)(ws + WS_WIN), M, NIN, DM}; pg8::StaticOrder S; S.init(M, NIN, F.G, (int)blockIdx.x);
        EpiIn E{ZB, (const float*)(ws + WS_RSTDX), (const float*)(ws + WS_COS), (const float*)(ws + WS_SIN), P.g_q, P.g_k, P.out};
        pg8::gemm_phase<EpiIn, pg8::StaticOrder, true, true>(F.lds + RING_OFF, g, S, E);
        if (BOTH(1)) GRID_BAR();
    }
    if (IN(2)) {
        for (int it = F.vcu; it < 384; it += F.G) { if (it < 256) retU_item(F, P, false, it >> 2, it & 3); else retU_item(F, P, true, (it - 256) >> 2, (it - 256) & 3); }
        for (int it = F.vcu; it < 768; it += F.G) { if (it < 512) attn_unit(F, P, false, it & 63, it >> 6); else attn_unit(F, P, true, (it - 512) >> 3, (it - 512) & 7); }
        if (BOTH(2)) GRID_BAR();
    }
    if (IN(3)) { ret_scan(F, P); if (BOTH(3)) GRID_BAR(); }
    if (IN(4)) {
        for (int it = F.vcu; it < 384; it += F.G) { if (it < 256) retO_item(F, P, false, it >> 2, it & 3); else retO_item(F, P, true, (it - 256) >> 2, (it - 256) & 3); }
        __syncthreads();
        if (BOTH(4)) GRID_BAR();
    }
    if (IN(5)) {
        TailSched S{P, F.ctl, F.MISC + 16, 0, 0, 0, 0u, 0u};
        pg8::gemm_stream<TailSched>(F.lds + RING_OFF, S);
    }
#undef IN
#undef BOTH
}

extern "C" void kernel_launch(void* const* d_in, const int* in_sizes, int n_in, void* d_out, int out_size, void* d_ws, size_t ws_size, hipStream_t stream) {
    static int grid = 0;
    if (grid == 0) {
        if (n_in != 21 || out_size != (int)OUT_TOTAL || ws_size < WS_END) { fprintf(stderr, "kernel_launch: unexpected shapes n_in %d out %d ws %zu\n", n_in, out_size, ws_size); grid = -1; return; }
#if MK_ONE_LAUNCH
        if (hipFuncSetAttribute((const void*)skel_fwd<0x3f>, hipFuncAttributeMaxDynamicSharedMemorySize, LDS_BYTES) != hipSuccess) { fprintf(stderr, "kernel_launch: hipFuncSetAttribute failed\n"); grid = -1; return; }
#else
#define SETATTR(ph) (void)hipFuncSetAttribute((const void*)skel_fwd<(1 << (ph))>, hipFuncAttributeMaxDynamicSharedMemorySize, LDS_BYTES)
        SETATTR(0); SETATTR(1); SETATTR(2); SETATTR(3); SETATTR(4); SETATTR(5); SETATTR(6); SETATTR(7); SETATTR(8); SETATTR(9);
#endif
        int dev = 0, cus = 0;
        if (hipGetDevice(&dev) != hipSuccess || hipDeviceGetAttribute(&cus, hipDeviceAttributeMultiprocessorCount, dev) != hipSuccess) { grid = -1; return; }
        (void)hipGetLastError();
        grid = cus;
    }
    if (grid < 0) return;
    (void)hipMemsetAsync((char*)d_ws + WS_CTL, 0, CTL_ZERO_BYTES, stream);
    Args a{};
    for (int i = 0; i < 21; ++i) a.in[i] = (const float*)d_in[i];
    a.out = (float*)d_out; a.ws = (unsigned char*)d_ws;
#if MK_ONE_LAUNCH
    a.ph_lo = 0; a.ph_hi = NPH;
    hipLaunchKernelGGL(skel_fwd<0x3f>, dim3(grid), dim3(NTHR), LDS_BYTES, stream, a);
#else
#define LAUNCH_PH(ph) do { a.ph_lo = (ph); a.ph_hi = (ph) + 1; hipLaunchKernelGGL(skel_fwd<(1 << (ph))>, dim3(grid), dim3(NTHR), LDS_BYTES, stream, a); } while (0)
    LAUNCH_PH(0); LAUNCH_PH(1); LAUNCH_PH(2); LAUNCH_PH(3); LAUNCH_PH(4); LAUNCH_PH(5); LAUNCH_PH(6); LAUNCH_PH(7); LAUNCH_PH(8); LAUNCH_PH(9);
#endif
}
```

```cpp
#include <hip/hip_runtime.h>
#include <cstdio>
#include <cstdint>
namespace pg8 {
#define PG8_LAS __attribute__((address_space(3)))
typedef unsigned short bf16_t;
typedef short bf16x8 __attribute__((ext_vector_type(8)));
typedef float f32x4 __attribute__((ext_vector_type(4)));
typedef unsigned u32x4 __attribute__((ext_vector_type(4)));
constexpr int BM = 256, BK = 64, HALF = 128, HTB = HALF * BK * 2  , STAGE_BYTES = 8 * HTB, NXCD = 8, WGM = 8;

__host__ __device__ __forceinline__ int lds_byte(int r, int c) { const int st = (r >> 4) * 2 + (c >> 5), rr = r & 15, cc = c & 31, ob = rr * 64 + cc * 2; return st * 1024 + (ob ^ (((ob >> 9) & 1) << 5)); }
__host__ __device__ __forceinline__ void stage_rc(int b, int& R, int& C) { const int st = b / 1024, sb = b % 1024, swz = sb ^ (((sb >> 9) & 1) << 5); R = (st >> 1) * 16 + swz / 64; C = (st & 1) * 32 + (swz % 64) / 2; }
__host__ __device__ __forceinline__ int perm32(int rho) { const int n = rho >> 4, i = rho & 15; return 8 * (i >> 2) + 4 * n + (i & 3); }

struct Unit { int pm, pn; };
struct Gemm { const bf16_t* A; const bf16_t* Bt; int M, N, K; };

struct StaticOrder {
    int nM, nN, nwg, G, c;
    __host__ __device__ void init(int M, int N, int G_, int c_) { nM = M / BM; nN = N / BM; nwg = nM * nN; G = G_; c = c_; }
    __host__ __device__ bool next(int i, Unit& u) const {
        const long L = (long)i * G + c; if (L >= nwg) return false;
        int wgid = (int)L; { const int q = nwg / NXCD, r = nwg % NXCD, xcd = wgid % NXCD, off = wgid / NXCD; wgid = (xcd < r ? xcd * (q + 1) : r * (q + 1) + (xcd - r) * q) + off; }
        const int nig = WGM * nN, gid = wgid / nig, fm = gid * WGM, gsz = (nM - fm) < WGM ? (nM - fm) : WGM;
        u.pm = fm + ((wgid % nig) % gsz); u.pn = (wgid % nig) / gsz; return true;
    }
    __device__ __forceinline__ void a_ready(const Unit&) const {}
    __device__ __forceinline__ void done(const Unit&) const {}
};

__device__ __forceinline__ unsigned cvt_pk_bf16(float lo, float hi) { unsigned r; asm volatile("v_cvt_pk_bf16_f32 %0, %1, %2" : "=v"(r) : "v"(lo), "v"(hi)); return r; }
typedef float f32x2 __attribute__((ext_vector_type(2)));
template <class Epi, class Sched, bool ALIGN_EPI = false, bool SP2 = false>
__device__ __forceinline__ void gemm_phase(PG8_LAS unsigned char* lds, const Gemm g, const Sched& S, const Epi& E) {
    int tid_ = threadIdx.x; asm volatile("" : "+v"(tid_));
    const int tid = tid_, wid = __builtin_amdgcn_readfirstlane(tid >> 6), lane = tid & 63, wr = wid >> 2, wc = wid & 3, fr = lane & 15, fq = lane >> 4;
    const int K = g.K, nt = K / BK;
    unsigned voffA[2], voffB[2];
#pragma unroll
    for (int i = 0; i < 2; ++i) { int R, C; stage_rc(tid * 16 + i * 8192, R, C); const int Rb = Epi::PERM ? ((R & ~31) + perm32(R & 31)) : R;
        voffA[i] = (unsigned)(R * K + C) * 2u; voffB[i] = (unsigned)(Rb * K + C) * 2u; }
    const size_t kstep = (size_t)(BK * 2);
    const size_t hstep = (size_t)HALF * K * 2;
    const size_t tstep = 2 * hstep;
    const unsigned ldsw = (unsigned)wid * 1024u;
    const int aoff = lds_byte(wr * 64 + fr, fq * 8), boff = lds_byte(wc * 32 + fr, fq * 8);
#define PG8_SA(b, h) (((b) * 2 + (h)) * HTB)
#define PG8_SB(b, h) ((4 + (b) * 2 + (h)) * HTB)
#define PG8_STAGE(bufoff, gbase, voff) do { _Pragma("unroll") for (int _i = 0; _i < 2; ++_i) \
        __builtin_amdgcn_global_load_lds((const unsigned*)((const char*)(gbase) + (voff)[_i]), (PG8_LAS unsigned*)(lds + (bufoff) + ldsw + _i * 8192), 16, 0, 0); } while (0)
#define PG8_LDA(dst, b, h) do { _Pragma("unroll") for (int m = 0; m < 4; ++m) _Pragma("unroll") for (int k = 0; k < 2; ++k) dst[m][k] = *(const PG8_LAS bf16x8*)(lds + PG8_SA(b, h) + aoff + m * 2048 + k * 1024); } while (0)
#define PG8_LDB(dst, b, h) do { _Pragma("unroll") for (int n = 0; n < 2; ++n) _Pragma("unroll") for (int k = 0; k < 2; ++k) dst[n][k] = *(const PG8_LAS bf16x8*)(lds + PG8_SB(b, h) + boff + n * 2048 + k * 1024); } while (0)
#define PG8_MMA(ai, bj, At, Bt) do { __builtin_amdgcn_s_setprio(1); _Pragma("unroll") for (int m = 0; m < 4; ++m) _Pragma("unroll") for (int n = 0; n < 2; ++n) _Pragma("unroll") for (int k = 0; k < 2; ++k) \
        acc[ai][bj][m][n] = __builtin_amdgcn_mfma_f32_16x16x32_bf16(Bt[n][k], At[m][k], acc[ai][bj][m][n], 0, 0, 0); __builtin_amdgcn_s_setprio(0); } while (0)
#define PG8_WAIT_V(n) asm volatile("s_waitcnt vmcnt(" #n ")" ::: "memory")
#define PG8_WAIT_L(n) asm volatile("s_waitcnt lgkmcnt(" #n ")" ::: "memory")
#define PG8_BAR __builtin_amdgcn_s_barrier()
#define PG8_SCHED __builtin_amdgcn_sched_barrier(0)
    Unit cur, nxt; int ui = 0;
    if (!S.next(0, cur)) return;
    f32x4 acc[2][2][4][2];
#pragma unroll
    for (int a = 0; a < 2; ++a)
#pragma unroll
        for (int b = 0; b < 2; ++b)
#pragma unroll
            for (int m = 0; m < 4; ++m)
#pragma unroll
                for (int n = 0; n < 2; ++n) acc[a][b][m][n] = (f32x4){0.f, 0.f, 0.f, 0.f};
    bf16x8 At[4][2], B0[2][2], B1[2][2];
    const char* cA = (const char*)g.A + (size_t)cur.pm * tstep; const char* cB = (const char*)g.Bt + (size_t)cur.pn * tstep;
    S.a_ready(cur);
    if constexpr (SP2) {
        PG8_STAGE(PG8_SB(0, 0), cB, voffB); PG8_STAGE(PG8_SB(0, 1), cB + hstep, voffB); PG8_STAGE(PG8_SA(0, 0), cA, voffA); PG8_STAGE(PG8_SA(0, 1), cA + hstep, voffA);
        if (wr == 1) PG8_BAR;
        PG8_WAIT_V(2); PG8_BAR;
        PG8_STAGE(PG8_SB(1, 0), cB + kstep, voffB); PG8_STAGE(PG8_SA(1, 0), cA + kstep, voffA); PG8_STAGE(PG8_SB(1, 1), cB + hstep + kstep, voffB);
        PG8_WAIT_V(6); PG8_BAR;
    } else {
        PG8_STAGE(PG8_SB(0, 0), cB, voffB); PG8_STAGE(PG8_SA(0, 0), cA, voffA); PG8_STAGE(PG8_SB(0, 1), cB + hstep, voffB); PG8_STAGE(PG8_SA(0, 1), cA + hstep, voffA);
        if (wr == 1) PG8_BAR;
        PG8_WAIT_V(4); PG8_BAR;
        PG8_STAGE(PG8_SB(1, 0), cB + kstep, voffB); PG8_STAGE(PG8_SA(1, 0), cA + kstep, voffA); PG8_STAGE(PG8_SB(1, 1), cB + hstep + kstep, voffB);
        PG8_WAIT_V(6); PG8_BAR;
    }
    for (;;) {
        const bool has_next = S.next(ui + 1, nxt);
        const char* nA = has_next ? (const char*)g.A + (size_t)nxt.pm * tstep : cA; const char* nB = has_next ? (const char*)g.Bt + (size_t)nxt.pn * tstep : cB;
        for (int t = 0; t < nt; t += 2) {
            const bool last = (t == nt - 2);
            const char* a1 = cA + (size_t)(t + 1) * kstep;
            const char* a2 = last ? nA : cA + (size_t)(t + 2) * kstep; const char* b2 = last ? nB : cB + (size_t)(t + 2) * kstep;
            const char* a3 = a2 + kstep; const char* b3 = b2 + kstep;
            if (last && has_next) S.a_ready(nxt);
            if constexpr (SP2) {
            PG8_LDB(B0, 0, 0); PG8_LDB(B1, 0, 1); PG8_SCHED; PG8_LDA(At, 0, 0); PG8_STAGE(PG8_SA(1, 1), a1 + hstep, voffA);
            PG8_WAIT_V(8); PG8_WAIT_L(0); PG8_BAR; PG8_MMA(0, 0, At, B0); PG8_MMA(0, 1, At, B1); PG8_BAR; PG8_SCHED;
            PG8_LDA(At, 0, 1); PG8_STAGE(PG8_SB(0, 0), b2, voffB); PG8_STAGE(PG8_SB(0, 1), b2 + hstep, voffB); PG8_STAGE(PG8_SA(0, 0), a2, voffA);
            PG8_WAIT_V(8); PG8_WAIT_L(0); PG8_BAR; PG8_MMA(1, 0, At, B0); PG8_MMA(1, 1, At, B1); PG8_BAR; PG8_SCHED;
            PG8_LDB(B0, 1, 0); PG8_LDB(B1, 1, 1); PG8_SCHED; PG8_LDA(At, 1, 0); PG8_STAGE(PG8_SA(0, 1), a2 + hstep, voffA);
            PG8_WAIT_V(8); PG8_WAIT_L(0); PG8_BAR; PG8_MMA(0, 0, At, B0); PG8_MMA(0, 1, At, B1); PG8_BAR; PG8_SCHED;
            PG8_LDA(At, 1, 1); PG8_STAGE(PG8_SB(1, 0), b3, voffB); PG8_STAGE(PG8_SB(1, 1), b3 + hstep, voffB); PG8_STAGE(PG8_SA(1, 0), a3, voffA);
            PG8_WAIT_V(8); PG8_WAIT_L(0); PG8_BAR; PG8_MMA(1, 0, At, B0); PG8_MMA(1, 1, At, B1); PG8_BAR; PG8_SCHED;
            } else {
            PG8_LDB(B0, 0, 0); PG8_SCHED; PG8_LDA(At, 0, 0); PG8_STAGE(PG8_SA(1, 1), a1 + hstep, voffA);
            PG8_WAIT_L(8); PG8_BAR; PG8_WAIT_L(0); PG8_MMA(0, 0, At, B0); PG8_BAR; PG8_SCHED;
            PG8_LDB(B1, 0, 1); PG8_STAGE(PG8_SB(0, 0), b2, voffB);
            PG8_BAR; PG8_WAIT_L(0); PG8_MMA(0, 1, At, B1); PG8_BAR;
            PG8_LDA(At, 0, 1); PG8_STAGE(PG8_SA(0, 0), a2, voffA);
            PG8_BAR; PG8_WAIT_L(0); PG8_MMA(1, 0, At, B0); PG8_BAR; PG8_SCHED;
            PG8_STAGE(PG8_SB(0, 1), b2 + hstep, voffB);
            PG8_WAIT_V(6); PG8_BAR; PG8_MMA(1, 1, At, B1); PG8_BAR;
            PG8_LDB(B0, 1, 0); PG8_SCHED; PG8_LDA(At, 1, 0); PG8_STAGE(PG8_SA(0, 1), a2 + hstep, voffA);
            PG8_WAIT_L(8); PG8_BAR; PG8_WAIT_L(0); PG8_MMA(0, 0, At, B0); PG8_BAR; PG8_SCHED;
            PG8_LDB(B1, 1, 1); PG8_STAGE(PG8_SB(1, 0), b3, voffB);
            PG8_BAR; PG8_WAIT_L(0); PG8_MMA(0, 1, At, B1); PG8_BAR;
            PG8_LDA(At, 1, 1); PG8_STAGE(PG8_SA(1, 0), a3, voffA);
            PG8_BAR; PG8_WAIT_L(0); PG8_MMA(1, 0, At, B0); PG8_BAR; PG8_SCHED;
            PG8_STAGE(PG8_SB(1, 1), b3 + hstep, voffB);
            PG8_WAIT_V(6); PG8_BAR; PG8_MMA(1, 1, At, B1); PG8_BAR;
            }
        }
        if constexpr (ALIGN_EPI) { if (wr == 0) PG8_BAR; }
        if constexpr (!Epi::AFTER_DRAIN) { E(acc, cur, wr, wc, fr, fq); S.done(cur); }
        if (!has_next) break;
#pragma unroll
        for (int a = 0; a < 2; ++a)
#pragma unroll
            for (int b = 0; b < 2; ++b)
#pragma unroll
                for (int m = 0; m < 4; ++m)
#pragma unroll
                    for (int n = 0; n < 2; ++n) acc[a][b][m][n] = (f32x4){0.f, 0.f, 0.f, 0.f};
        cur = nxt; cA = nA; cB = nB; ++ui;
        if constexpr (ALIGN_EPI) { if (wr == 1) PG8_BAR; }
    }
    PG8_WAIT_V(0);
    if constexpr (!ALIGN_EPI) { if (wr == 0) PG8_BAR; }
    PG8_BAR;
    if constexpr (Epi::AFTER_DRAIN) { E.fused(acc, cur, wr, wc, fr, fq, lds, wid, lane); S.done(cur); }
#undef PG8_SA
#undef PG8_SB
#undef PG8_STAGE
#undef PG8_LDA
#undef PG8_LDB
#undef PG8_MMA
#undef PG8_WAIT_V
#undef PG8_WAIT_L
#undef PG8_BAR
#undef PG8_SCHED
}
}
namespace pg8 {
struct SUnit { int kind, pm, pn; };
struct SGeo { const char* A; const char* B; unsigned ld, hstep; int nt; };

template <class Sched>
__device__ __forceinline__ void gemm_stream(PG8_LAS unsigned char* lds, Sched& S) {
    int tid_ = threadIdx.x; asm volatile("" : "+v"(tid_));
    const int tid = tid_, wid = __builtin_amdgcn_readfirstlane(tid >> 6), lane = tid & 63, wr = wid >> 2, wc = wid & 3, fr = lane & 15, fq = lane >> 4;
    unsigned RA2[2], RB2[2], C2[2];
#pragma unroll
    for (int i = 0; i < 2; ++i) { int R, C; stage_rc(tid * 16 + i * 8192, R, C); const int Rb = (R & ~31) + perm32(R & 31); RA2[i] = 2u * R; RB2[i] = 2u * Rb; C2[i] = 2u * C; }
    const size_t kstep = (size_t)(BK * 2);
    const unsigned ldsw = (unsigned)wid * 1024u;
    const int aoff = lds_byte(wr * 64 + fr, fq * 8), boff = lds_byte(wc * 32 + fr, fq * 8);
#define PG8_SA(b, h) (((b) * 2 + (h)) * HTB)
#define PG8_SB(b, h) ((4 + (b) * 2 + (h)) * HTB)
#ifndef STA_AUX
#define STA_AUX 0
#endif
#define PG8_STA(bufoff, gbase, ld_) do { _Pragma("unroll") for (int _i = 0; _i < 2; ++_i) \
        __builtin_amdgcn_global_load_lds((const unsigned*)((const char*)(gbase) + (RA2[_i] * (ld_) + C2[_i])), (PG8_LAS unsigned*)(lds + (bufoff) + ldsw + _i * 8192), 16, 0, STA_AUX); } while (0)
#define PG8_STB(bufoff, gbase, ld_) do { _Pragma("unroll") for (int _i = 0; _i < 2; ++_i) \
        __builtin_amdgcn_global_load_lds((const unsigned*)((const char*)(gbase) + (RB2[_i] * (ld_) + C2[_i])), (PG8_LAS unsigned*)(lds + (bufoff) + ldsw + _i * 8192), 16, 0, 0); } while (0)
#define PG8_LDA(dst, b, h) do { _Pragma("unroll") for (int m = 0; m < 4; ++m) _Pragma("unroll") for (int k = 0; k < 2; ++k) dst[m][k] = *(const PG8_LAS bf16x8*)(lds + PG8_SA(b, h) + aoff + m * 2048 + k * 1024); } while (0)
#define PG8_LDB(dst, b, h) do { _Pragma("unroll") for (int n = 0; n < 2; ++n) _Pragma("unroll") for (int k = 0; k < 2; ++k) dst[n][k] = *(const PG8_LAS bf16x8*)(lds + PG8_SB(b, h) + boff + n * 2048 + k * 1024); } while (0)
#define PG8_MMA(ai, bj, At, Bt) do { __builtin_amdgcn_s_setprio(1); _Pragma("unroll") for (int m = 0; m < 4; ++m) _Pragma("unroll") for (int n = 0; n < 2; ++n) _Pragma("unroll") for (int k = 0; k < 2; ++k) \
        acc[ai][bj][m][n] = __builtin_amdgcn_mfma_f32_16x16x32_bf16(Bt[n][k], At[m][k], acc[ai][bj][m][n], 0, 0, 0); __builtin_amdgcn_s_setprio(0); } while (0)
#define PG8_WAIT_V(n) asm volatile("s_waitcnt vmcnt(" #n ")" ::: "memory")
#define PG8_WAIT_L(n) asm volatile("s_waitcnt lgkmcnt(" #n ")" ::: "memory")
#define PG8_BAR __builtin_amdgcn_s_barrier()
#define PG8_SCHED __builtin_amdgcn_sched_barrier(0)
    SUnit cur, nxt;
    if (!S.first(cur, wid, lane)) return;
    f32x4 acc[2][2][4][2];
#pragma unroll
    for (int a = 0; a < 2; ++a)
#pragma unroll
        for (int b = 0; b < 2; ++b)
#pragma unroll
            for (int m = 0; m < 4; ++m)
#pragma unroll
                for (int n = 0; n < 2; ++n) acc[a][b][m][n] = (f32x4){0.f, 0.f, 0.f, 0.f};
    bf16x8 At[4][2], B0[2][2], B1[2][2];
    for (;;) {
        S.wait_ready(cur, lane);
        SGeo gc = S.geo(cur);
        PG8_STB(PG8_SB(0, 0), gc.B, gc.ld); PG8_STB(PG8_SB(0, 1), gc.B + gc.hstep, gc.ld); PG8_STA(PG8_SA(0, 0), gc.A, gc.ld); PG8_STA(PG8_SA(0, 1), gc.A + gc.hstep, gc.ld);
        if (wr == 1) PG8_BAR;
        PG8_WAIT_V(2); PG8_BAR;
        PG8_STB(PG8_SB(1, 0), gc.B + kstep, gc.ld); PG8_STA(PG8_SA(1, 0), gc.A + kstep, gc.ld); PG8_STB(PG8_SB(1, 1), gc.B + gc.hstep + kstep, gc.ld);
        PG8_WAIT_V(6); PG8_BAR;
        bool finished = false;
        for (;;) {
            bool has_next = false, ready = false; SGeo gn = gc;
            const int nt = gc.nt, tprobe = nt >= 6 ? nt - 4 : 0;
            for (int t = 0; t < nt; t += 2) {
                const bool last = (t == nt - 2);
                if (t == tprobe) S.probe(cur, wid, lane);
                if (last) { has_next = S.peek(cur, nxt, ready); if (has_next && ready) gn = S.geo(nxt); }
                const char* a1 = gc.A + (size_t)(t + 1) * kstep;
                const char* a2 = last ? gn.A : gc.A + (size_t)(t + 2) * kstep; const char* b2 = last ? gn.B : gc.B + (size_t)(t + 2) * kstep;
                const unsigned ld2 = last ? gn.ld : gc.ld, hs2 = last ? gn.hstep : gc.hstep;
                const char* a3 = a2 + kstep; const char* b3 = b2 + kstep;
                PG8_LDB(B0, 0, 0); PG8_LDB(B1, 0, 1); PG8_SCHED; PG8_LDA(At, 0, 0); PG8_STA(PG8_SA(1, 1), a1 + gc.hstep, gc.ld);
                PG8_WAIT_V(8); PG8_WAIT_L(0); PG8_BAR; PG8_MMA(0, 0, At, B0); PG8_MMA(0, 1, At, B1); PG8_BAR; PG8_SCHED;
                PG8_LDA(At, 0, 1); PG8_STB(PG8_SB(0, 0), b2, ld2); PG8_STB(PG8_SB(0, 1), b2 + hs2, ld2); PG8_STA(PG8_SA(0, 0), a2, ld2);
                PG8_WAIT_V(8); PG8_WAIT_L(0); PG8_BAR; PG8_MMA(1, 0, At, B0); PG8_MMA(1, 1, At, B1); PG8_BAR; PG8_SCHED;
                PG8_LDB(B0, 1, 0); PG8_LDB(B1, 1, 1); PG8_SCHED; PG8_LDA(At, 1, 0); PG8_STA(PG8_SA(0, 1), a2 + hs2, ld2);
                PG8_WAIT_V(8); PG8_WAIT_L(0); PG8_BAR; PG8_MMA(0, 0, At, B0); PG8_MMA(0, 1, At, B1); PG8_BAR; PG8_SCHED;
                PG8_LDA(At, 1, 1); PG8_STB(PG8_SB(1, 0), b3, ld2); PG8_STB(PG8_SB(1, 1), b3 + hs2, ld2); PG8_STA(PG8_SA(1, 0), a3, ld2);
                PG8_WAIT_V(8); PG8_WAIT_L(0); PG8_BAR; PG8_MMA(1, 0, At, B0); PG8_MMA(1, 1, At, B1); PG8_BAR; PG8_SCHED;
            }
            if (wr == 0) PG8_BAR;
            S.epilogue(acc, cur, has_next, nxt, wr, wc, fr, fq, wid, lane);
            if (!has_next) { finished = true; break; }
#pragma unroll
            for (int a = 0; a < 2; ++a)
#pragma unroll
                for (int b = 0; b < 2; ++b)
#pragma unroll
                    for (int m = 0; m < 4; ++m)
#pragma unroll
                        for (int n = 0; n < 2; ++n) acc[a][b][m][n] = (f32x4){0.f, 0.f, 0.f, 0.f};
            cur = nxt;
            if (!ready) break;
            gc = gn;
            if (wr == 1) PG8_BAR;
        }
        PG8_WAIT_V(0); PG8_BAR;
        if (finished) break;
    }
#undef PG8_SA
#undef PG8_SB
#undef PG8_STA
#undef PG8_STB
#undef PG8_LDA
#undef PG8_LDB
#undef PG8_MMA
#undef PG8_WAIT_V
#undef PG8_WAIT_L
#undef PG8_BAR
#undef PG8_SCHED
}
}

#define GAS __attribute__((address_space(1)))
#define LAS __attribute__((address_space(3)))
typedef unsigned short bf16;
typedef unsigned v4u __attribute__((ext_vector_type(4)));
typedef float f32x4 __attribute__((ext_vector_type(4)));
typedef short bf16x8 __attribute__((ext_vector_type(8)));
typedef GAS unsigned gu32;
typedef GAS unsigned long long gu64;
#define RLX_AGENT __ATOMIC_RELAXED, __HIP_MEMORY_SCOPE_AGENT
#define LDS_WAIT() asm volatile("s_waitcnt lgkmcnt(0)" ::: "memory")
#define VM_WAIT() asm volatile("s_waitcnt vmcnt(0)" ::: "memory")
__device__ __forceinline__ unsigned long long rt() { return __builtin_amdgcn_s_memrealtime(); }
__device__ __forceinline__ unsigned f2bf(float f) { unsigned u = __builtin_bit_cast(unsigned, f); return (u + 0x7fffu + ((u >> 16) & 1u)) >> 16; }
__device__ __forceinline__ unsigned pk2(float lo, float hi) { return f2bf(lo) | (f2bf(hi) << 16); }

#define XB_TMO      128
#define XB_XCNT(j)  (256  + 64 * (j))
#define XB_XSUB(j)  (1280 + 64 * (j))
#define XB_XGEN(j)  (2304 + 64 * (j))
#define XB_TOP      3328
#define XB_TOPGEN   3392
#define XCD_BAR_WORDS 3456
#define XB_SPIN_CAP (1u << 18)

__device__ __forceinline__ unsigned xb_ld(unsigned* p)              { return __hip_atomic_load(p, __ATOMIC_RELAXED, __HIP_MEMORY_SCOPE_AGENT); }
__device__ __forceinline__ unsigned xb_add(unsigned* p, unsigned v) { return __hip_atomic_fetch_add(p, v, __ATOMIC_RELAXED, __HIP_MEMORY_SCOPE_AGENT); }
__device__ __forceinline__ unsigned xb_xcc_id() { return (unsigned)__builtin_amdgcn_s_getreg((3 << 11) | 20) & 0xFu; }
#define XB_SPIN(cond, bar) do { unsigned _sp = 0; while (cond) { __builtin_amdgcn_s_sleep(1); \
    if ((++_sp & 255u) == 0u) { if (xb_ld(&(bar)[XB_TMO])) break; if (_sp > XB_SPIN_CAP) { atomicAdd(&(bar)[XB_TMO], 1u); break; } } } } while (0)

struct XcdBarrier {
    unsigned* bar; unsigned x;
    volatile LAS unsigned* st;
};

__device__ __forceinline__ XcdBarrier xcd_barrier_post(unsigned* bar, volatile LAS unsigned* st) {
    XcdBarrier b; b.bar = bar; b.x = xb_xcc_id(); b.st = st;
    if (threadIdx.x == 0) (void)xb_add(&bar[XB_XCNT(b.x)], 1u);
    return b;
}
__device__ __forceinline__ void xcd_barrier_complete(unsigned* bar, unsigned x, unsigned& nloc, unsigned& nx) {
    const unsigned G = gridDim.x * gridDim.y * gridDim.z;
    unsigned sum, cnt, mine, sp = 0u;
    for (;;) {
        sum = 0u; cnt = 0u; mine = 0u;
#pragma unroll
        for (unsigned j = 0; j < 16; ++j) { const unsigned c = xb_ld(&bar[XB_XCNT(j)]); sum += c; cnt += (c > 0u) ? 1u : 0u; mine = (j == x) ? c : mine; }
        if (sum == G) break;
        __builtin_amdgcn_s_sleep(1);
        if ((++sp & 255u) == 0u) { if (xb_ld(&bar[XB_TMO])) break; if (sp > XB_SPIN_CAP) { atomicAdd(&bar[XB_TMO], 1u); break; } }
    }
    nloc = mine > 0u ? mine : 1u; nx = cnt > 0u ? cnt : 1u;
}

__device__ __forceinline__ void xcd_barrier(const XcdBarrier& b) {
    asm volatile("s_waitcnt vmcnt(0)" ::: "memory");
    __syncthreads();
    if (threadIdx.x == 0) {
        unsigned* bar = b.bar;
        __builtin_amdgcn_s_waitcnt(0);
        unsigned nloc = b.st[0], nx = b.st[1];
        if (nloc == 0u) { xcd_barrier_complete(bar, b.x, nloc, nx); b.st[0] = nloc; b.st[1] = nx; }
        const unsigned old = xb_add(&bar[XB_XSUB(b.x)], 1u);
        const unsigned gen = old / nloc;
        if (old + 1u == (gen + 1u) * nloc) {
            __builtin_amdgcn_fence(__ATOMIC_RELEASE, "agent");
            asm volatile("s_waitcnt vmcnt(0)" ::: "memory");
            const unsigned og = xb_add(&bar[XB_TOP], 1u);
            const unsigned tg = og / nx;
            if (og + 1u == (tg + 1u) * nx) xb_add(&bar[XB_TOPGEN], 1u);
            else XB_SPIN(xb_ld(&bar[XB_TOPGEN]) == tg, bar);
            __builtin_amdgcn_fence(__ATOMIC_ACQUIRE, "agent");
            xb_add(&bar[XB_XGEN(b.x)], 1u);
            asm volatile("s_waitcnt vmcnt(0)" ::: "memory");
        } else {
            XB_SPIN(xb_ld(&bar[XB_XGEN(b.x)]) == gen, bar);
            __builtin_amdgcn_fence(__ATOMIC_ACQUIRE, "agent");
            asm volatile("s_waitcnt vmcnt(0)" ::: "memory");
        }
    }
    __syncthreads();
}

constexpr int DM = 1024, MP = 16384, MS = 2048, M = MP + MS;
constexpr int NIN = 3584, FF = 2816, NGU = 2 * FF, PLE = 256, PAST = 2048;
constexpr int NCP = 256, NCS = 32, NCH = NCP + NCS;
constexpr int RH = 4, RD = 128, AH = 8, AD = 64;
constexpr float EPS = 1e-6f, LOG2E = 1.4426950408889634f;
constexpr int ZQ = 0, ZK = 512, ZV = 1024, ZG = 1536, ZQA = 2048, ZKA = 2560, ZVA = 3072;
constexpr size_t OFF_Y = 0, OFF_RP = (size_t)M * DM, OFF_KP = OFF_RP + 65536, OFF_VP = OFF_KP + 262144, OFF_RS = OFF_VP + 262144,
                 OFF_KS = OFF_RS + 2097152, OFF_VS = OFF_KS + 1048576, OUT_TOTAL = OFF_VS + 1048576;
static_assert(OUT_TOTAL == 23658496, "output size");

constexpr size_t MiB = 1u << 20;
constexpr size_t WS_CTL = 0, CTL_ZERO_BYTES = 1 * MiB;
constexpr size_t WS_RSTDX = 1 * MiB, WS_M0 = 1 * MiB + 256 * 1024, WS_ST1 = 2 * MiB, WS_ST2 = 4 * MiB;
constexpr size_t WS_WIN = 6 * MiB, WS_WOUT = 13 * MiB, WS_WGU = 15 * MiB, WS_WDN = 26 * MiB, WS_WPG = 32 * MiB, WS_WPP = 34 * MiB;
constexpr size_t WS_PB = 35 * MiB;
constexpr size_t WS_XB = 44 * MiB;
constexpr size_t WS_Z = 80 * MiB;
constexpr size_t WS_UF = 206 * MiB;
constexpr size_t WS_RB = 222 * MiB;
constexpr size_t WS_COS = 230 * MiB, WS_SIN = 234 * MiB;
constexpr size_t WS_HB = 80 * MiB;
constexpr size_t WS_T = 116 * MiB;
constexpr size_t WS_H2B = 215 * MiB;
constexpr size_t WS_END = 251 * MiB;
static_assert(WS_T + (size_t)M * FF * 2 <= WS_H2B && WS_Z + (size_t)M * NIN * 2 <= WS_UF && WS_HB + (size_t)M * DM * 2 <= WS_T && WS_H2B + (size_t)M * DM * 2 <= WS_END, "ws map");

constexpr int CW_TMO = 0, CW_CODE = 1, CW_BAR = 4096;

using pg8::u32x4; using pg8::bf16_t; using pg8::Unit;
__device__ __forceinline__ u32x4 pack8(f32x4 a, f32x4 b) { u32x4 w; w.x = pg8::cvt_pk_bf16(a[0], a[1]); w.y = pg8::cvt_pk_bf16(a[2], a[3]); w.z = pg8::cvt_pk_bf16(b[0], b[1]); w.w = pg8::cvt_pk_bf16(b[2], b[3]); return w; }
__device__ __forceinline__ float lg2_gamma(int h) { return log2f(1.0f - exp2f(-5.0f - (float)h)); }
__device__ __forceinline__ float bf2f(unsigned short b) { return __uint_as_float((unsigned)b << 16); }
__device__ __forceinline__ float sum4(f32x4 a) { return (a[0] + a[1]) + (a[2] + a[3]); }
__device__ __forceinline__ float rstd16(const float* st, int r) {
    const f32x4* p = (const f32x4*)(st + (size_t)r * 16); const f32x4 a = p[0], b = p[1], c = p[2], d = p[3];
    return rsqrtf(((sum4(a) + sum4(b)) + (sum4(c) + sum4(d))) * (1.0f / DM) + EPS);
}
__device__ __forceinline__ f32x4 sigmoid4(f32x4 g) { f32x4 o;
#pragma unroll
    for (int i = 0; i < 4; ++i) o[i] = __builtin_amdgcn_rcpf(1.0f + __builtin_amdgcn_exp2f(-g[i] * LOG2E));
    return o; }

struct EpiIn {
    static constexpr bool PERM = true, AFTER_DRAIN = false;
    bf16_t* Z; const float* rstd; const float* cosT; const float* sinT; const float* gq; const float* gk; float* dout;
    __device__ __forceinline__ void operator()(const f32x4 (&acc)[2][2][4][2], const Unit& u, int wr, int wc, int fr, int fq) const {
        const int pn = u.pn; const int rbase = u.pm * 256 + wr * 64 + fr;
        if (pn < 4) {
            const int sec = (pn >> 1) * 512, head = 2 * (pn & 1) + (wc >> 1), j0 = (wc & 1) * 32 + fq * 8;
            const float osc = (pn >= 2) ? 0.08838834764831845f : 1.0f; const float lgs = (pn >= 2) ? -lg2_gamma(head) : lg2_gamma(head);
#pragma unroll
            for (int ai = 0; ai < 2; ++ai)
#pragma unroll
                for (int m = 0; m < 4; ++m) {
                    const int r = rbase + ai * 128 + m * 16; const int pos = r < MP ? r : PAST + ((r - MP) & 63); const int nloc = r < MP ? (r & 255) : ((r - MP) & 63);
                    const float rs = rstd[r] * osc * exp2f((float)nloc * lgs);
                    const f32x4 c0 = *(const f32x4*)(cosT + (size_t)pos * 64 + j0), c1 = *(const f32x4*)(cosT + (size_t)pos * 64 + j0 + 4);
                    const f32x4 s0 = *(const f32x4*)(sinT + (size_t)pos * 64 + j0), s1 = *(const f32x4*)(sinT + (size_t)pos * 64 + j0 + 4);
                    const f32x4 x1a = acc[ai][0][m][0] * rs, x1b = acc[ai][0][m][1] * rs, x2a = acc[ai][1][m][0] * rs, x2b = acc[ai][1][m][1] * rs;
                    const f32x4 o1a = x1a * c0 - x2a * s0, o1b = x1b * c1 - x2b * s1, o2a = x1a * s0 + x2a * c0, o2b = x1b * s1 + x2b * c1;
                    bf16_t* dst = Z + (size_t)r * NIN + sec + head * 128 + j0;
                    *(u32x4*)dst = pack8(o1a, o1b); *(u32x4*)(dst + 64) = pack8(o2a, o2b);
                }
        } else if (pn < 8 || pn >= 12) {
#pragma unroll
            for (int ai = 0; ai < 2; ++ai)
#pragma unroll
                for (int m = 0; m < 4; ++m) {
                    const int r = rbase + ai * 128 + m * 16; const float rs = rstd[r];
#pragma unroll
                    for (int bj = 0; bj < 2; ++bj) {
                        const f32x4 v0 = acc[ai][bj][m][0] * rs, v1 = acc[ai][bj][m][1] * rs; const int t = bj * 128 + wc * 32 + fq * 8;
                        *(u32x4*)(Z + (size_t)r * NIN + pn * 256 + t) = pack8(v0, v1);
                        if (pn >= 12) { const int c5 = (pn - 12) * 256 + t;
                            if (r >= MP) { float* o = dout + OFF_VS + (size_t)(r - MP) * 512 + c5; *(f32x4*)o = v0; *(f32x4*)(o + 4) = v1; }
                            else if (r >= MP - 512) { float* o = dout + OFF_VP + (size_t)(r - (MP - 512)) * 512 + c5; *(f32x4*)o = v0; *(f32x4*)(o + 4) = v1; } }
                    }
                }
        } else {
            const float* g = pn < 10 ? gq : gk; f32x4 gv[2][2];
#pragma unroll
            for (int bj = 0; bj < 2; ++bj)
#pragma unroll
                for (int n = 0; n < 2; ++n) gv[bj][n] = *(const f32x4*)(g + bj * 32 + fq * 8 + 4 * n);
#pragma unroll
            for (int ai = 0; ai < 2; ++ai)
#pragma unroll
                for (int m = 0; m < 4; ++m) {
                    const int r = rbase + ai * 128 + m * 16; const float rs = rstd[r]; f32x4 v[2][2]; float ss = 0.f;
#pragma unroll
                    for (int bj = 0; bj < 2; ++bj)
#pragma unroll
                        for (int n = 0; n < 2; ++n) { v[bj][n] = acc[ai][bj][m][n] * rs; ss += sum4(v[bj][n] * v[bj][n]); }
                    ss += __shfl_xor(ss, 16); ss += __shfl_xor(ss, 32);
                    const float inv = rsqrtf(ss * (1.0f / 64.0f) + EPS) * (pn < 10 ? 0.125f * LOG2E : 1.0f);
#pragma unroll
                    for (int bj = 0; bj < 2; ++bj) {
                        const f32x4 o0 = v[bj][0] * inv * gv[bj][0], o1 = v[bj][1] * inv * gv[bj][1]; const int e = wc * 64 + bj * 32 + fq * 8;
                        *(u32x4*)(Z + (size_t)r * NIN + pn * 256 + e) = pack8(o0, o1);
                        if (pn >= 10) { const int c5 = (pn - 10) * 256 + e;
                            if (r >= MP) { float* o = dout + OFF_KS + (size_t)(r - MP) * 512 + c5; *(f32x4*)o = o0; *(f32x4*)(o + 4) = o1; }
                            else if (r >= MP - 512) { float* o = dout + OFF_KP + (size_t)(r - (MP - 512)) * 512 + c5; *(f32x4*)o = o0; *(f32x4*)(o + 4) = o1; } }
                    }
                }
        }
    }
};
struct EpiRes {
    static constexpr bool PERM = true, AFTER_DRAIN = false;
    const float* res_p; const float* res_s; float* out; bf16_t* hb; float* stats;
    __device__ __forceinline__ void operator()(const f32x4 (&acc)[2][2][4][2], const Unit& u, int wr, int wc, int fr, int fq) const {
        const int rbase = u.pm * 256 + wr * 64 + fr;
#pragma unroll
        for (int ai = 0; ai < 2; ++ai)
#pragma unroll
            for (int m = 0; m < 4; ++m) {
                const int r = rbase + ai * 128 + m * 16; const float* rp = r < MP ? res_p + (size_t)r * DM : res_s + (size_t)(r - MP) * DM; float ss = 0.f;
#pragma unroll
                for (int bj = 0; bj < 2; ++bj) {
                    const int c0 = u.pn * 256 + bj * 128 + wc * 32 + fq * 8;
                    const f32x4 h0 = *(const f32x4*)(rp + c0) + acc[ai][bj][m][0], h1 = *(const f32x4*)(rp + c0 + 4) + acc[ai][bj][m][1];
                    float* o = out + (size_t)r * DM + c0; *(f32x4*)o = h0; *(f32x4*)(o + 4) = h1;
                    *(u32x4*)(hb + (size_t)r * DM + c0) = pack8(h0, h1);
                    ss += sum4(h0 * h0) + sum4(h1 * h1);
                }
                ss += __shfl_xor(ss, 16); ss += __shfl_xor(ss, 32);
                if (fq == 0) stats[(size_t)r * 16 + u.pn * 4 + wc] = ss;
            }
    }
};
struct EpiGU {
    static constexpr bool PERM = true, AFTER_DRAIN = false;
    const float* stats; bf16_t* T;
    __device__ __forceinline__ void operator()(const f32x4 (&acc)[2][2][4][2], const Unit& u, int wr, int wc, int fr, int fq) const {
        const int rbase = u.pm * 256 + wr * 64 + fr;
#pragma unroll
        for (int ai = 0; ai < 2; ++ai)
#pragma unroll
            for (int m = 0; m < 4; ++m) {
                const int r = rbase + ai * 128 + m * 16; const float rs = rstd16(stats, r);
                const f32x4 g0 = acc[ai][0][m][0] * rs, g1 = acc[ai][0][m][1] * rs, u0 = acc[ai][1][m][0] * rs, u1 = acc[ai][1][m][1] * rs;
                const f32x4 t0 = g0 * sigmoid4(g0) * u0, t1 = g1 * sigmoid4(g1) * u1;
                *(u32x4*)(T + (size_t)r * FF + u.pn * 128 + wc * 32 + fq * 8) = pack8(t0, t1);
            }
    }
};
struct EpiPP {
    static constexpr bool PERM = true, AFTER_DRAIN = false;
    bf16_t* O;
    __device__ __forceinline__ void operator()(const f32x4 (&acc)[2][2][4][2], const Unit& u, int wr, int wc, int fr, int fq) const {
        const unsigned boff = (unsigned)((u.pm * 256 + wr * 64 + fr) * DM + u.pn * 256 + wc * 32 + fq * 8) * 2u;
#pragma unroll
        for (int ai = 0; ai < 2; ++ai)
#pragma unroll
            for (int m = 0; m < 4; ++m) {
#pragma unroll
                for (int bj = 0; bj < 2; ++bj) *(u32x4*)((char*)O + (boff + (unsigned)((ai * 128 + m * 16) * DM + bj * 128) * 2u)) = pack8(acc[ai][bj][m][0], acc[ai][bj][m][1]);
                asm volatile("" ::: "memory"); }
    }
};
struct EpiPG {
    static constexpr bool PERM = true, AFTER_DRAIN = false;
    const float* stats; const bf16_t* PP; float* y;
    __device__ __forceinline__ void operator()(const f32x4 (&acc)[2][2][4][2], const Unit& u, int wr, int wc, int fr, int fq) const {
        const int rbase = u.pm * 256 + wr * 64 + fr;
#pragma unroll
        for (int ai = 0; ai < 2; ++ai)
#pragma unroll
            for (int m = 0; m < 4; ++m) {
                const int r = rbase + ai * 128 + m * 16; const float rs = rstd16(stats, r);
#pragma unroll
                for (int bj = 0; bj < 2; ++bj) {
                    const int c0 = u.pn * 256 + bj * 128 + wc * 32 + fq * 8; float* o = y + (size_t)r * DM + c0;
                    const u32x4 pw = *(const u32x4*)(PP + (size_t)r * DM + c0);
                    const f32x4 p0 = {__uint_as_float(pw.x << 16), __uint_as_float(pw.x & 0xffff0000u), __uint_as_float(pw.y << 16), __uint_as_float(pw.y & 0xffff0000u)};
                    const f32x4 p1 = {__uint_as_float(pw.z << 16), __uint_as_float(pw.z & 0xffff0000u), __uint_as_float(pw.w << 16), __uint_as_float(pw.w & 0xffff0000u)};
                    const f32x4 y0 = *(const f32x4*)o + p0 * sigmoid4(acc[ai][bj][m][0] * rs), y1 = *(const f32x4*)(o + 4) + p1 * sigmoid4(acc[ai][bj][m][1] * rs);
                    *(f32x4*)o = y0; *(f32x4*)(o + 4) = y1;
                }
            }
    }
};

constexpr int NWAVES = 8, NTHR = 512;
#ifndef MK_ONE_LAUNCH
#define MK_ONE_LAUNCH 1
#endif
constexpr int NPH = 6;
constexpr int RING_OFF = 0, RING_BYTES = 131072, LDSCTL_OFF = RING_BYTES, MISC_OFF = LDSCTL_OFF + 320, LDS_BYTES = 147456;
typedef short s16x8 __attribute__((ext_vector_type(8)));
typedef short s16x4 __attribute__((ext_vector_type(4)));
typedef float f32x16 __attribute__((ext_vector_type(16)));
typedef unsigned u32x2v __attribute__((ext_vector_type(2)));

struct Frame {
    LAS unsigned char* lds; volatile LAS unsigned* MISC; gu32* ctl;
    int tid, lane, wave, vcu, G;
};
__device__ __forceinline__ float wave_sum(float v) {
#pragma unroll
    for (int o = 1; o < 64; o <<= 1) v += __shfl_xor(v, o);
    return v;
}
__device__ __forceinline__ int crow(int r, int hi) { return (r & 3) + 8 * (r >> 2) + 4 * hi; }
__device__ __forceinline__ s16x8 frag(const LAS bf16* X, int ld, int row0, int k0, int lane) { return *(const LAS s16x8*)(X + (row0 + (lane & 31)) * ld + k0 + 8 * (lane >> 5)); }
#define MFMA32(a, b, c) __builtin_amdgcn_mfma_f32_32x32x16_bf16((a), (b), (c), 0, 0, 0)

constexpr int NQ = 306, TK_NONE = 0xffff;
constexpr int CW_ADONE = 1024;
constexpr int CW_TKT = 2048;
constexpr int CW_DEP = 32768;
constexpr size_t WS_TAB = 1 * MiB + 512 * 1024;
__device__ __forceinline__ unsigned enc_unit(int kind, int q, int pn) { return (unsigned)((kind << 12) | (q << 5) | pn); }
__device__ __forceinline__ void build_ticket_table(unsigned short* tab) {
    int o = 0;
    for (int pn = 0; pn < 4; ++pn) for (int q = 0; q < 9; ++q) tab[o++] = (unsigned short)enc_unit(0, q, pn);
    for (int pn = 0; pn < 22; ++pn) tab[o++] = (unsigned short)enc_unit(1, 0, pn);
    int body = 0;
    for (int g = 0; g < 2; ++g) for (int pn = 0; pn < 22; ++pn) for (int j = 0; j < 4; ++j) {
        if (body == 40) for (int c = 0; c < 4; ++c) tab[o++] = (unsigned short)enc_unit(2, 0, c);
        if (body == 126) for (int c = 0; c < 4; ++c) tab[o++] = (unsigned short)enc_unit(3, 0, c);
        tab[o++] = (unsigned short)enc_unit(1, 1 + 4 * g + j, pn); ++body; }
    for (int pn = 0; pn < 4; ++pn) for (int q = 1; q < 9; ++q) tab[o++] = (unsigned short)enc_unit(2, q, pn);
    for (int pn = 0; pn < 4; ++pn) for (int q = 1; q < 9; ++q) tab[o++] = (unsigned short)enc_unit(3, q, pn);
}
__device__ __forceinline__ void tr_item(const float* W, int ldw, int K, int k0, int c0, bf16* WT, int d0, const float* g, LAS float* scr, int lane) {
    const int kb = lane >> 3, n4 = (lane & 7) * 4;
    f32x4 v[8];
#pragma unroll
    for (int i = 0; i < 8; ++i) v[i] = *(const f32x4*)(W + (size_t)(k0 + 8 * i + kb) * ldw + c0 + n4);
#pragma unroll
    for (int i = 0; i < 8; ++i) { const int kk = 8 * i + kb; f32x4 x = v[i]; if (g) x = x * g[k0 + kk];
        LAS float* d = scr + kk * 33 + n4; d[0] = x[0]; d[1] = x[1]; d[2] = x[2]; d[3] = x[3]; }
    LDS_WAIT(); asm volatile("" ::: "memory");
    const int c = lane & 7;
#pragma unroll
    for (int j = 0; j < 4; ++j) { const int n = (lane >> 3) + 8 * j; const LAS float* s = scr + (8 * c) * 33 + n;
        v4u o; o.x = pk2(s[0 * 33], s[1 * 33]); o.y = pk2(s[2 * 33], s[3 * 33]); o.z = pk2(s[4 * 33], s[5 * 33]); o.w = pk2(s[6 * 33], s[7 * 33]);
        *(GAS v4u*)(WT + (size_t)(d0 + n) * K + k0 + 8 * c) = o; }
    LDS_WAIT(); asm volatile("" ::: "memory");
}
__device__ __forceinline__ int sigma_in(int np) {
    const int pn = np >> 8, t = np & 255;
    if (pn < 4) { const int base = (pn >> 1) * 512 + (pn & 1) * 256, tt = t & 127; return base + (tt >> 6) * 128 + (t >> 7) * 64 + (tt & 63); }
    if (pn >= 8 && pn < 12) return pn * 256 + ((t >> 5) & 3) * 64 + (t >> 7) * 32 + (t & 31);
    return np;
}
struct Ptrs {
    const float *xp, *xs, *ck, *cv, *sr, *pp, *ps, *g_mix, *w_in, *g_ro, *g_q, *g_k, *rel_bias, *w_out, *g_ffn, *w_g, *w_u, *w_d, *g_ple, *w_pg, *w_pp;
    float* out; unsigned char* ws;
};
template <int PART> __device__ __forceinline__ void p0_prologue(Frame& F, const Ptrs& P) {
    LAS float* scr = (LAS float*)(F.lds + RING_OFF + F.wave * 16384);
    const int gw = F.vcu * NWAVES + F.wave, NGW = F.G * NWAVES;
    bf16* Wt_in = (bf16*)(P.ws + WS_WIN); bf16* Wt_out = (bf16*)(P.ws + WS_WOUT); bf16* Wt_gu = (bf16*)(P.ws + WS_WGU);
    bf16* Wt_dn = (bf16*)(P.ws + WS_WDN); bf16* Wt_pg = (bf16*)(P.ws + WS_WPG); bf16* Wt_pp = (bf16*)(P.ws + WS_WPP);
    constexpr int I_IN = 16 * (NIN / 32), I_OUT = 16 * 32, I_GU = 16 * (NGU / 32), I_DN = (FF / 64) * 32, I_PG = 16 * 32, I_PP = 4 * 32;
    constexpr int NITEMS = I_IN + I_OUT + I_GU + I_DN + I_PG + I_PP;
    for (int it = (PART == 0 ? 0 : I_IN) + gw; it < (PART == 0 ? I_IN : NITEMS); it += NGW) {
        int r = it;
        if (r < I_IN) { const int nb = r % (NIN / 32), kb = r / (NIN / 32); tr_item(P.w_in, NIN, DM, 64 * kb, sigma_in(32 * nb), Wt_in, 32 * nb, P.g_mix, scr, F.lane); continue; } r -= I_IN;
        if (r < I_OUT) { const int nb = r % 32, kb = r / 32; tr_item(P.w_out, DM, DM, 64 * kb, 32 * nb, Wt_out, 32 * nb, nullptr, scr, F.lane); continue; } r -= I_OUT;
        if (r < I_GU) { const int nb = r % (NGU / 32), kb = r / (NGU / 32); const int np = 32 * nb, pn = np >> 8, t = np & 255;
            tr_item(t < 128 ? P.w_g : P.w_u, FF, DM, 64 * kb, 128 * pn + (t & 127), Wt_gu, np, P.g_ffn, scr, F.lane); continue; } r -= I_GU;
        if (r < I_DN) { const int nb = r % 32, kb = r / 32; tr_item(P.w_d, DM, FF, 64 * kb, 32 * nb, Wt_dn, 32 * nb, nullptr, scr, F.lane); continue; } r -= I_DN;
        if (r < I_PG) { const int nb = r % 32, kb = r / 32; tr_item(P.w_pg, DM, DM, 64 * kb, 32 * nb, Wt_pg, 32 * nb, P.g_ple, scr, F.lane); continue; } r -= I_PG;
        { const int nb = r % 32, kb = r / 32; tr_item(P.w_pp, DM, PLE, 64 * kb, 32 * nb, Wt_pp, 32 * nb, nullptr, scr, F.lane); }
    }
    if (PART == 0) {
    bf16* xb = (bf16*)(P.ws + WS_XB); float* rstdx = (float*)(P.ws + WS_RSTDX);
    for (int m = gw; m < M; m += NGW) {
        const float* xr = m < MP ? P.xp + (size_t)m * DM : P.xs + (size_t)(m - MP) * DM;
        const GAS f32x4* x4 = (const GAS f32x4*)xr + F.lane; f32x4 v[4]; float s = 0.f;
#pragma unroll
        for (int j = 0; j < 4; ++j) { v[j] = x4[64 * j]; s += sum4(v[j] * v[j]); }
        s = wave_sum(s);
        GAS unsigned long long* o8 = (GAS unsigned long long*)(xb + (size_t)m * DM) + F.lane;
#pragma unroll
        for (int j = 0; j < 4; ++j) o8[64 * j] = (unsigned long long)pk2(v[j].x, v[j].y) | ((unsigned long long)pk2(v[j].z, v[j].w) << 32);
        if (F.lane == 0) rstdx[m] = rsqrtf(s * (1.0f / DM) + EPS);
    }
    }
    if (PART == 1) {
    bf16* pb = (bf16*)(P.ws + WS_PB);
    for (int m = gw; m < M; m += NGW) {
        const float* pr = m < MP ? P.pp + (size_t)m * PLE : P.ps + (size_t)(m - MP) * PLE;
        const f32x4 v = ((const GAS f32x4*)pr)[F.lane];
        ((GAS unsigned long long*)(pb + (size_t)m * PLE))[F.lane] = (unsigned long long)pk2(v.x, v.y) | ((unsigned long long)pk2(v.z, v.w) << 32);
    }
    }
    if (PART == 0) {
    if (F.vcu == 0 && F.tid == 0) build_ticket_table((unsigned short*)(P.ws + WS_TAB));
    if (F.vcu == 1) {
        float gq = fabsf(P.g_q[F.lane]), gk = fabsf(P.g_k[F.lane]);
        const float* rb = P.rel_bias + (size_t)F.wave * 513; const float rb512 = rb[512]; float bm = 0.f;
        for (int i = F.lane; i < 513; i += 64) bm = fmaxf(bm, rb[i] - rb512);
#pragma unroll
        for (int o = 1; o < 64; o <<= 1) { gq = fmaxf(gq, __shfl_xor(gq, o)); gk = fmaxf(gk, __shfl_xor(gk, o)); bm = fmaxf(bm, __shfl_xor(bm, o)); }
        if (F.lane == 0) ((float*)(P.ws + WS_M0))[F.wave] = (8.0f * gq * gk + bm) * LOG2E * 1.01f + 0.25f; }
    float* cosT = (float*)(P.ws + WS_COS); float* sinT = (float*)(P.ws + WS_SIN);
    for (int i = (F.vcu * NTHR + F.tid); i < MP * 64; i += F.G * NTHR) {
        const int pos = i >> 6, j = i & 63;
        const float inv = exp2f(-(float)j * (13.287712379549449f / 64.0f));
        const float ang = (float)pos * inv;
        const float k = rintf(ang * 0.15915494309189535f);
        float r = fmaf(-k, 6.28125f, ang); r = fmaf(-k, 1.9353071795864769e-3f, r);
        cosT[i] = __cosf(r); sinT[i] = __sinf(r);
    }
    }
}

typedef short v4i16_t __attribute__((ext_vector_type(4)));
__device__ __forceinline__ s16x4 trrd(const LAS bf16* p) { return __builtin_bit_cast(s16x4, __builtin_amdgcn_ds_read_tr16_b64_v4i16((LAS v4i16_t*)p)); }
__device__ __forceinline__ s16x8 frag_tr(const LAS bf16* X, int ld, int rA, int rB, int c0, int lane) {
    const int i = lane & 15, co = c0 + 16 * ((lane >> 4) & 1) + 4 * (i & 3);
    const s16x4 lo = trrd(X + (rA + (i >> 2)) * ld + co), hh = trrd(X + (rB + (i >> 2)) * ld + co);
    return (s16x8){lo[0], lo[1], lo[2], lo[3], hh[0], hh[1], hh[2], hh[3]};
}
__device__ __forceinline__ s16x8 pack_p(const f32x16& p, int s2) { u32x4 w;
    w.x = pg8::cvt_pk_bf16(p[8 * s2 + 0], p[8 * s2 + 1]); w.y = pg8::cvt_pk_bf16(p[8 * s2 + 2], p[8 * s2 + 3]); w.z = pg8::cvt_pk_bf16(p[8 * s2 + 4], p[8 * s2 + 5]); w.w = pg8::cvt_pk_bf16(p[8 * s2 + 6], p[8 * s2 + 7]);
    return __builtin_bit_cast(s16x8, w); }
__device__ __forceinline__ void unpack8(v4u w, float* f) {
    f[0] = __uint_as_float(w.x << 16); f[1] = __uint_as_float(w.x & 0xffff0000u); f[2] = __uint_as_float(w.y << 16); f[3] = __uint_as_float(w.y & 0xffff0000u);
    f[4] = __uint_as_float(w.z << 16); f[5] = __uint_as_float(w.z & 0xffff0000u); f[6] = __uint_as_float(w.w << 16); f[7] = __uint_as_float(w.w & 0xffff0000u); }
constexpr int LDT = 160;
constexpr int LQ = 136;

constexpr int LKA = 72, LVA = 96;
template <bool FIX> __device__ __forceinline__ void attn_unit(Frame& F, const Ptrs& P, const bool samp, const int idx, const int h) {
    const bf16* Z = (const bf16*)(P.ws + WS_Z); bf16* MIX = (bf16*)P.out;
    const int tid = F.tid, lane = F.lane, wave = F.wave, hi = lane >> 5, l31 = lane & 31, wp = wave >> 1, qb = wave & 1;
    LAS bf16* Kb = (LAS bf16*)F.lds; LAS bf16* Vb = Kb + 2 * 64 * LKA; LAS float* BTX = (LAS float*)(F.lds + 43008); LAS float* SC = (LAS float*)(F.lds + 46336) + wave * 32;
    LAS bf16* OS = (LAS bf16*)(F.lds + 47360) + wave * (32 * LKA);
    const int nsteps = samp ? 9 : 12, t0 = samp ? 0 : (idx >= 2 ? 0 : 8 - 4 * idx);
    const int rowq = samp ? MP + 64 * idx + 32 * qb : 256 * idx + 64 * wp + 32 * qb;
    const bool wact = samp ? (wp == 0) : true;
    __syncthreads();
    const float M0 = FIX ? ((const float*)(P.ws + WS_M0))[h] : 0.f;
    { const float* rb = P.rel_bias + (size_t)h * 513; const float rb512 = rb[512];
      for (int i = tid; i < 832; i += NTHR) BTX[i] = (i <= 512 ? (rb[i] - rb512) * LOG2E : 0.f) - M0; }
    s16x8 qf[4];
    { const bf16* qs = Z + (size_t)(rowq + l31) * NIN + ZQA + h * 64 + 8 * hi;
#pragma unroll
      for (int s = 0; s < 4; ++s) qf[s] = wact ? *(const s16x8*)(qs + 16 * s) : (s16x8){0, 0, 0, 0, 0, 0, 0, 0}; }
    const int srow = tid >> 3, sch = tid & 7; v4u kreg, vreg, kreg2, vreg2;
#define A_LOAD(t) do { if (samp && (t) < 8) { \
            const float* ks_ = P.ck + ((size_t)(idx * 512 + 64 * (t) + srow) * 8 + h) * 64 + sch * 8; const float* vs_ = P.cv + ((size_t)(idx * 512 + 64 * (t) + srow) * 8 + h) * 64 + sch * 8; \
            const f32x4 a_ = *(const f32x4*)ks_, b_ = *(const f32x4*)(ks_ + 4), c_ = *(const f32x4*)vs_, d_ = *(const f32x4*)(vs_ + 4); \
            kreg = pack8(a_, b_); vreg = pack8(c_, d_); \
        } else { const int kr_ = samp ? MP + 64 * idx + srow : 64 * (4 * idx - 8 + (t)) + srow; const bf16* s_ = Z + (size_t)kr_ * NIN + h * 64 + sch * 8; \
            kreg = *(const v4u*)(s_ + ZKA); vreg = *(const v4u*)(s_ + ZVA); } } while (0)
#define A_STORE(buf) do { *(LAS v4u*)(Kb + (buf) * 64 * LKA + srow * LKA + sch * 8) = kreg; *(LAS v4u*)(Vb + (buf) * 64 * LVA + srow * LVA + sch * 8) = vreg; } while (0)
    f32x16 o0 = {}, o1 = {}; float m_run = 0.f, l_run = 0.f; bool first = true;
    const int b0 = 768 + 32 * qb + l31 - 4 * hi;
    A_LOAD(t0); A_STORE(0); if (t0 + 1 < nsteps) A_LOAD(t0 + 1);
    __syncthreads();
    for (int t = t0, it = 0; t < nsteps; ++t, ++it) {
        if (t + 2 < nsteps) { const v4u k1 = kreg, v1 = vreg; A_LOAD(t + 2); kreg2 = kreg; vreg2 = vreg; kreg = k1; vreg = v1; }
        const int j = samp ? t : t - wp;
        if (wact && j >= 0 && j <= 8) {
            const LAS bf16* Kc = Kb + (it & 1) * 64 * LKA; const LAS bf16* Vc = Vb + (it & 1) * 64 * LVA;
            f32x16 p[2];
#pragma unroll
            for (int lb = 0; lb < 2; ++lb) { f32x16 c;
                if (j >= 4) { const LAS float* bp = BTX + (b0 - 64 * j - 32 * lb);
#pragma unroll
                    for (int r = 0; r < 16; ++r) c[r] = FIX ? bp[-((r & 3) + 8 * (r >> 2))] : bp[-((r & 3) + 8 * (r >> 2))] - m_run;
                } else {
#pragma unroll
                    for (int r = 0; r < 16; ++r) c[r] = FIX ? -M0 : -m_run; }
#pragma unroll
                for (int s = 0; s < 4; ++s) c = MFMA32(frag(Kc, LKA, 32 * lb, 16 * s, lane), qf[s], c);
                p[lb] = c; }
            if (!FIX) {
            float mx = p[0][0];
#pragma unroll
            for (int r = 0; r < 16; ++r) { mx = fmaxf(mx, p[0][r]); mx = fmaxf(mx, p[1][r]); }
            mx = fmaxf(mx, __shfl_xor(mx, 32));
            if (first || __any(mx > 8.0f)) {
                const float d = first ? mx : fmaxf(mx, 0.f); m_run += d;
#pragma unroll
                for (int r = 0; r < 16; ++r) { p[0][r] -= d; p[1][r] -= d; }
                if (!first) { const float alpha = exp2f(-d); l_run *= alpha;
                    if (hi == 0) SC[l31] = alpha;
                    asm volatile("s_waitcnt lgkmcnt(0)" ::: "memory");
#pragma unroll
                    for (int r = 0; r < 16; ++r) { const float f = SC[crow(r, hi)]; o0[r] *= f; o1[r] *= f; }
                    asm volatile("s_waitcnt lgkmcnt(0)" ::: "memory"); }
                first = false;
            }
            }
            float ls = 0.f;
#pragma unroll
            for (int r = 0; r < 16; ++r) { p[0][r] = __builtin_amdgcn_exp2f(p[0][r]); p[1][r] = __builtin_amdgcn_exp2f(p[1][r]); ls += p[0][r] + p[1][r]; }
            l_run += ls;
#pragma unroll
            for (int lb = 0; lb < 2; ++lb)
#pragma unroll
                for (int s2 = 0; s2 < 2; ++s2) { const s16x8 pa = pack_p(p[lb], s2); const int kb = 32 * lb + 16 * s2 + 4 * hi;
                    o0 = MFMA32(pa, frag_tr(Vc, LVA, kb, kb + 8, 0, lane), o0); o1 = MFMA32(pa, frag_tr(Vc, LVA, kb, kb + 8, 32, lane), o1); }
        }
        if (t + 1 < nsteps) { A_STORE((it + 1) & 1); kreg = kreg2; vreg = vreg2; }
        __syncthreads();
    }
#undef A_LOAD
#undef A_STORE
    if (wact) {
        l_run += __shfl_xor(l_run, 32);
        if (hi == 0) SC[l31] = 1.0f / l_run;
        asm volatile("s_waitcnt lgkmcnt(0)" ::: "memory");
#pragma unroll
        for (int r = 0; r < 16; ++r) { const int n = crow(r, hi); const float f = SC[n]; OS[n * LKA + l31] = (bf16)f2bf(o0[r] * f); OS[n * LKA + 32 + l31] = (bf16)f2bf(o1[r] * f); }
        asm volatile("s_waitcnt lgkmcnt(0)" ::: "memory");
        const int row = lane >> 1, half = lane & 1; bf16* dst = MIX + (size_t)(rowq + row) * DM + 512 + h * 64 + 32 * half;
#pragma unroll
        for (int c = 0; c < 4; ++c) *(v4u*)(dst + 8 * c) = *(const LAS v4u*)(OS + row * LKA + 32 * half + 8 * c);
    }
}

__device__ __forceinline__ void retU_item(Frame& F, const Ptrs& P, const bool samp, const int idx, const int h) {
    const bf16* Z = (const bf16*)(P.ws + WS_Z);
    const int tid = F.tid, lane = F.lane, wave = F.wave, hi = lane >> 5, l31 = lane & 31;
    LAS bf16* Vi = (LAS bf16*)F.lds; LAS bf16* Ki = Vi + 128 * LDT;
    const int T = samp ? 64 : 256, row0 = samp ? MP + 64 * idx : 256 * idx;
    const LAS bf16* X = samp ? Ki : Vi; const LAS bf16* Y = samp ? Vi : Ki;
    const int ib = wave >> 1, jb0 = 2 * (wave & 1);
    f32x16 a0 = {}, a1 = {};
    for (int p0 = 0; p0 < T; p0 += 128) {
        const int rows = (T - p0) < 128 ? (T - p0) : 128;
        __syncthreads();
        for (int c = tid; c < rows * 16; c += NTHR) { const int row = c >> 4, ch = c & 15;
            const bf16* src = Z + (size_t)(row0 + p0 + row) * NIN + h * 128 + ch * 8;
            *(LAS v4u*)(Vi + row * LDT + ch * 8) = *(const v4u*)(src + ZV); *(LAS v4u*)(Ki + row * LDT + ch * 8) = *(const v4u*)(src + ZK); }
        __syncthreads();
        for (int s = 0; s < rows / 16; ++s) { const int rA = 16 * s + 8 * hi;
            const s16x8 a = frag_tr(X, LDT, rA, rA + 4, 32 * ib, lane);
            a0 = MFMA32(a, frag_tr(Y, LDT, rA, rA + 4, 32 * jb0, lane), a0); a1 = MFMA32(a, frag_tr(Y, LDT, rA, rA + 4, 32 * jb0 + 32, lane), a1); }
    }
    const float lg2 = lg2_gamma(h), gT1 = exp2f((float)(T - 1) * lg2);
    if (!samp) {
        float* UF = (float*)(P.ws + WS_UF) + (size_t)(idx * 4 + h) * 16384;
#pragma unroll
        for (int r = 0; r < 16; ++r) { const int e = 32 * ib + crow(r, hi); UF[e * 128 + 32 * jb0 + l31] = gT1 * a0[r]; UF[e * 128 + 32 * jb0 + 32 + l31] = gT1 * a1[r]; }
    } else {
        const float g64 = exp2f(64.0f * lg2);
        const float* R0 = P.sr + (size_t)(idx * 4 + h) * 16384; float* RO = P.out + OFF_RS + (size_t)(idx * 4 + h) * 16384;
#pragma unroll
        for (int r = 0; r < 16; ++r) { const int d = 32 * ib + crow(r, hi); const int e0 = 32 * jb0 + l31;
            RO[d * 128 + e0] = g64 * R0[d * 128 + e0] + gT1 * a0[r]; RO[d * 128 + e0 + 32] = g64 * R0[d * 128 + e0 + 32] + gT1 * a1[r]; }
    }
}
__device__ __forceinline__ void ret_scan(Frame& F, const Ptrs& P) {
    const int gid = F.vcu * NTHR + F.tid;
    if (gid < 32768) {
        typedef float f32x2v __attribute__((ext_vector_type(2)));
        const f32x2v* uf = (const f32x2v*)(P.ws + WS_UF) + gid; unsigned* rb = (unsigned*)(P.ws + WS_RB) + gid; const int h = gid >> 13;
        const float g = exp2f(256.0f * lg2_gamma(h)); float R0 = 0.f, R1 = 0.f;
        f32x2v u[64];
#pragma unroll
        for (int c = 0; c < 64; ++c) u[c] = uf[(size_t)c * 32768];
#pragma unroll
        for (int c = 0; c < 64; ++c) { rb[(size_t)c * 32768] = pk2(R0, R1); R0 = g * R0 + u[c].x; R1 = g * R1 + u[c].y; }
        const int el = (2 * gid) & 16383, e = el >> 7, d = el & 127;
        float* o = P.out + OFF_RP + (size_t)h * 16384; o[d * 128 + e] = R0; o[(d + 1) * 128 + e] = R1;
    }
}
__device__ __forceinline__ void retO_item(Frame& F, const Ptrs& P, const bool samp, const int idx, const int h) {
    const bf16* Z = (const bf16*)(P.ws + WS_Z); bf16* MIX = (bf16*)P.out;
    const int tid = F.tid, lane = F.lane, wave = F.wave, hi = lane >> 5, l31 = lane & 31;
    LAS bf16* RT = (LAS bf16*)F.lds; LAS bf16* Kb = RT + 128 * LQ; LAS bf16* Vb = Kb + 2 * 64 * LQ; LAS bf16* OS = Kb + wave * (32 * LQ);
    const int T = samp ? 64 : 256, row0 = samp ? MP + 64 * idx : 256 * idx, nkb_all = T / 64;
    const int rb = wave < 4 ? wave : 11 - wave; const bool act = rb * 32 < T; const int nkb = act ? (rb >> 1) + 1 : 0;
    const float gam = exp2f(lg2_gamma(h));
    __syncthreads();
    if (!samp) { const bf16* rs = (const bf16*)(P.ws + WS_RB) + (size_t)(idx * 4 + h) * 16384;
#pragma unroll
        for (int i = 0; i < 4; ++i) { const int c = tid + NTHR * i, e = c >> 4, ch = c & 15; *(LAS v4u*)(RT + e * LQ + ch * 8) = *(const v4u*)(rs + e * 128 + ch * 8); }
    } else { const float* rs = P.sr + (size_t)(idx * 4 + h) * 16384;
#pragma unroll
        for (int i = 0; i < 8; ++i) { const int id = i * NTHR + tid, d = id >> 5, e0 = (id & 31) * 4; const f32x4 v = *(const f32x4*)(rs + d * 128 + e0);
            RT[(e0 + 0) * LQ + d] = (bf16)f2bf(v.x); RT[(e0 + 1) * LQ + d] = (bf16)f2bf(v.y); RT[(e0 + 2) * LQ + d] = (bf16)f2bf(v.z); RT[(e0 + 3) * LQ + d] = (bf16)f2bf(v.w); } }
    s16x8 qf[8];
    { const bf16* qs = Z + (size_t)(row0 + (act ? 32 * rb : 0) + l31) * NIN + ZQ + h * 128 + 8 * hi;
#pragma unroll
      for (int s = 0; s < 8; ++s) qf[s] = *(const s16x8*)(qs + 16 * s); }
    v4u kreg[2], vreg[2];
#define R_LOAD(kb) do { _Pragma("unroll") for (int i_ = 0; i_ < 2; ++i_) { const int c_ = tid + NTHR * i_; const bf16* s_ = Z + (size_t)(row0 + 64 * (kb) + (c_ >> 4)) * NIN + h * 128 + (c_ & 15) * 8; \
        kreg[i_] = *(const v4u*)(s_ + ZK); vreg[i_] = *(const v4u*)(s_ + ZV); } } while (0)
#define R_STORE(buf) do { _Pragma("unroll") for (int i_ = 0; i_ < 2; ++i_) { const int c_ = tid + NTHR * i_; \
        *(LAS v4u*)(Kb + (buf) * 64 * LQ + (c_ >> 4) * LQ + (c_ & 15) * 8) = kreg[i_]; *(LAS v4u*)(Vb + (buf) * 64 * LDT + (c_ >> 4) * LDT + (c_ & 15) * 8) = vreg[i_]; } } while (0)
    R_LOAD(0); R_STORE(0); __syncthreads();
    f32x16 acc[4];
#pragma unroll
    for (int eb = 0; eb < 4; ++eb) { f32x16 a = {};
        if (act) {
#pragma unroll
            for (int s = 0; s < 8; ++s) a = MFMA32(qf[s], frag(RT, LQ, 32 * eb, 16 * s, lane), a); }
        acc[eb] = a * gam; }
    for (int kb = 0; kb < nkb_all; ++kb) {
        if (kb + 1 < nkb_all) R_LOAD(kb + 1);
        if (kb < nkb) {
            const LAS bf16* Kc = Kb + (kb & 1) * 64 * LQ; const LAS bf16* Vc = Vb + (kb & 1) * 64 * LDT; const bool diag = (kb == nkb - 1);
#pragma unroll
            for (int lb = 0; lb < 2; ++lb) {
                if (diag && lb == 1 && !(rb & 1)) continue;
                f32x16 p = {};
#pragma unroll
                for (int s = 0; s < 8; ++s) p = MFMA32(frag(Kc, LQ, 32 * lb, 16 * s, lane), qf[s], p);
                if (diag) { const int nl = 32 * (rb & 1) + l31;
#pragma unroll
                    for (int r = 0; r < 16; ++r) if (32 * lb + crow(r, hi) > nl) p[r] = 0.f; }
#pragma unroll
                for (int s2 = 0; s2 < 2; ++s2) { const s16x8 pa = pack_p(p, s2); const int kr = 32 * lb + 16 * s2 + 4 * hi;
#pragma unroll
                    for (int eb = 0; eb < 4; ++eb) acc[eb] = MFMA32(pa, frag_tr(Vc, LDT, kr, kr + 8, 32 * eb, lane), acc[eb]); }
            }
        }
        if (kb + 1 < nkb_all) R_STORE((kb + 1) & 1);
        __syncthreads();
    }
#undef R_LOAD
#undef R_STORE
    if (act) {
#pragma unroll
        for (int eb = 0; eb < 4; ++eb)
#pragma unroll
            for (int r = 0; r < 16; ++r) OS[crow(r, hi) * LQ + 32 * eb + l31] = (bf16)f2bf(acc[eb][r]);
        asm volatile("s_waitcnt lgkmcnt(0)" ::: "memory");
        const int row = lane >> 1, half = lane & 1, grow = row0 + 32 * rb + row;
        v4u ow[8]; float ss = 0.f;
#pragma unroll
        for (int c = 0; c < 8; ++c) { ow[c] = *(const LAS v4u*)(OS + row * LQ + 64 * half + 8 * c); float f[8]; unpack8(ow[c], f);
#pragma unroll
            for (int i = 0; i < 8; ++i) ss += f[i] * f[i]; }
        ss += __shfl_xor(ss, 1);
        const float inv = rsqrtf(ss * (1.0f / 128.0f) + EPS);
        const bf16* gs = Z + (size_t)grow * NIN + ZG + h * 128 + 64 * half; const float* gro = P.g_ro + h * 128 + 64 * half; bf16* dst = MIX + (size_t)grow * DM + h * 128 + 64 * half;
#pragma unroll
        for (int c = 0; c < 8; ++c) { float f[8], g[8]; unpack8(ow[c], f); unpack8(*(const v4u*)(gs + 8 * c), g);
            const f32x4 r0 = *(const f32x4*)(gro + 8 * c), r1 = *(const f32x4*)(gro + 8 * c + 4); f32x4 x0, x1;
#pragma unroll
            for (int i = 0; i < 4; ++i) { x0[i] = g[i] * __builtin_amdgcn_rcpf(1.0f + __builtin_amdgcn_exp2f(-g[i] * LOG2E)) * f[i] * inv * r0[i];
                                          x1[i] = g[4 + i] * __builtin_amdgcn_rcpf(1.0f + __builtin_amdgcn_exp2f(-g[4 + i] * LOG2E)) * f[4 + i] * inv * r1[i]; }
            *(v4u*)(dst + 8 * c) = pack8(x0, x1); }
    }
}

#ifndef ST_AUX
#define ST_AUX 0
#endif
typedef __amdgpu_buffer_rsrc_t rsrc_t;
__device__ __forceinline__ rsrc_t mk_rsrc(const void* p, unsigned bytes) { return __builtin_amdgcn_make_buffer_rsrc((void*)p, 0, (int)bytes, 0x00020000); }
__device__ __forceinline__ f32x4 ld_sc1_f4(rsrc_t r, unsigned off) { return __builtin_bit_cast(f32x4, __builtin_amdgcn_raw_buffer_load_b128(r, (int)off, 0, 16)); }
__device__ __forceinline__ void st_sc1_f4(rsrc_t r, unsigned off, f32x4 v) { __builtin_amdgcn_raw_buffer_store_b128(__builtin_bit_cast(v4u, v), r, (int)off, 0, ST_AUX); }
__device__ __forceinline__ void st_sc1_u4(rsrc_t r, unsigned off, v4u v) { __builtin_amdgcn_raw_buffer_store_b128(v, r, (int)off, 0, ST_AUX); }
__device__ __forceinline__ float rstd16_sc1(rsrc_t r, int row) {
    const f32x4 a = ld_sc1_f4(r, (unsigned)row * 64u), b = ld_sc1_f4(r, (unsigned)row * 64u + 16u), c = ld_sc1_f4(r, (unsigned)row * 64u + 32u), d = ld_sc1_f4(r, (unsigned)row * 64u + 48u);
    return rsqrtf(((sum4(a) + sum4(b)) + (sum4(c) + sum4(d))) * (1.0f / DM) + EPS);
}
struct TailSched {
    const Ptrs& P; gu32* ctl; volatile LAS unsigned* LW;
    int tk_read, tk_fetched, par; unsigned tkv, myq;
    __device__ __forceinline__ gu32* dep(int stage, int pm) const { return ctl + CW_DEP + (stage * 72 + pm) * 64; }
    __device__ __forceinline__ static pg8::SUnit dec(unsigned e) { pg8::SUnit u; u.kind = (int)((e >> 12) & 7u); u.pm = (int)(((e >> 5) & 15u) * 8u + (e >> 16)); u.pn = (int)(e & 31u); return u; }
    __device__ __forceinline__ unsigned tab_entry(unsigned tk) const { const unsigned short* tab = (const unsigned short*)(P.ws + WS_TAB); return (unsigned)__builtin_amdgcn_readfirstlane((int)tab[tk & 511u]) | ((tk >> 9) << 16); }
    __device__ __forceinline__ unsigned fetch_ticket() const {
        const unsigned i = __hip_atomic_fetch_add(ctl + CW_TKT + 64 * myq, 1u, __ATOMIC_RELAXED, __HIP_MEMORY_SCOPE_AGENT);
        return i < (unsigned)NQ ? ((myq << 9) | i) : (unsigned)TK_NONE;
    }
    __device__ __forceinline__ void need_of(const pg8::SUnit& u, int& stage, unsigned& need) const {
        stage = -1; need = 0u;
        if (u.kind == 1) { stage = 0; need = 32u; } else if (u.kind == 2) { stage = 1; need = 176u; } else if (u.kind == 3) { stage = 2; need = 32u; }
    }
    __device__ __forceinline__ bool first(pg8::SUnit& cur, int wid, int lane) {
        tk_read = 1; tk_fetched = 2; par = 0; tkv = 0u; myq = xb_xcc_id() & 7u;
        if (wid == 0 && lane == 0) { const unsigned t0 = fetch_ticket(); const unsigned t1 = (t0 == (unsigned)TK_NONE) ? t0 : fetch_ticket(); LW[0] = t0; LW[1] = t1; }
        __syncthreads();
        const unsigned t0 = LW[0];
        if (t0 == (unsigned)TK_NONE) return false;
        cur = dec(tab_entry(t0)); return true;
    }
    __device__ __forceinline__ void spin_ge(gu32* p, unsigned need, int lane) const {
        unsigned spins = 0;
        while ((unsigned)__builtin_amdgcn_readfirstlane((int)__hip_atomic_load(p, __ATOMIC_RELAXED, __HIP_MEMORY_SCOPE_AGENT)) < need) {
            __builtin_amdgcn_s_sleep(8);
            if (++spins > (1u << 22)) { if (lane == 0) __hip_atomic_store(ctl + CW_TMO, 1u, __ATOMIC_RELAXED, __HIP_MEMORY_SCOPE_AGENT); break; }
        }
    }
    __device__ __forceinline__ void wait_ready(const pg8::SUnit& u, int lane) const {
        int stage; unsigned need; need_of(u, stage, need);
        if (stage < 0) return;
        spin_ge(dep(stage, u.pm), need, lane);
        if (u.kind == 3) spin_ge(ctl + CW_ADONE, 288u * 8u, lane);
    }
    __device__ __forceinline__ void probe(const pg8::SUnit& cur, int wid, int lane) {
        par ^= 1;
        if (cur.kind == 3) return;
        if (wid == 0) {
            const unsigned tk = LW[tk_read & 1]; unsigned e = TK_NONE, ok = 1u;
            if (tk != (unsigned)TK_NONE) { e = tab_entry(tk); const pg8::SUnit u = dec(e); int stage; unsigned need; need_of(u, stage, need);
                if (stage >= 0) ok = ((unsigned)__builtin_amdgcn_readfirstlane((int)__hip_atomic_load(dep(stage, u.pm), __ATOMIC_RELAXED, __HIP_MEMORY_SCOPE_AGENT)) >= need) ? 1u : 0u;
                if (u.kind == 3 && ok) ok = ((unsigned)__builtin_amdgcn_readfirstlane((int)__hip_atomic_load(ctl + CW_ADONE, __ATOMIC_RELAXED, __HIP_MEMORY_SCOPE_AGENT)) >= 288u * 8u) ? 1u : 0u; }
            if (lane == 0) { LW[2 + par] = e; LW[4 + par] = ok; }
        }
    }
    __device__ __forceinline__ bool peek(const pg8::SUnit& cur, pg8::SUnit& nxt, bool& ready) {
        if (cur.kind == 3) { nxt.kind = 4; nxt.pm = cur.pm; nxt.pn = cur.pn; ready = true; return true; }
        const unsigned e = LW[2 + par], ok = LW[4 + par]; ++tk_read;
        if ((e & 0xffffu) == (unsigned)TK_NONE) { ready = false; return false; }
        nxt = dec(e); ready = ok != 0u; return true;
    }
    __device__ __forceinline__ pg8::SGeo geo(const pg8::SUnit& u) const {
        pg8::SGeo g; const char* ws = (const char*)P.ws;
        if (u.kind == 0)      { g.ld = DM;  g.nt = 16; g.A = (const char*)P.out; g.B = ws + WS_WOUT; }
        else if (u.kind == 1) { g.ld = DM;  g.nt = 16; g.A = ws + WS_HB; g.B = ws + WS_WGU; }
        else if (u.kind == 2) { g.ld = FF;  g.nt = 44; g.A = ws + WS_T;  g.B = ws + WS_WDN; }
        else if (u.kind == 3) { g.ld = PLE; g.nt = 4;  g.A = ws + WS_PB; g.B = ws + WS_WPP; }
        else                  { g.ld = DM;  g.nt = 16; g.A = ws + WS_H2B; g.B = ws + WS_WPG; }
        g.hstep = 128u * g.ld * 2u; g.A += (size_t)u.pm * 2u * g.hstep; g.B += (size_t)u.pn * 2u * g.hstep; return g;
    }
    __device__ __forceinline__ void rstd_pair(rsrc_t rS, int base, int lane, float& ra, float& rb) const {
        const unsigned o0 = (unsigned)(base + lane) * 64u, o1 = o0 + 128u * 64u;
        const f32x4 a0 = ld_sc1_f4(rS, o0), a1 = ld_sc1_f4(rS, o0 + 16u), a2 = ld_sc1_f4(rS, o0 + 32u), a3 = ld_sc1_f4(rS, o0 + 48u);
        const f32x4 b0 = ld_sc1_f4(rS, o1), b1 = ld_sc1_f4(rS, o1 + 16u), b2 = ld_sc1_f4(rS, o1 + 32u), b3 = ld_sc1_f4(rS, o1 + 48u);
        ra = rsqrtf(((sum4(a0) + sum4(a1)) + (sum4(a2) + sum4(a3))) * (1.0f / DM) + EPS);
        rb = rsqrtf(((sum4(b0) + sum4(b1)) + (sum4(b2) + sum4(b3))) * (1.0f / DM) + EPS);
    }
    __device__ __forceinline__ void epilogue(const f32x4 (&acc)[2][2][4][2], const pg8::SUnit& u, bool has_next, const pg8::SUnit& nxt, int wr, int wc, int fr, int fq, int wid, int lane) {
        const bool fetch = has_next && nxt.kind != 3;
        if (fetch && wid == 0 && lane == 0) tkv = fetch_ticket();
        const int rbase = u.pm * 256 + wr * 64 + fr;
        if (u.kind == 0 || u.kind == 2) {
            const rsrc_t rR = mk_rsrc(P.ws + (u.kind == 0 ? WS_XB : WS_HB), (unsigned)M * DM * 2u), rH = mk_rsrc(P.ws + (u.kind == 0 ? WS_HB : WS_H2B), (unsigned)M * DM * 2u);
            const rsrc_t rS = mk_rsrc(P.ws + (u.kind == 0 ? WS_ST1 : WS_ST2), (unsigned)M * 64u);
            v4u rw[2][4][2];
#pragma unroll
            for (int ai = 0; ai < 2; ++ai)
#pragma unroll
                for (int m = 0; m < 4; ++m)
#pragma unroll
                    for (int bj = 0; bj < 2; ++bj) rw[ai][m][bj] = __builtin_amdgcn_raw_buffer_load_b128(rR, (int)(((unsigned)(rbase + ai * 128 + m * 16) * DM + (unsigned)(u.pn * 256 + bj * 128 + wc * 32 + fq * 8)) * 2u), 0, 16);
#pragma unroll
            for (int ai = 0; ai < 2; ++ai)
#pragma unroll
                for (int m = 0; m < 4; ++m) {
                    const int r = rbase + ai * 128 + m * 16; float ss = 0.f;
#pragma unroll
                    for (int bj = 0; bj < 2; ++bj) {
                        const unsigned eo = (unsigned)r * DM + (unsigned)(u.pn * 256 + bj * 128 + wc * 32 + fq * 8);
                        float f[8]; unpack8(rw[ai][m][bj], f);
                        const f32x4 h0 = (f32x4){f[0], f[1], f[2], f[3]} + acc[ai][bj][m][0], h1 = (f32x4){f[4], f[5], f[6], f[7]} + acc[ai][bj][m][1];
                        st_sc1_u4(rH, eo * 2u, pack8(h0, h1));
                        ss += sum4(h0 * h0) + sum4(h1 * h1);
                    }
                    ss += __shfl_xor(ss, 16); ss += __shfl_xor(ss, 32);
                    if (fq == 0) __builtin_amdgcn_raw_buffer_store_b32(__float_as_uint(ss), rS, (int)(((unsigned)r * 16u + (unsigned)(u.pn * 4 + wc)) * 4u), 0, ST_AUX);
                }
        } else if (u.kind == 1) {
            const rsrc_t rS = mk_rsrc(P.ws + WS_ST1, (unsigned)M * 64u), rT = mk_rsrc(P.ws + WS_T, (unsigned)M * FF * 2u);
            float ra, rb; rstd_pair(rS, u.pm * 256 + wr * 64, lane, ra, rb);
#pragma unroll
            for (int ai = 0; ai < 2; ++ai)
#pragma unroll
                for (int m = 0; m < 4; ++m) {
                    const int r = rbase + ai * 128 + m * 16; const float rs = __shfl(ai ? rb : ra, m * 16 + fr);
                    const f32x4 g0 = acc[ai][0][m][0] * rs, g1 = acc[ai][0][m][1] * rs, u0 = acc[ai][1][m][0] * rs, u1 = acc[ai][1][m][1] * rs;
                    const f32x4 t0 = g0 * sigmoid4(g0) * u0, t1 = g1 * sigmoid4(g1) * u1;
                    st_sc1_u4(rT, ((unsigned)r * FF + (unsigned)(u.pn * 128 + wc * 32 + fq * 8)) * 2u, pack8(t0, t1));
                }
        } else if (u.kind == 3) {
            const rsrc_t rT = mk_rsrc(P.ws + WS_T, (unsigned)M * FF * 2u);
#pragma unroll
            for (int ai = 0; ai < 2; ++ai)
#pragma unroll
                for (int m = 0; m < 4; ++m) { const int r = rbase + ai * 128 + m * 16;
#pragma unroll
                    for (int bj = 0; bj < 2; ++bj) st_sc1_u4(rT, ((unsigned)r * FF + (unsigned)(u.pn * 256 + bj * 128 + wc * 32 + fq * 8)) * 2u, pack8(acc[ai][bj][m][0], acc[ai][bj][m][1]));
                    asm volatile("" ::: "memory"); }
        } else {
            const rsrc_t rH = mk_rsrc(P.ws + WS_H2B, (unsigned)M * DM * 2u), rS = mk_rsrc(P.ws + WS_ST2, (unsigned)M * 64u), rT = mk_rsrc(P.ws + WS_T, (unsigned)M * FF * 2u);
            float ra, rb; rstd_pair(rS, u.pm * 256 + wr * 64, lane, ra, rb);
#pragma unroll
            for (int ai = 0; ai < 2; ++ai)
#pragma unroll
                for (int m = 0; m < 4; ++m) {
                    const int r = rbase + ai * 128 + m * 16; const float rs = __shfl(ai ? rb : ra, m * 16 + fr);
                    v4u pw[2], hw[2];
#pragma unroll
                    for (int bj = 0; bj < 2; ++bj) { const unsigned c0 = (unsigned)(u.pn * 256 + bj * 128 + wc * 32 + fq * 8);
                        pw[bj] = __builtin_amdgcn_raw_buffer_load_b128(rT, (int)(((unsigned)r * FF + c0) * 2u), 0, 16); hw[bj] = __builtin_amdgcn_raw_buffer_load_b128(rH, (int)(((unsigned)r * DM + c0) * 2u), 0, 16); }
#pragma unroll
                    for (int bj = 0; bj < 2; ++bj) {
                        const unsigned eo = (unsigned)r * DM + (unsigned)(u.pn * 256 + bj * 128 + wc * 32 + fq * 8);
                        float pf[8], hf[8]; unpack8(pw[bj], pf); unpack8(hw[bj], hf);
                        const f32x4 y0 = (f32x4){hf[0], hf[1], hf[2], hf[3]} + (f32x4){pf[0], pf[1], pf[2], pf[3]} * sigmoid4(acc[ai][bj][m][0] * rs);
                        const f32x4 y1 = (f32x4){hf[4], hf[5], hf[6], hf[7]} + (f32x4){pf[4], pf[5], pf[6], pf[7]} * sigmoid4(acc[ai][bj][m][1] * rs);
                        float* o = P.out + eo; *(f32x4*)o = y0; *(f32x4*)(o + 4) = y1;
                    }
                }
        }
        asm volatile("s_waitcnt vmcnt(0)" ::: "memory");
        if (u.kind <= 2 && lane == 0) __hip_atomic_fetch_add(dep(u.kind, u.pm), 1u, __ATOMIC_RELAXED, __HIP_MEMORY_SCOPE_AGENT);
        if (u.kind == 0 && lane == 0) __hip_atomic_fetch_add(ctl + CW_ADONE, 1u, __ATOMIC_RELAXED, __HIP_MEMORY_SCOPE_AGENT);
        if (fetch) { if (wid == 0 && lane == 0) LW[tk_fetched & 1] = tkv; ++tk_fetched; }
    }
};

struct Args { const float* in[21]; float* out; unsigned char* ws; int ph_lo, ph_hi; };
template <int PHM> __global__ void __launch_bounds__(NTHR, 2) skel_fwd(Args args) {
    extern __shared__ __attribute__((aligned(16))) unsigned char lds[];
    Frame F;
    F.lds = (LAS unsigned char*)lds; F.MISC = (volatile LAS unsigned*)(F.lds + MISC_OFF);
    F.tid = threadIdx.x; F.lane = F.tid & 63; F.wave = __builtin_amdgcn_readfirstlane(F.tid >> 6);
    F.G = gridDim.x; { const int bx = blockIdx.x; F.vcu = (F.G % 8 == 0) ? (bx % 8) * (F.G / 8) + bx / 8 : bx; }
    unsigned char* ws = args.ws; F.ctl = (gu32*)(ws + WS_CTL);
    Ptrs P; P.xp = args.in[0]; P.xs = args.in[1]; P.ck = args.in[2]; P.cv = args.in[3]; P.sr = args.in[4]; P.pp = args.in[5]; P.ps = args.in[6]; P.g_mix = args.in[7]; P.w_in = args.in[8];
    P.g_ro = args.in[9]; P.g_q = args.in[10]; P.g_k = args.in[11]; P.rel_bias = args.in[12]; P.w_out = args.in[13]; P.g_ffn = args.in[14]; P.w_g = args.in[15]; P.w_u = args.in[16];
    P.w_d = args.in[17]; P.g_ple = args.in[18]; P.w_pg = args.in[19]; P.w_pp = args.in[20]; P.out = args.out; P.ws = ws;
    for (int u = F.tid; u < (LDS_BYTES - LDSCTL_OFF) / 4; u += NTHR) ((LAS unsigned*)(F.lds + LDSCTL_OFF))[u] = 0u;
    __syncthreads();
    XcdBarrier bar; bar.bar = (unsigned*)(F.ctl + CW_BAR); bar.x = 0; bar.st = nullptr;
    if (MK_ONE_LAUNCH) bar = xcd_barrier_post((unsigned*)(F.ctl + CW_BAR), F.MISC + 8);
#define GRID_BAR() do { if (MK_ONE_LAUNCH) xcd_barrier(bar); } while (0)
    const int lo = args.ph_lo, hi = args.ph_hi;
#define IN(k) (((PHM >> (k)) & 1) && lo <= (k) && (k) < hi)
#define BOTH(k) (IN(k) && IN((k) + 1))
    bf16* XB = (bf16*)(ws + WS_XB); bf16* ZB = (bf16*)(ws + WS_Z); bf16* HB = (bf16*)(ws + WS_HB); bf16* TB = (bf16*)(ws + WS_T);
    float* ST1 = (float*)(ws + WS_ST1); float* ST2 = (float*)(ws + WS_ST2);

    if (IN(0)) { p0_prologue<0>(F, P); if (BOTH(0)) GRID_BAR(); }
    if (IN(1)) {
        pg8::Gemm g{XB, (const bf16*)(ws + WS_WIN), M, NIN, DM}; pg8::StaticOrder S; S.init(M, NIN, F.G, (int)blockIdx.x);
        EpiIn E{ZB, (const float*)(ws + WS_RSTDX), (const float*)(ws + WS_COS), (const float*)(ws + WS_SIN), P.g_q, P.g_k, P.out};
        pg8::gemm_phase<EpiIn, pg8::StaticOrder, true, true>(F.lds + RING_OFF, g, S, E);
        if (BOTH(1)) GRID_BAR();
    }
    if (IN(2)) {
        for (int it = F.vcu; it < 384; it += F.G) { if (it < 256) retU_item(F, P, false, it >> 2, it & 3); else retU_item(F, P, true, (it - 256) >> 2, (it - 256) & 3); }
        { const float* m0p = (const float*)(P.ws + WS_M0); float m0mx = m0p[0];
#pragma unroll
          for (int i = 1; i < 8; ++i) m0mx = fmaxf(m0mx, m0p[i]);
          const bool fixok = m0mx <= 60.f;
          for (int it = F.vcu; it < 512; it += F.G) { if (fixok) attn_unit<true>(F, P, false, it & 63, it >> 6); else attn_unit<false>(F, P, false, it & 63, it >> 6); }
          for (int it = F.vcu; it < 256; it += F.G) attn_unit<false>(F, P, true, it >> 3, it & 7); }
        if (BOTH(2)) GRID_BAR();
    }
    if (IN(3)) { ret_scan(F, P); p0_prologue<1>(F, P); if (BOTH(3)) GRID_BAR(); }
    if (IN(4)) {
        for (int it = F.vcu; it < 384; it += F.G) { if (it < 256) retO_item(F, P, false, it >> 2, it & 3); else retO_item(F, P, true, (it - 256) >> 2, (it - 256) & 3); }
        __syncthreads();
        if (BOTH(4)) GRID_BAR();
    }
    if (IN(5)) {
        TailSched S{P, F.ctl, F.MISC + 16, 0, 0, 0, 0u, 0u};
        pg8::gemm_stream<TailSched>(F.lds + RING_OFF, S);
    }
#undef IN
#undef BOTH
}

extern "C" void kernel_launch(void* const* d_in, const int* in_sizes, int n_in, void* d_out, int out_size, void* d_ws, size_t ws_size, hipStream_t stream) {
    static int grid = 0;
    if (grid == 0) {
        if (n_in != 21 || out_size != (int)OUT_TOTAL || ws_size < WS_END) { fprintf(stderr, "kernel_launch: unexpected shapes n_in %d out %d ws %zu\n", n_in, out_size, ws_size); grid = -1; return; }
#if MK_ONE_LAUNCH
        if (hipFuncSetAttribute((const void*)skel_fwd<0x3f>, hipFuncAttributeMaxDynamicSharedMemorySize, LDS_BYTES) != hipSuccess) { fprintf(stderr, "kernel_launch: hipFuncSetAttribute failed\n"); grid = -1; return; }
#else
#define SETATTR(ph) (void)hipFuncSetAttribute((const void*)skel_fwd<(1 << (ph))>, hipFuncAttributeMaxDynamicSharedMemorySize, LDS_BYTES)
        SETATTR(0); SETATTR(1); SETATTR(2); SETATTR(3); SETATTR(4); SETATTR(5); SETATTR(6); SETATTR(7); SETATTR(8); SETATTR(9);
#endif
        int dev = 0, cus = 0;
        if (hipGetDevice(&dev) != hipSuccess || hipDeviceGetAttribute(&cus, hipDeviceAttributeMultiprocessorCount, dev) != hipSuccess) { grid = -1; return; }
        (void)hipGetLastError();
        grid = cus;
    }
    if (grid < 0) return;
    (void)hipMemsetAsync((char*)d_ws + WS_CTL, 0, CTL_ZERO_BYTES, stream);
    Args a{};
    for (int i = 0; i < 21; ++i) a.in[i] = (const float*)d_in[i];
    a.out = (float*)d_out; a.ws = (unsigned char*)d_ws;
#if MK_ONE_LAUNCH
    a.ph_lo = 0; a.ph_hi = NPH;
    hipLaunchKernelGGL(skel_fwd<0x3f>, dim3(grid), dim3(NTHR), LDS_BYTES, stream, a);
#else
#define LAUNCH_PH(ph) do { a.ph_lo = (ph); a.ph_hi = (ph) + 1; hipLaunchKernelGGL(skel_fwd<(1 << (ph))>, dim3(grid), dim3(NTHR), LDS_BYTES, stream, a); } while (0)
    LAUNCH_PH(0); LAUNCH_PH(1); LAUNCH_PH(2); LAUNCH_PH(3); LAUNCH_PH(4); LAUNCH_PH(5); LAUNCH_PH(6); LAUNCH_PH(7); LAUNCH_PH(8); LAUNCH_PH(9);
#endif
}
```

```cpp
#include <hip/hip_runtime.h>
#include <cstdio>
#include <cstdint>
namespace pg8 {
#define PG8_LAS __attribute__((address_space(3)))
typedef unsigned short bf16_t;
typedef short bf16x8 __attribute__((ext_vector_type(8)));
typedef float f32x4 __attribute__((ext_vector_type(4)));
typedef unsigned u32x4 __attribute__((ext_vector_type(4)));
constexpr int BM = 256, BK = 64, HALF = 128, HTB = HALF * BK * 2  , STAGE_BYTES = 8 * HTB, NXCD = 8, WGM = 8;

__host__ __device__ __forceinline__ int lds_byte(int r, int c) { const int st = (r >> 4) * 2 + (c >> 5), rr = r & 15, cc = c & 31, ob = rr * 64 + cc * 2; return st * 1024 + (ob ^ (((ob >> 9) & 1) << 5)); }
__host__ __device__ __forceinline__ void stage_rc(int b, int& R, int& C) { const int st = b / 1024, sb = b % 1024, swz = sb ^ (((sb >> 9) & 1) << 5); R = (st >> 1) * 16 + swz / 64; C = (st & 1) * 32 + (swz % 64) / 2; }
__host__ __device__ __forceinline__ int perm32(int rho) { const int n = rho >> 4, i = rho & 15; return 8 * (i >> 2) + 4 * n + (i & 3); }

struct Unit { int pm, pn; };
struct Gemm { const bf16_t* A; const bf16_t* Bt; int M, N, K; };

struct StaticOrder {
    int nM, nN, nwg, G, c;
    __host__ __device__ void init(int M, int N, int G_, int c_) { nM = M / BM; nN = N / BM; nwg = nM * nN; G = G_; c = c_; }
    __host__ __device__ bool next(int i, Unit& u) const {
        const long L = (long)i * G + c; if (L >= nwg) return false;
        int wgid = (int)L; { const int q = nwg / NXCD, r = nwg % NXCD, xcd = wgid % NXCD, off = wgid / NXCD; wgid = (xcd < r ? xcd * (q + 1) : r * (q + 1) + (xcd - r) * q) + off; }
        const int nig = WGM * nN, gid = wgid / nig, fm = gid * WGM, gsz = (nM - fm) < WGM ? (nM - fm) : WGM;
        u.pm = fm + ((wgid % nig) % gsz); u.pn = (wgid % nig) / gsz; return true;
    }
    __device__ __forceinline__ void a_ready(const Unit&) const {}
    __device__ __forceinline__ void done(const Unit&) const {}
};

__device__ __forceinline__ unsigned cvt_pk_bf16(float lo, float hi) { unsigned r; asm volatile("v_cvt_pk_bf16_f32 %0, %1, %2" : "=v"(r) : "v"(lo), "v"(hi)); return r; }
typedef float f32x2 __attribute__((ext_vector_type(2)));
template <class Epi, class Sched, bool ALIGN_EPI = false, bool SP2 = false>
__device__ __forceinline__ void gemm_phase(PG8_LAS unsigned char* lds, const Gemm g, const Sched& S, const Epi& E) {
    int tid_ = threadIdx.x; asm volatile("" : "+v"(tid_));
    const int tid = tid_, wid = __builtin_amdgcn_readfirstlane(tid >> 6), lane = tid & 63, wr = wid >> 2, wc = wid & 3, fr = lane & 15, fq = lane >> 4;
    const int K = g.K, nt = K / BK;
    unsigned voffA[2], voffB[2];
#pragma unroll
    for (int i = 0; i < 2; ++i) { int R, C; stage_rc(tid * 16 + i * 8192, R, C); const int Rb = Epi::PERM ? ((R & ~31) + perm32(R & 31)) : R;
        voffA[i] = (unsigned)(R * K + C) * 2u; voffB[i] = (unsigned)(Rb * K + C) * 2u; }
    const size_t kstep = (size_t)(BK * 2);
    const size_t hstep = (size_t)HALF * K * 2;
    const size_t tstep = 2 * hstep;
    const unsigned ldsw = (unsigned)wid * 1024u;
    const int aoff = lds_byte(wr * 64 + fr, fq * 8), boff = lds_byte(wc * 32 + fr, fq * 8);
#define PG8_SA(b, h) (((b) * 2 + (h)) * HTB)
#define PG8_SB(b, h) ((4 + (b) * 2 + (h)) * HTB)
#define PG8_STAGE(bufoff, gbase, voff) do { _Pragma("unroll") for (int _i = 0; _i < 2; ++_i) \
        __builtin_amdgcn_global_load_lds((const unsigned*)((const char*)(gbase) + (voff)[_i]), (PG8_LAS unsigned*)(lds + (bufoff) + ldsw + _i * 8192), 16, 0, 0); } while (0)
#define PG8_LDA(dst, b, h) do { _Pragma("unroll") for (int m = 0; m < 4; ++m) _Pragma("unroll") for (int k = 0; k < 2; ++k) dst[m][k] = *(const PG8_LAS bf16x8*)(lds + PG8_SA(b, h) + aoff + m * 2048 + k * 1024); } while (0)
#define PG8_LDB(dst, b, h) do { _Pragma("unroll") for (int n = 0; n < 2; ++n) _Pragma("unroll") for (int k = 0; k < 2; ++k) dst[n][k] = *(const PG8_LAS bf16x8*)(lds + PG8_SB(b, h) + boff + n * 2048 + k * 1024); } while (0)
#define PG8_MMA(ai, bj, At, Bt) do { __builtin_amdgcn_s_setprio(1); _Pragma("unroll") for (int m = 0; m < 4; ++m) _Pragma("unroll") for (int n = 0; n < 2; ++n) _Pragma("unroll") for (int k = 0; k < 2; ++k) \
        acc[ai][bj][m][n] = __builtin_amdgcn_mfma_f32_16x16x32_bf16(Bt[n][k], At[m][k], acc[ai][bj][m][n], 0, 0, 0); __builtin_amdgcn_s_setprio(0); } while (0)
#define PG8_WAIT_V(n) asm volatile("s_waitcnt vmcnt(" #n ")" ::: "memory")
#define PG8_WAIT_L(n) asm volatile("s_waitcnt lgkmcnt(" #n ")" ::: "memory")
#define PG8_BAR __builtin_amdgcn_s_barrier()
#define PG8_SCHED __builtin_amdgcn_sched_barrier(0)
    Unit cur, nxt; int ui = 0;
    if (!S.next(0, cur)) return;
    f32x4 acc[2][2][4][2];
#pragma unroll
    for (int a = 0; a < 2; ++a)
#pragma unroll
        for (int b = 0; b < 2; ++b)
#pragma unroll
            for (int m = 0; m < 4; ++m)
#pragma unroll
                for (int n = 0; n < 2; ++n) acc[a][b][m][n] = (f32x4){0.f, 0.f, 0.f, 0.f};
    bf16x8 At[4][2], B0[2][2], B1[2][2];
    const char* cA = (const char*)g.A + (size_t)cur.pm * tstep; const char* cB = (const char*)g.Bt + (size_t)cur.pn * tstep;
    S.a_ready(cur);
    if constexpr (SP2) {
        PG8_STAGE(PG8_SB(0, 0), cB, voffB); PG8_STAGE(PG8_SB(0, 1), cB + hstep, voffB); PG8_STAGE(PG8_SA(0, 0), cA, voffA); PG8_STAGE(PG8_SA(0, 1), cA + hstep, voffA);
        if (wr == 1) PG8_BAR;
        PG8_WAIT_V(2); PG8_BAR;
        PG8_STAGE(PG8_SB(1, 0), cB + kstep, voffB); PG8_STAGE(PG8_SA(1, 0), cA + kstep, voffA); PG8_STAGE(PG8_SB(1, 1), cB + hstep + kstep, voffB);
        PG8_WAIT_V(6); PG8_BAR;
    } else {
        PG8_STAGE(PG8_SB(0, 0), cB, voffB); PG8_STAGE(PG8_SA(0, 0), cA, voffA); PG8_STAGE(PG8_SB(0, 1), cB + hstep, voffB); PG8_STAGE(PG8_SA(0, 1), cA + hstep, voffA);
        if (wr == 1) PG8_BAR;
        PG8_WAIT_V(4); PG8_BAR;
        PG8_STAGE(PG8_SB(1, 0), cB + kstep, voffB); PG8_STAGE(PG8_SA(1, 0), cA + kstep, voffA); PG8_STAGE(PG8_SB(1, 1), cB + hstep + kstep, voffB);
        PG8_WAIT_V(6); PG8_BAR;
    }
    for (;;) {
        const bool has_next = S.next(ui + 1, nxt);
        const char* nA = has_next ? (const char*)g.A + (size_t)nxt.pm * tstep : cA; const char* nB = has_next ? (const char*)g.Bt + (size_t)nxt.pn * tstep : cB;
        for (int t = 0; t < nt; t += 2) {
            const bool last = (t == nt - 2);
            const char* a1 = cA + (size_t)(t + 1) * kstep;
            const char* a2 = last ? nA : cA + (size_t)(t + 2) * kstep; const char* b2 = last ? nB : cB + (size_t)(t + 2) * kstep;
            const char* a3 = a2 + kstep; const char* b3 = b2 + kstep;
            if (last && has_next) S.a_ready(nxt);
            if constexpr (SP2) {
            PG8_LDB(B0, 0, 0); PG8_LDB(B1, 0, 1); PG8_SCHED; PG8_LDA(At, 0, 0); PG8_STAGE(PG8_SA(1, 1), a1 + hstep, voffA);
            PG8_WAIT_V(8); PG8_WAIT_L(0); PG8_BAR; PG8_MMA(0, 0, At, B0); PG8_MMA(0, 1, At, B1); PG8_BAR; PG8_SCHED;
            PG8_LDA(At, 0, 1); PG8_STAGE(PG8_SB(0, 0), b2, voffB); PG8_STAGE(PG8_SB(0, 1), b2 + hstep, voffB); PG8_STAGE(PG8_SA(0, 0), a2, voffA);
            PG8_WAIT_V(8); PG8_WAIT_L(0); PG8_BAR; PG8_MMA(1, 0, At, B0); PG8_MMA(1, 1, At, B1); PG8_BAR; PG8_SCHED;
            PG8_LDB(B0, 1, 0); PG8_LDB(B1, 1, 1); PG8_SCHED; PG8_LDA(At, 1, 0); PG8_STAGE(PG8_SA(0, 1), a2 + hstep, voffA);
            PG8_WAIT_V(8); PG8_WAIT_L(0); PG8_BAR; PG8_MMA(0, 0, At, B0); PG8_MMA(0, 1, At, B1); PG8_BAR; PG8_SCHED;
            PG8_LDA(At, 1, 1); PG8_STAGE(PG8_SB(1, 0), b3, voffB); PG8_STAGE(PG8_SB(1, 1), b3 + hstep, voffB); PG8_STAGE(PG8_SA(1, 0), a3, voffA);
            PG8_WAIT_V(8); PG8_WAIT_L(0); PG8_BAR; PG8_MMA(1, 0, At, B0); PG8_MMA(1, 1, At, B1); PG8_BAR; PG8_SCHED;
            } else {
            PG8_LDB(B0, 0, 0); PG8_SCHED; PG8_LDA(At, 0, 0); PG8_STAGE(PG8_SA(1, 1), a1 + hstep, voffA);
            PG8_WAIT_L(8); PG8_BAR; PG8_WAIT_L(0); PG8_MMA(0, 0, At, B0); PG8_BAR; PG8_SCHED;
            PG8_LDB(B1, 0, 1); PG8_STAGE(PG8_SB(0, 0), b2, voffB);
            PG8_BAR; PG8_WAIT_L(0); PG8_MMA(0, 1, At, B1); PG8_BAR;
            PG8_LDA(At, 0, 1); PG8_STAGE(PG8_SA(0, 0), a2, voffA);
            PG8_BAR; PG8_WAIT_L(0); PG8_MMA(1, 0, At, B0); PG8_BAR; PG8_SCHED;
            PG8_STAGE(PG8_SB(0, 1), b2 + hstep, voffB);
            PG8_WAIT_V(6); PG8_BAR; PG8_MMA(1, 1, At, B1); PG8_BAR;
            PG8_LDB(B0, 1, 0); PG8_SCHED; PG8_LDA(At, 1, 0); PG8_STAGE(PG8_SA(0, 1), a2 + hstep, voffA);
            PG8_WAIT_L(8); PG8_BAR; PG8_WAIT_L(0); PG8_MMA(0, 0, At, B0); PG8_BAR; PG8_SCHED;
            PG8_LDB(B1, 1, 1); PG8_STAGE(PG8_SB(1, 0), b3, voffB);
            PG8_BAR; PG8_WAIT_L(0); PG8_MMA(0, 1, At, B1); PG8_BAR;
            PG8_LDA(At, 1, 1); PG8_STAGE(PG8_SA(1, 0), a3, voffA);
            PG8_BAR; PG8_WAIT_L(0); PG8_MMA(1, 0, At, B0); PG8_BAR; PG8_SCHED;
            PG8_STAGE(PG8_SB(1, 1), b3 + hstep, voffB);
            PG8_WAIT_V(6); PG8_BAR; PG8_MMA(1, 1, At, B1); PG8_BAR;
            }
        }
        if constexpr (ALIGN_EPI) { if (wr == 0) PG8_BAR; }
        if constexpr (!Epi::AFTER_DRAIN) { E(acc, cur, wr, wc, fr, fq); S.done(cur); }
        if (!has_next) break;
#pragma unroll
        for (int a = 0; a < 2; ++a)
#pragma unroll
            for (int b = 0; b < 2; ++b)
#pragma unroll
                for (int m = 0; m < 4; ++m)
#pragma unroll
                    for (int n = 0; n < 2; ++n) acc[a][b][m][n] = (f32x4){0.f, 0.f, 0.f, 0.f};
        cur = nxt; cA = nA; cB = nB; ++ui;
        if constexpr (ALIGN_EPI) { if (wr == 1) PG8_BAR; }
    }
    PG8_WAIT_V(0);
    if constexpr (!ALIGN_EPI) { if (wr == 0) PG8_BAR; }
    PG8_BAR;
    if constexpr (Epi::AFTER_DRAIN) { E.fused(acc, cur, wr, wc, fr, fq, lds, wid, lane); S.done(cur); }
#undef PG8_SA
#undef PG8_SB
#undef PG8_STAGE
#undef PG8_LDA
#undef PG8_LDB
#undef PG8_MMA
#undef PG8_WAIT_V
#undef PG8_WAIT_L
#undef PG8_BAR
#undef PG8_SCHED
}
}
namespace pg8 {
struct SUnit { int kind, pm, pn; };
struct SGeo { const char* A; const char* B; unsigned ld, hstep; int nt; };

template <class Sched>
__device__ __forceinline__ void gemm_stream(PG8_LAS unsigned char* lds, Sched& S) {
    int tid_ = threadIdx.x; asm volatile("" : "+v"(tid_));
    const int tid = tid_, wid = __builtin_amdgcn_readfirstlane(tid >> 6), lane = tid & 63, wr = wid >> 2, wc = wid & 3, fr = lane & 15, fq = lane >> 4;
    unsigned RA2[2], RB2[2], C2[2];
#pragma unroll
    for (int i = 0; i < 2; ++i) { int R, C; stage_rc(tid * 16 + i * 8192, R, C); const int Rb = (R & ~31) + perm32(R & 31); RA2[i] = 2u * R; RB2[i] = 2u * Rb; C2[i] = 2u * C; }
    const size_t kstep = (size_t)(BK * 2);
    const unsigned ldsw = (unsigned)wid * 1024u;
    const int aoff = lds_byte(wr * 64 + fr, fq * 8), boff = lds_byte(wc * 32 + fr, fq * 8);
#define PG8_SA(b, h) (((b) * 2 + (h)) * HTB)
#define PG8_SB(b, h) ((4 + (b) * 2 + (h)) * HTB)
#ifndef STA_AUX
#define STA_AUX 0
#endif
#define PG8_STA(bufoff, gbase, ld_) do { _Pragma("unroll") for (int _i = 0; _i < 2; ++_i) \
        __builtin_amdgcn_global_load_lds((const unsigned*)((const char*)(gbase) + (RA2[_i] * (ld_) + C2[_i])), (PG8_LAS unsigned*)(lds + (bufoff) + ldsw + _i * 8192), 16, 0, STA_AUX); } while (0)
#define PG8_STB(bufoff, gbase, ld_) do { _Pragma("unroll") for (int _i = 0; _i < 2; ++_i) \
        __builtin_amdgcn_global_load_lds((const unsigned*)((const char*)(gbase) + (RB2[_i] * (ld_) + C2[_i])), (PG8_LAS unsigned*)(lds + (bufoff) + ldsw + _i * 8192), 16, 0, 0); } while (0)
#define PG8_LDA(dst, b, h) do { _Pragma("unroll") for (int m = 0; m < 4; ++m) _Pragma("unroll") for (int k = 0; k < 2; ++k) dst[m][k] = *(const PG8_LAS bf16x8*)(lds + PG8_SA(b, h) + aoff + m * 2048 + k * 1024); } while (0)
#define PG8_LDB(dst, b, h) do { _Pragma("unroll") for (int n = 0; n < 2; ++n) _Pragma("unroll") for (int k = 0; k < 2; ++k) dst[n][k] = *(const PG8_LAS bf16x8*)(lds + PG8_SB(b, h) + boff + n * 2048 + k * 1024); } while (0)
#define PG8_MMA(ai, bj, At, Bt) do { __builtin_amdgcn_s_setprio(1); _Pragma("unroll") for (int m = 0; m < 4; ++m) _Pragma("unroll") for (int n = 0; n < 2; ++n) _Pragma("unroll") for (int k = 0; k < 2; ++k) \
        acc[ai][bj][m][n] = __builtin_amdgcn_mfma_f32_16x16x32_bf16(Bt[n][k], At[m][k], acc[ai][bj][m][n], 0, 0, 0); __builtin_amdgcn_s_setprio(0); } while (0)
#define PG8_WAIT_V(n) asm volatile("s_waitcnt vmcnt(" #n ")" ::: "memory")
#define PG8_WAIT_L(n) asm volatile("s_waitcnt lgkmcnt(" #n ")" ::: "memory")
#define PG8_BAR __builtin_amdgcn_s_barrier()
#define PG8_SCHED __builtin_amdgcn_sched_barrier(0)
    SUnit cur, nxt;
    if (!S.first(cur, wid, lane)) return;
    f32x4 acc[2][2][4][2];
#pragma unroll
    for (int a = 0; a < 2; ++a)
#pragma unroll
        for (int b = 0; b < 2; ++b)
#pragma unroll
            for (int m = 0; m < 4; ++m)
#pragma unroll
                for (int n = 0; n < 2; ++n) acc[a][b][m][n] = (f32x4){0.f, 0.f, 0.f, 0.f};
    bf16x8 At[4][2], B0[2][2], B1[2][2];
    for (;;) {
        S.wait_ready(cur, lane);
        SGeo gc = S.geo(cur);
        PG8_STB(PG8_SB(0, 0), gc.B, gc.ld); PG8_STB(PG8_SB(0, 1), gc.B + gc.hstep, gc.ld); PG8_STA(PG8_SA(0, 0), gc.A, gc.ld); PG8_STA(PG8_SA(0, 1), gc.A + gc.hstep, gc.ld);
        if (wr == 1) PG8_BAR;
        PG8_WAIT_V(2); PG8_BAR;
        PG8_STB(PG8_SB(1, 0), gc.B + kstep, gc.ld); PG8_STA(PG8_SA(1, 0), gc.A + kstep, gc.ld); PG8_STB(PG8_SB(1, 1), gc.B + gc.hstep + kstep, gc.ld);
        PG8_WAIT_V(6); PG8_BAR;
        bool finished = false;
        for (;;) {
            bool has_next = false, ready = false; SGeo gn = gc;
            const int nt = gc.nt, tprobe = nt >= 6 ? nt - 4 : 0;
            for (int t = 0; t < nt; t += 2) {
                const bool last = (t == nt - 2);
                if (t == tprobe) S.probe(cur, wid, lane);
                if (last) { has_next = S.peek(cur, nxt, ready); if (has_next && ready) gn = S.geo(nxt); }
                const char* a1 = gc.A + (size_t)(t + 1) * kstep;
                const char* a2 = last ? gn.A : gc.A + (size_t)(t + 2) * kstep; const char* b2 = last ? gn.B : gc.B + (size_t)(t + 2) * kstep;
                const unsigned ld2 = last ? gn.ld : gc.ld, hs2 = last ? gn.hstep : gc.hstep;
                const char* a3 = a2 + kstep; const char* b3 = b2 + kstep;
                PG8_LDB(B0, 0, 0); PG8_LDB(B1, 0, 1); PG8_SCHED; PG8_LDA(At, 0, 0); PG8_STA(PG8_SA(1, 1), a1 + gc.hstep, gc.ld);
                PG8_WAIT_V(8); PG8_WAIT_L(0); PG8_BAR; PG8_MMA(0, 0, At, B0); PG8_MMA(0, 1, At, B1); PG8_BAR; PG8_SCHED;
                PG8_LDA(At, 0, 1); PG8_STB(PG8_SB(0, 0), b2, ld2); PG8_STB(PG8_SB(0, 1), b2 + hs2, ld2); PG8_STA(PG8_SA(0, 0), a2, ld2);
                PG8_WAIT_V(8); PG8_WAIT_L(0); PG8_BAR; PG8_MMA(1, 0, At, B0); PG8_MMA(1, 1, At, B1); PG8_BAR; PG8_SCHED;
                PG8_LDB(B0, 1, 0); PG8_LDB(B1, 1, 1); PG8_SCHED; PG8_LDA(At, 1, 0); PG8_STA(PG8_SA(0, 1), a2 + hs2, ld2);
                PG8_WAIT_V(8); PG8_WAIT_L(0); PG8_BAR; PG8_MMA(0, 0, At, B0); PG8_MMA(0, 1, At, B1); PG8_BAR; PG8_SCHED;
                PG8_LDA(At, 1, 1); PG8_STB(PG8_SB(1, 0), b3, ld2); PG8_STB(PG8_SB(1, 1), b3 + hs2, ld2); PG8_STA(PG8_SA(1, 0), a3, ld2);
                PG8_WAIT_V(8); PG8_WAIT_L(0); PG8_BAR; PG8_MMA(1, 0, At, B0); PG8_MMA(1, 1, At, B1); PG8_BAR; PG8_SCHED;
            }
            if (wr == 0) PG8_BAR;
            S.epilogue(acc, cur, has_next, nxt, wr, wc, fr, fq, wid, lane);
            if (!has_next) { finished = true; break; }
#pragma unroll
            for (int a = 0; a < 2; ++a)
#pragma unroll
                for (int b = 0; b < 2; ++b)
#pragma unroll
                    for (int m = 0; m < 4; ++m)
#pragma unroll
                        for (int n = 0; n < 2; ++n) acc[a][b][m][n] = (f32x4){0.f, 0.f, 0.f, 0.f};
            cur = nxt;
            if (!ready) break;
            gc = gn;
            if (wr == 1) PG8_BAR;
        }
        PG8_WAIT_V(0); PG8_BAR;
        if (finished) break;
    }
#undef PG8_SA
#undef PG8_SB
#undef PG8_STA
#undef PG8_STB
#undef PG8_LDA
#undef PG8_LDB
#undef PG8_MMA
#undef PG8_WAIT_V
#undef PG8_WAIT_L
#undef PG8_BAR
#undef PG8_SCHED
}
}

#define GAS __attribute__((address_space(1)))
#define LAS __attribute__((address_space(3)))
typedef unsigned short bf16;
typedef unsigned v4u __attribute__((ext_vector_type(4)));
typedef float f32x4 __attribute__((ext_vector_type(4)));
typedef short bf16x8 __attribute__((ext_vector_type(8)));
typedef GAS unsigned gu32;
typedef GAS unsigned long long gu64;
#define RLX_AGENT __ATOMIC_RELAXED, __HIP_MEMORY_SCOPE_AGENT
#define LDS_WAIT() asm volatile("s_waitcnt lgkmcnt(0)" ::: "memory")
#define VM_WAIT() asm volatile("s_waitcnt vmcnt(0)" ::: "memory")
__device__ __forceinline__ unsigned long long rt() { return __builtin_amdgcn_s_memrealtime(); }
__device__ __forceinline__ unsigned f2bf(float f) { unsigned u = __builtin_bit_cast(unsigned, f); return (u + 0x7fffu + ((u >> 16) & 1u)) >> 16; }
__device__ __forceinline__ unsigned pk2(float lo, float hi) { return f2bf(lo) | (f2bf(hi) << 16); }

#define XB_TMO      128
#define XB_XCNT(j)  (256  + 64 * (j))
#define XB_XSUB(j)  (1280 + 64 * (j))
#define XB_XGEN(j)  (2304 + 64 * (j))
#define XB_TOP      3328
#define XB_TOPGEN   3392
#define XCD_BAR_WORDS 3456
#define XB_SPIN_CAP (1u << 18)

__device__ __forceinline__ unsigned xb_ld(unsigned* p)              { return __hip_atomic_load(p, __ATOMIC_RELAXED, __HIP_MEMORY_SCOPE_AGENT); }
__device__ __forceinline__ unsigned xb_add(unsigned* p, unsigned v) { return __hip_atomic_fetch_add(p, v, __ATOMIC_RELAXED, __HIP_MEMORY_SCOPE_AGENT); }
__device__ __forceinline__ unsigned xb_xcc_id() { return (unsigned)__builtin_amdgcn_s_getreg((3 << 11) | 20) & 0xFu; }
#define XB_SPIN(cond, bar) do { unsigned _sp = 0; while (cond) { __builtin_amdgcn_s_sleep(1); \
    if ((++_sp & 255u) == 0u) { if (xb_ld(&(bar)[XB_TMO])) break; if (_sp > XB_SPIN_CAP) { atomicAdd(&(bar)[XB_TMO], 1u); break; } } } } while (0)

struct XcdBarrier {
    unsigned* bar; unsigned x;
    volatile LAS unsigned* st;
};

__device__ __forceinline__ XcdBarrier xcd_barrier_post(unsigned* bar, volatile LAS unsigned* st) {
    XcdBarrier b; b.bar = bar; b.x = xb_xcc_id(); b.st = st;
    if (threadIdx.x == 0) (void)xb_add(&bar[XB_XCNT(b.x)], 1u);
    return b;
}
__device__ __forceinline__ void xcd_barrier_complete(unsigned* bar, unsigned x, unsigned& nloc, unsigned& nx) {
    const unsigned G = gridDim.x * gridDim.y * gridDim.z;
    unsigned sum, cnt, mine, sp = 0u;
    for (;;) {
        sum = 0u; cnt = 0u; mine = 0u;
#pragma unroll
        for (unsigned j = 0; j < 16; ++j) { const unsigned c = xb_ld(&bar[XB_XCNT(j)]); sum += c; cnt += (c > 0u) ? 1u : 0u; mine = (j == x) ? c : mine; }
        if (sum == G) break;
        __builtin_amdgcn_s_sleep(1);
        if ((++sp & 255u) == 0u) { if (xb_ld(&bar[XB_TMO])) break; if (sp > XB_SPIN_CAP) { atomicAdd(&bar[XB_TMO], 1u); break; } }
    }
    nloc = mine > 0u ? mine : 1u; nx = cnt > 0u ? cnt : 1u;
}

__device__ __forceinline__ void xcd_barrier(const XcdBarrier& b) {
    asm volatile("s_waitcnt vmcnt(0)" ::: "memory");
    __syncthreads();
    if (threadIdx.x == 0) {
        unsigned* bar = b.bar;
        __builtin_amdgcn_s_waitcnt(0);
        unsigned nloc = b.st[0], nx = b.st[1];
        if (nloc == 0u) { xcd_barrier_complete(bar, b.x, nloc, nx); b.st[0] = nloc; b.st[1] = nx; }
        const unsigned old = xb_add(&bar[XB_XSUB(b.x)], 1u);
        const unsigned gen = old / nloc;
        if (old + 1u == (gen + 1u) * nloc) {
            __builtin_amdgcn_fence(__ATOMIC_RELEASE, "agent");
            asm volatile("s_waitcnt vmcnt(0)" ::: "memory");
            const unsigned og = xb_add(&bar[XB_TOP], 1u);
            const unsigned tg = og / nx;
            if (og + 1u == (tg + 1u) * nx) xb_add(&bar[XB_TOPGEN], 1u);
            else XB_SPIN(xb_ld(&bar[XB_TOPGEN]) == tg, bar);
            __builtin_amdgcn_fence(__ATOMIC_ACQUIRE, "agent");
            xb_add(&bar[XB_XGEN(b.x)], 1u);
            asm volatile("s_waitcnt vmcnt(0)" ::: "memory");
        } else {
            XB_SPIN(xb_ld(&bar[XB_XGEN(b.x)]) == gen, bar);
            __builtin_amdgcn_fence(__ATOMIC_ACQUIRE, "agent");
            asm volatile("s_waitcnt vmcnt(0)" ::: "memory");
        }
    }
    __syncthreads();
}

constexpr int DM = 1024, MP = 16384, MS = 2048, M = MP + MS;
constexpr int NIN = 3584, FF = 2816, NGU = 2 * FF, PLE = 256, PAST = 2048;
constexpr int NCP = 256, NCS = 32, NCH = NCP + NCS;
constexpr int RH = 4, RD = 128, AH = 8, AD = 64;
constexpr float EPS = 1e-6f, LOG2E = 1.4426950408889634f;
constexpr int ZQ = 0, ZK = 512, ZV = 1024, ZG = 1536, ZQA = 2048, ZKA = 2560, ZVA = 3072;
constexpr size_t OFF_Y = 0, OFF_RP = (size_t)M * DM, OFF_KP = OFF_RP + 65536, OFF_VP = OFF_KP + 262144, OFF_RS = OFF_VP + 262144,
                 OFF_KS = OFF_RS + 2097152, OFF_VS = OFF_KS + 1048576, OUT_TOTAL = OFF_VS + 1048576;
static_assert(OUT_TOTAL == 23658496, "output size");

constexpr size_t MiB = 1u << 20;
constexpr size_t WS_CTL = 0, CTL_ZERO_BYTES = 1 * MiB;
constexpr size_t WS_RSTDX = 1 * MiB, WS_M0 = 1 * MiB + 256 * 1024, WS_ST1 = 2 * MiB, WS_ST2 = 4 * MiB;
constexpr size_t WS_WIN = 6 * MiB, WS_WOUT = 13 * MiB, WS_WGU = 15 * MiB, WS_WDN = 26 * MiB, WS_WPG = 32 * MiB, WS_WPP = 34 * MiB;
constexpr size_t WS_PB = 35 * MiB;
constexpr size_t WS_XB = 44 * MiB;
constexpr size_t WS_Z = 80 * MiB;
constexpr size_t WS_UF = 206 * MiB;
constexpr size_t WS_RB = 222 * MiB;
constexpr size_t WS_COS = 230 * MiB, WS_SIN = 234 * MiB;
constexpr size_t WS_HB = 80 * MiB;
constexpr size_t WS_T = 116 * MiB;
constexpr size_t WS_H2B = 215 * MiB;
constexpr size_t WS_END = 251 * MiB;
static_assert(WS_T + (size_t)M * FF * 2 <= WS_H2B && WS_Z + (size_t)M * NIN * 2 <= WS_UF && WS_HB + (size_t)M * DM * 2 <= WS_T && WS_H2B + (size_t)M * DM * 2 <= WS_END, "ws map");

constexpr int CW_TMO = 0, CW_CODE = 1, CW_BAR = 4096;

using pg8::u32x4; using pg8::bf16_t; using pg8::Unit;
__device__ __forceinline__ u32x4 pack8(f32x4 a, f32x4 b) { u32x4 w; w.x = pg8::cvt_pk_bf16(a[0], a[1]); w.y = pg8::cvt_pk_bf16(a[2], a[3]); w.z = pg8::cvt_pk_bf16(b[0], b[1]); w.w = pg8::cvt_pk_bf16(b[2], b[3]); return w; }
__device__ __forceinline__ float lg2_gamma(int h) { return log2f(1.0f - exp2f(-5.0f - (float)h)); }
__device__ __forceinline__ float bf2f(unsigned short b) { return __uint_as_float((unsigned)b << 16); }
__device__ __forceinline__ float sum4(f32x4 a) { return (a[0] + a[1]) + (a[2] + a[3]); }
__device__ __forceinline__ float rstd16(const float* st, int r) {
    const f32x4* p = (const f32x4*)(st + (size_t)r * 16); const f32x4 a = p[0], b = p[1], c = p[2], d = p[3];
    return rsqrtf(((sum4(a) + sum4(b)) + (sum4(c) + sum4(d))) * (1.0f / DM) + EPS);
}
__device__ __forceinline__ f32x4 sigmoid4(f32x4 g) { f32x4 o;
#pragma unroll
    for (int i = 0; i < 4; ++i) o[i] = __builtin_amdgcn_rcpf(1.0f + __builtin_amdgcn_exp2f(-g[i] * LOG2E));
    return o; }

struct EpiIn {
    static constexpr bool PERM = true, AFTER_DRAIN = false;
    bf16_t* Z; const float* rstd; const float* cosT; const float* sinT; const float* gq; const float* gk; float* dout;
    __device__ __forceinline__ void operator()(const f32x4 (&acc)[2][2][4][2], const Unit& u, int wr, int wc, int fr, int fq) const {
        const int pn = u.pn; const int rbase = u.pm * 256 + wr * 64 + fr;
        if (pn < 4) {
            const int sec = (pn >> 1) * 512, head = 2 * (pn & 1) + (wc >> 1), j0 = (wc & 1) * 32 + fq * 8;
            const float osc = (pn >= 2) ? 0.08838834764831845f : 1.0f; const float lgs = (pn >= 2) ? -lg2_gamma(head) : lg2_gamma(head);
#pragma unroll
            for (int ai = 0; ai < 2; ++ai)
#pragma unroll
                for (int m = 0; m < 4; ++m) {
                    const int r = rbase + ai * 128 + m * 16; const int pos = r < MP ? r : PAST + ((r - MP) & 63); const int nloc = r < MP ? (r & 255) : ((r - MP) & 63);
                    const float rs = rstd[r] * osc * exp2f((float)nloc * lgs);
                    const f32x4 c0 = *(const f32x4*)(cosT + (size_t)pos * 64 + j0), c1 = *(const f32x4*)(cosT + (size_t)pos * 64 + j0 + 4);
                    const f32x4 s0 = *(const f32x4*)(sinT + (size_t)pos * 64 + j0), s1 = *(const f32x4*)(sinT + (size_t)pos * 64 + j0 + 4);
                    const f32x4 x1a = acc[ai][0][m][0] * rs, x1b = acc[ai][0][m][1] * rs, x2a = acc[ai][1][m][0] * rs, x2b = acc[ai][1][m][1] * rs;
                    const f32x4 o1a = x1a * c0 - x2a * s0, o1b = x1b * c1 - x2b * s1, o2a = x1a * s0 + x2a * c0, o2b = x1b * s1 + x2b * c1;
                    bf16_t* dst = Z + (size_t)r * NIN + sec + head * 128 + j0;
                    *(u32x4*)dst = pack8(o1a, o1b); *(u32x4*)(dst + 64) = pack8(o2a, o2b);
                }
        } else if (pn < 8 || pn >= 12) {
#pragma unroll
            for (int ai = 0; ai < 2; ++ai)
#pragma unroll
                for (int m = 0; m < 4; ++m) {
                    const int r = rbase + ai * 128 + m * 16; const float rs = rstd[r];
#pragma unroll
                    for (int bj = 0; bj < 2; ++bj) {
                        const f32x4 v0 = acc[ai][bj][m][0] * rs, v1 = acc[ai][bj][m][1] * rs; const int t = bj * 128 + wc * 32 + fq * 8;
                        *(u32x4*)(Z + (size_t)r * NIN + pn * 256 + t) = pack8(v0, v1);
                        if (pn >= 12) { const int c5 = (pn - 12) * 256 + t;
                            if (r >= MP) { float* o = dout + OFF_VS + (size_t)(r - MP) * 512 + c5; *(f32x4*)o = v0; *(f32x4*)(o + 4) = v1; }
                            else if (r >= MP - 512) { float* o = dout + OFF_VP + (size_t)(r - (MP - 512)) * 512 + c5; *(f32x4*)o = v0; *(f32x4*)(o + 4) = v1; } }
                    }
                }
        } else {
            const float* g = pn < 10 ? gq : gk; f32x4 gv[2][2];
#pragma unroll
            for (int bj = 0; bj < 2; ++bj)
#pragma unroll
                for (int n = 0; n < 2; ++n) gv[bj][n] = *(const f32x4*)(g + bj * 32 + fq * 8 + 4 * n);
#pragma unroll
            for (int ai = 0; ai < 2; ++ai)
#pragma unroll
                for (int m = 0; m < 4; ++m) {
                    const int r = rbase + ai * 128 + m * 16; const float rs = rstd[r]; f32x4 v[2][2]; float ss = 0.f;
#pragma unroll
                    for (int bj = 0; bj < 2; ++bj)
#pragma unroll
                        for (int n = 0; n < 2; ++n) { v[bj][n] = acc[ai][bj][m][n] * rs; ss += sum4(v[bj][n] * v[bj][n]); }
                    ss += __shfl_xor(ss, 16); ss += __shfl_xor(ss, 32);
                    const float inv = rsqrtf(ss * (1.0f / 64.0f) + EPS) * (pn < 10 ? 0.125f * LOG2E : 1.0f);
#pragma unroll
                    for (int bj = 0; bj < 2; ++bj) {
                        const f32x4 o0 = v[bj][0] * inv * gv[bj][0], o1 = v[bj][1] * inv * gv[bj][1]; const int e = wc * 64 + bj * 32 + fq * 8;
                        *(u32x4*)(Z + (size_t)r * NIN + pn * 256 + e) = pack8(o0, o1);
                        if (pn >= 10) { const int c5 = (pn - 10) * 256 + e;
                            if (r >= MP) { float* o = dout + OFF_KS + (size_t)(r - MP) * 512 + c5; *(f32x4*)o = o0; *(f32x4*)(o + 4) = o1; }
                            else if (r >= MP - 512) { float* o = dout + OFF_KP + (size_t)(r - (MP - 512)) * 512 + c5; *(f32x4*)o = o0; *(f32x4*)(o + 4) = o1; } }
                    }
                }
        }
    }
};
struct EpiRes {
    static constexpr bool PERM = true, AFTER_DRAIN = false;
    const float* res_p; const float* res_s; float* out; bf16_t* hb; float* stats;
    __device__ __forceinline__ void operator()(const f32x4 (&acc)[2][2][4][2], const Unit& u, int wr, int wc, int fr, int fq) const {
        const int rbase = u.pm * 256 + wr * 64 + fr;
#pragma unroll
        for (int ai = 0; ai < 2; ++ai)
#pragma unroll
            for (int m = 0; m < 4; ++m) {
                const int r = rbase + ai * 128 + m * 16; const float* rp = r < MP ? res_p + (size_t)r * DM : res_s + (size_t)(r - MP) * DM; float ss = 0.f;
#pragma unroll
                for (int bj = 0; bj < 2; ++bj) {
                    const int c0 = u.pn * 256 + bj * 128 + wc * 32 + fq * 8;
                    const f32x4 h0 = *(const f32x4*)(rp + c0) + acc[ai][bj][m][0], h1 = *(const f32x4*)(rp + c0 + 4) + acc[ai][bj][m][1];
                    float* o = out + (size_t)r * DM + c0; *(f32x4*)o = h0; *(f32x4*)(o + 4) = h1;
                    *(u32x4*)(hb + (size_t)r * DM + c0) = pack8(h0, h1);
                    ss += sum4(h0 * h0) + sum4(h1 * h1);
                }
                ss += __shfl_xor(ss, 16); ss += __shfl_xor(ss, 32);
                if (fq == 0) stats[(size_t)r * 16 + u.pn * 4 + wc] = ss;
            }
    }
};
struct EpiGU {
    static constexpr bool PERM = true, AFTER_DRAIN = false;
    const float* stats; bf16_t* T;
    __device__ __forceinline__ void operator()(const f32x4 (&acc)[2][2][4][2], const Unit& u, int wr, int wc, int fr, int fq) const {
        const int rbase = u.pm * 256 + wr * 64 + fr;
#pragma unroll
        for (int ai = 0; ai < 2; ++ai)
#pragma unroll
            for (int m = 0; m < 4; ++m) {
                const int r = rbase + ai * 128 + m * 16; const float rs = rstd16(stats, r);
                const f32x4 g0 = acc[ai][0][m][0] * rs, g1 = acc[ai][0][m][1] * rs, u0 = acc[ai][1][m][0] * rs, u1 = acc[ai][1][m][1] * rs;
                const f32x4 t0 = g0 * sigmoid4(g0) * u0, t1 = g1 * sigmoid4(g1) * u1;
                *(u32x4*)(T + (size_t)r * FF + u.pn * 128 + wc * 32 + fq * 8) = pack8(t0, t1);
            }
    }
};
struct EpiPP {
    static constexpr bool PERM = true, AFTER_DRAIN = false;
    bf16_t* O;
    __device__ __forceinline__ void operator()(const f32x4 (&acc)[2][2][4][2], const Unit& u, int wr, int wc, int fr, int fq) const {
        const unsigned boff = (unsigned)((u.pm * 256 + wr * 64 + fr) * DM + u.pn * 256 + wc * 32 + fq * 8) * 2u;
#pragma unroll
        for (int ai = 0; ai < 2; ++ai)
#pragma unroll
            for (int m = 0; m < 4; ++m) {
#pragma unroll
                for (int bj = 0; bj < 2; ++bj) *(u32x4*)((char*)O + (boff + (unsigned)((ai * 128 + m * 16) * DM + bj * 128) * 2u)) = pack8(acc[ai][bj][m][0], acc[ai][bj][m][1]);
                asm volatile("" ::: "memory"); }
    }
};
struct EpiPG {
    static constexpr bool PERM = true, AFTER_DRAIN = false;
    const float* stats; const bf16_t* PP; float* y;
    __device__ __forceinline__ void operator()(const f32x4 (&acc)[2][2][4][2], const Unit& u, int wr, int wc, int fr, int fq) const {
        const int rbase = u.pm * 256 + wr * 64 + fr;
#pragma unroll
        for (int ai = 0; ai < 2; ++ai)
#pragma unroll
            for (int m = 0; m < 4; ++m) {
                const int r = rbase + ai * 128 + m * 16; const float rs = rstd16(stats, r);
#pragma unroll
                for (int bj = 0; bj < 2; ++bj) {
                    const int c0 = u.pn * 256 + bj * 128 + wc * 32 + fq * 8; float* o = y + (size_t)r * DM + c0;
                    const u32x4 pw = *(const u32x4*)(PP + (size_t)r * DM + c0);
                    const f32x4 p0 = {__uint_as_float(pw.x << 16), __uint_as_float(pw.x & 0xffff0000u), __uint_as_float(pw.y << 16), __uint_as_float(pw.y & 0xffff0000u)};
                    const f32x4 p1 = {__uint_as_float(pw.z << 16), __uint_as_float(pw.z & 0xffff0000u), __uint_as_float(pw.w << 16), __uint_as_float(pw.w & 0xffff0000u)};
                    const f32x4 y0 = *(const f32x4*)o + p0 * sigmoid4(acc[ai][bj][m][0] * rs), y1 = *(const f32x4*)(o + 4) + p1 * sigmoid4(acc[ai][bj][m][1] * rs);
                    *(f32x4*)o = y0; *(f32x4*)(o + 4) = y1;
                }
            }
    }
};

constexpr int NWAVES = 8, NTHR = 512;
#ifndef MK_ONE_LAUNCH
#define MK_ONE_LAUNCH 1
#endif
constexpr int NPH = 4;
constexpr int RING_OFF = 0, RING_BYTES = 131072, LDSCTL_OFF = RING_BYTES, MISC_OFF = LDSCTL_OFF + 320, LDS_BYTES = 147456;
typedef short s16x8 __attribute__((ext_vector_type(8)));
typedef short s16x4 __attribute__((ext_vector_type(4)));
typedef float f32x16 __attribute__((ext_vector_type(16)));
typedef unsigned u32x2v __attribute__((ext_vector_type(2)));

struct Frame {
    LAS unsigned char* lds; volatile LAS unsigned* MISC; gu32* ctl;
    int tid, lane, wave, vcu, G;
};
__device__ __forceinline__ float wave_sum(float v) {
#pragma unroll
    for (int o = 1; o < 64; o <<= 1) v += __shfl_xor(v, o);
    return v;
}
__device__ __forceinline__ int crow(int r, int hi) { return (r & 3) + 8 * (r >> 2) + 4 * hi; }
__device__ __forceinline__ s16x8 frag(const LAS bf16* X, int ld, int row0, int k0, int lane) { return *(const LAS s16x8*)(X + (row0 + (lane & 31)) * ld + k0 + 8 * (lane >> 5)); }
#define MFMA32(a, b, c) __builtin_amdgcn_mfma_f32_32x32x16_bf16((a), (b), (c), 0, 0, 0)

constexpr int CONV_TR_CHUNKS = 672, CONV_P_CHUNKS = 288, CONV_CHUNKS = CONV_TR_CHUNKS + CONV_P_CHUNKS;
constexpr int CW_UDONE = 1088, CW_SDONE = 1152, CW_CONV = 1216;
constexpr int NQ = 306, TK_NONE = 0xffff;
constexpr int CW_ADONE = 1024;
constexpr int CW_TKT = 2048;
constexpr int CW_DEP = 32768;
constexpr size_t WS_TAB = 1 * MiB + 512 * 1024;
__device__ __forceinline__ unsigned enc_unit(int kind, int q, int pn) { return (unsigned)((kind << 12) | (q << 5) | pn); }
__device__ __forceinline__ void build_ticket_table(unsigned short* tab) {
    int o = 0;
    for (int pn = 0; pn < 4; ++pn) for (int q = 0; q < 9; ++q) tab[o++] = (unsigned short)enc_unit(0, q, pn);
    for (int pn = 0; pn < 22; ++pn) tab[o++] = (unsigned short)enc_unit(1, 0, pn);
    int body = 0;
    for (int g = 0; g < 2; ++g) for (int pn = 0; pn < 22; ++pn) for (int j = 0; j < 4; ++j) {
        if (body == 40) for (int c = 0; c < 4; ++c) tab[o++] = (unsigned short)enc_unit(2, 0, c);
        if (body == 126) for (int c = 0; c < 4; ++c) tab[o++] = (unsigned short)enc_unit(3, 0, c);
        tab[o++] = (unsigned short)enc_unit(1, 1 + 4 * g + j, pn); ++body; }
    for (int pn = 0; pn < 4; ++pn) for (int q = 1; q < 9; ++q) tab[o++] = (unsigned short)enc_unit(2, q, pn);
    for (int pn = 0; pn < 4; ++pn) for (int q = 1; q < 9; ++q) tab[o++] = (unsigned short)enc_unit(3, q, pn);
}
__device__ __forceinline__ void tr_item(const float* W, int ldw, int K, int k0, int c0, bf16* WT, int d0, const float* g, LAS float* scr, int lane) {
    const int kb = lane >> 3, n4 = (lane & 7) * 4;
    f32x4 v[8];
#pragma unroll
    for (int i = 0; i < 8; ++i) v[i] = *(const f32x4*)(W + (size_t)(k0 + 8 * i + kb) * ldw + c0 + n4);
#pragma unroll
    for (int i = 0; i < 8; ++i) { const int kk = 8 * i + kb; f32x4 x = v[i]; if (g) x = x * g[k0 + kk];
        LAS float* d = scr + kk * 33 + n4; d[0] = x[0]; d[1] = x[1]; d[2] = x[2]; d[3] = x[3]; }
    LDS_WAIT(); asm volatile("" ::: "memory");
    const int c = lane & 7;
#pragma unroll
    for (int j = 0; j < 4; ++j) { const int n = (lane >> 3) + 8 * j; const LAS float* s = scr + (8 * c) * 33 + n;
        v4u o; o.x = pk2(s[0 * 33], s[1 * 33]); o.y = pk2(s[2 * 33], s[3 * 33]); o.z = pk2(s[4 * 33], s[5 * 33]); o.w = pk2(s[6 * 33], s[7 * 33]);
        *(GAS v4u*)(WT + (size_t)(d0 + n) * K + k0 + 8 * c) = o; }
    LDS_WAIT(); asm volatile("" ::: "memory");
}
__device__ __forceinline__ int sigma_in(int np) {
    const int pn = np >> 8, t = np & 255;
    if (pn < 4) { const int base = (pn >> 1) * 512 + (pn & 1) * 256, tt = t & 127; return base + (tt >> 6) * 128 + (t >> 7) * 64 + (tt & 63); }
    if (pn >= 8 && pn < 12) return pn * 256 + ((t >> 5) & 3) * 64 + (t >> 7) * 32 + (t & 31);
    return np;
}
struct Ptrs {
    const float *xp, *xs, *ck, *cv, *sr, *pp, *ps, *g_mix, *w_in, *g_ro, *g_q, *g_k, *rel_bias, *w_out, *g_ffn, *w_g, *w_u, *w_d, *g_ple, *w_pg, *w_pp;
    float* out; unsigned char* ws;
};
template <int PART> __device__ __forceinline__ void p0_prologue(Frame& F, const Ptrs& P, const int chunk = 0) {
    LAS float* scr = (LAS float*)(F.lds + RING_OFF + F.wave * 16384);
    const int gw = F.vcu * NWAVES + F.wave, NGW = F.G * NWAVES;
    bf16* Wt_in = (bf16*)(P.ws + WS_WIN); bf16* Wt_out = (bf16*)(P.ws + WS_WOUT); bf16* Wt_gu = (bf16*)(P.ws + WS_WGU);
    bf16* Wt_dn = (bf16*)(P.ws + WS_WDN); bf16* Wt_pg = (bf16*)(P.ws + WS_WPG); bf16* Wt_pp = (bf16*)(P.ws + WS_WPP);
    constexpr int I_IN = 16 * (NIN / 32), I_OUT = 16 * 32, I_GU = 16 * (NGU / 32), I_DN = (FF / 64) * 32, I_PG = 16 * 32, I_PP = 4 * 32;
    constexpr int NITEMS = I_IN + I_OUT + I_GU + I_DN + I_PG + I_PP;
    static_assert((NITEMS - I_IN) % 8 == 0 && (NITEMS - I_IN) / 8 == CONV_TR_CHUNKS && M / 64 == CONV_P_CHUNKS, "conversion chunk counts");
    const int it_lo = PART == 0 ? gw : (chunk < CONV_TR_CHUNKS ? I_IN + 8 * chunk + F.wave : NITEMS), it_hi = PART == 0 ? I_IN : NITEMS, it_step = PART == 0 ? NGW : NITEMS;
    for (int it = it_lo; it < it_hi; it += it_step) {
        int r = it;
        if (r < I_IN) { const int nb = r % (NIN / 32), kb = r / (NIN / 32); tr_item(P.w_in, NIN, DM, 64 * kb, sigma_in(32 * nb), Wt_in, 32 * nb, P.g_mix, scr, F.lane); continue; } r -= I_IN;
        if (r < I_OUT) { const int nb = r % 32, kb = r / 32; tr_item(P.w_out, DM, DM, 64 * kb, 32 * nb, Wt_out, 32 * nb, nullptr, scr, F.lane); continue; } r -= I_OUT;
        if (r < I_GU) { const int nb = r % (NGU / 32), kb = r / (NGU / 32); const int np = 32 * nb, pn = np >> 8, t = np & 255;
            tr_item(t < 128 ? P.w_g : P.w_u, FF, DM, 64 * kb, 128 * pn + (t & 127), Wt_gu, np, P.g_ffn, scr, F.lane); continue; } r -= I_GU;
        if (r < I_DN) { const int nb = r % 32, kb = r / 32; tr_item(P.w_d, DM, FF, 64 * kb, 32 * nb, Wt_dn, 32 * nb, nullptr, scr, F.lane); continue; } r -= I_DN;
        if (r < I_PG) { const int nb = r % 32, kb = r / 32; tr_item(P.w_pg, DM, DM, 64 * kb, 32 * nb, Wt_pg, 32 * nb, P.g_ple, scr, F.lane); continue; } r -= I_PG;
        { const int nb = r % 32, kb = r / 32; tr_item(P.w_pp, DM, PLE, 64 * kb, 32 * nb, Wt_pp, 32 * nb, nullptr, scr, F.lane); }
    }
    if (PART == 0) {
    bf16* xb = (bf16*)(P.ws + WS_XB); float* rstdx = (float*)(P.ws + WS_RSTDX);
    for (int m = gw; m < M; m += NGW) {
        const float* xr = m < MP ? P.xp + (size_t)m * DM : P.xs + (size_t)(m - MP) * DM;
        const GAS f32x4* x4 = (const GAS f32x4*)xr + F.lane; f32x4 v[4]; float s = 0.f;
#pragma unroll
        for (int j = 0; j < 4; ++j) { v[j] = x4[64 * j]; s += sum4(v[j] * v[j]); }
        s = wave_sum(s);
        GAS unsigned long long* o8 = (GAS unsigned long long*)(xb + (size_t)m * DM) + F.lane;
#pragma unroll
        for (int j = 0; j < 4; ++j) o8[64 * j] = (unsigned long long)pk2(v[j].x, v[j].y) | ((unsigned long long)pk2(v[j].z, v[j].w) << 32);
        if (F.lane == 0) rstdx[m] = rsqrtf(s * (1.0f / DM) + EPS);
    }
    }
    if (PART == 1) {
    bf16* pb = (bf16*)(P.ws + WS_PB);
    if (chunk >= CONV_TR_CHUNKS)
    for (int m = 64 * (chunk - CONV_TR_CHUNKS) + F.wave; m < 64 * (chunk - CONV_TR_CHUNKS + 1); m += NWAVES) {
        const float* pr = m < MP ? P.pp + (size_t)m * PLE : P.ps + (size_t)(m - MP) * PLE;
        const f32x4 v = ((const GAS f32x4*)pr)[F.lane];
        ((GAS unsigned long long*)(pb + (size_t)m * PLE))[F.lane] = (unsigned long long)pk2(v.x, v.y) | ((unsigned long long)pk2(v.z, v.w) << 32);
    }
    }
    if (PART == 0) {
    if (F.vcu == 0 && F.tid == 0) build_ticket_table((unsigned short*)(P.ws + WS_TAB));
    if (F.vcu == 1) {
        float gq = fabsf(P.g_q[F.lane]), gk = fabsf(P.g_k[F.lane]);
        const float* rb = P.rel_bias + (size_t)F.wave * 513; const float rb512 = rb[512]; float bm = 0.f;
        for (int i = F.lane; i < 513; i += 64) bm = fmaxf(bm, rb[i] - rb512);
#pragma unroll
        for (int o = 1; o < 64; o <<= 1) { gq = fmaxf(gq, __shfl_xor(gq, o)); gk = fmaxf(gk, __shfl_xor(gk, o)); bm = fmaxf(bm, __shfl_xor(bm, o)); }
        if (F.lane == 0) ((float*)(P.ws + WS_M0))[F.wave] = (8.0f * gq * gk + bm) * LOG2E * 1.01f + 0.25f; }
    float* cosT = (float*)(P.ws + WS_COS); float* sinT = (float*)(P.ws + WS_SIN);
    for (int i = (F.vcu * NTHR + F.tid); i < MP * 64; i += F.G * NTHR) {
        const int pos = i >> 6, j = i & 63;
        const float inv = exp2f(-(float)j * (13.287712379549449f / 64.0f));
        const float ang = (float)pos * inv;
        const float k = rintf(ang * 0.15915494309189535f);
        float r = fmaf(-k, 6.28125f, ang); r = fmaf(-k, 1.9353071795864769e-3f, r);
        cosT[i] = __cosf(r); sinT[i] = __sinf(r);
    }
    }
}

typedef short v4i16_t __attribute__((ext_vector_type(4)));
__device__ __forceinline__ s16x4 trrd(const LAS bf16* p) { return __builtin_bit_cast(s16x4, __builtin_amdgcn_ds_read_tr16_b64_v4i16((LAS v4i16_t*)p)); }
__device__ __forceinline__ s16x8 frag_tr(const LAS bf16* X, int ld, int rA, int rB, int c0, int lane) {
    const int i = lane & 15, co = c0 + 16 * ((lane >> 4) & 1) + 4 * (i & 3);
    const s16x4 lo = trrd(X + (rA + (i >> 2)) * ld + co), hh = trrd(X + (rB + (i >> 2)) * ld + co);
    return (s16x8){lo[0], lo[1], lo[2], lo[3], hh[0], hh[1], hh[2], hh[3]};
}
__device__ __forceinline__ s16x8 pack_p(const f32x16& p, int s2) { u32x4 w;
    w.x = pg8::cvt_pk_bf16(p[8 * s2 + 0], p[8 * s2 + 1]); w.y = pg8::cvt_pk_bf16(p[8 * s2 + 2], p[8 * s2 + 3]); w.z = pg8::cvt_pk_bf16(p[8 * s2 + 4], p[8 * s2 + 5]); w.w = pg8::cvt_pk_bf16(p[8 * s2 + 6], p[8 * s2 + 7]);
    return __builtin_bit_cast(s16x8, w); }
__device__ __forceinline__ void unpack8(v4u w, float* f) {
    f[0] = __uint_as_float(w.x << 16); f[1] = __uint_as_float(w.x & 0xffff0000u); f[2] = __uint_as_float(w.y << 16); f[3] = __uint_as_float(w.y & 0xffff0000u);
    f[4] = __uint_as_float(w.z << 16); f[5] = __uint_as_float(w.z & 0xffff0000u); f[6] = __uint_as_float(w.w << 16); f[7] = __uint_as_float(w.w & 0xffff0000u); }
constexpr int LDT = 160;
constexpr int LQ = 136;

constexpr int LKA = 72, LVA = 96;
template <bool FIX> __device__ __forceinline__ void attn_unit(Frame& F, const Ptrs& P, const bool samp, const int idx, const int h) {
    const bf16* Z = (const bf16*)(P.ws + WS_Z); bf16* MIX = (bf16*)P.out;
    const int tid = F.tid, lane = F.lane, wave = F.wave, hi = lane >> 5, l31 = lane & 31, wp = wave >> 1, qb = wave & 1;
    LAS bf16* Kb = (LAS bf16*)F.lds; LAS bf16* Vb = Kb + 2 * 64 * LKA; LAS float* BTX = (LAS float*)(F.lds + 43008); LAS float* SC = (LAS float*)(F.lds + 46336) + wave * 32;
    LAS bf16* OS = (LAS bf16*)(F.lds + 47360) + wave * (32 * LKA);
    const int nsteps = samp ? 9 : 12, t0 = samp ? 0 : (idx >= 2 ? 0 : 8 - 4 * idx);
    const int rowq = samp ? MP + 64 * idx + 32 * qb : 256 * idx + 64 * wp + 32 * qb;
    const bool wact = samp ? (wp == 0) : true;
    __syncthreads();
    const float M0 = FIX ? ((const float*)(P.ws + WS_M0))[h] : 0.f;
    { const float* rb = P.rel_bias + (size_t)h * 513; const float rb512 = rb[512];
      for (int i = tid; i < 832; i += NTHR) BTX[i] = (i <= 512 ? (rb[i] - rb512) * LOG2E : 0.f) - M0; }
    s16x8 qf[4];
    { const bf16* qs = Z + (size_t)(rowq + l31) * NIN + ZQA + h * 64 + 8 * hi;
#pragma unroll
      for (int s = 0; s < 4; ++s) qf[s] = wact ? *(const s16x8*)(qs + 16 * s) : (s16x8){0, 0, 0, 0, 0, 0, 0, 0}; }
    const int srow = tid >> 3, sch = tid & 7; v4u kA, vA, kB, vB, kC, vC;
#define A_LOADX(t, KR, VR) do { if (samp && (t) < 8) { \
            const float* ks_ = P.ck + ((size_t)(idx * 512 + 64 * (t) + srow) * 8 + h) * 64 + sch * 8; const float* vs_ = P.cv + ((size_t)(idx * 512 + 64 * (t) + srow) * 8 + h) * 64 + sch * 8; \
            const f32x4 a_ = *(const f32x4*)ks_, b_ = *(const f32x4*)(ks_ + 4), c_ = *(const f32x4*)vs_, d_ = *(const f32x4*)(vs_ + 4); \
            KR = pack8(a_, b_); VR = pack8(c_, d_); \
        } else { const int kr_ = samp ? MP + 64 * idx + srow : 64 * (4 * idx - 8 + (t)) + srow; const bf16* s_ = Z + (size_t)kr_ * NIN + h * 64 + sch * 8; \
            KR = *(const v4u*)(s_ + ZKA); VR = *(const v4u*)(s_ + ZVA); } } while (0)
#define A_STOREX(buf, KR, VR) do { *(LAS v4u*)(Kb + (buf) * 64 * LKA + srow * LKA + sch * 8) = KR; *(LAS v4u*)(Vb + (buf) * 64 * LVA + srow * LVA + sch * 8) = VR; } while (0)
    f32x16 o0 = {}, o1 = {}; float m_run = 0.f, l_run = 0.f; bool first = true;
    const int b0 = 768 + 32 * qb + l31 - 4 * hi;
    auto step = [&](const int t, const int it) __attribute__((always_inline)) {
        const int j = samp ? t : t - wp;
        if (wact && j >= 0 && j <= 8) {
            const LAS bf16* Kc = Kb + (it & 1) * 64 * LKA; const LAS bf16* Vc = Vb + (it & 1) * 64 * LVA;
            f32x16 p[2];
#pragma unroll
            for (int lb = 0; lb < 2; ++lb) { f32x16 c;
                if (j >= 4) { const LAS float* bp = BTX + (b0 - 64 * j - 32 * lb);
#pragma unroll
                    for (int r = 0; r < 16; ++r) c[r] = FIX ? bp[-((r & 3) + 8 * (r >> 2))] : bp[-((r & 3) + 8 * (r >> 2))] - m_run;
                } else {
#pragma unroll
                    for (int r = 0; r < 16; ++r) c[r] = FIX ? -M0 : -m_run; }
#pragma unroll
                for (int s = 0; s < 4; ++s) c = MFMA32(frag(Kc, LKA, 32 * lb, 16 * s, lane), qf[s], c);
                p[lb] = c; }
            if (!FIX) {
            float mx = p[0][0];
#pragma unroll
            for (int r = 0; r < 16; ++r) { mx = fmaxf(mx, p[0][r]); mx = fmaxf(mx, p[1][r]); }
            mx = fmaxf(mx, __shfl_xor(mx, 32));
            if (first || __any(mx > 8.0f)) {
                const float d = first ? mx : fmaxf(mx, 0.f); m_run += d;
#pragma unroll
                for (int r = 0; r < 16; ++r) { p[0][r] -= d; p[1][r] -= d; }
                if (!first) { const float alpha = exp2f(-d); l_run *= alpha;
                    if (hi == 0) SC[l31] = alpha;
                    asm volatile("s_waitcnt lgkmcnt(0)" ::: "memory");
#pragma unroll
                    for (int r = 0; r < 16; ++r) { const float f = SC[crow(r, hi)]; o0[r] *= f; o1[r] *= f; }
                    asm volatile("s_waitcnt lgkmcnt(0)" ::: "memory"); }
                first = false;
            }
            }
            float ls = 0.f;
#pragma unroll
            for (int r = 0; r < 16; ++r) { p[0][r] = __builtin_amdgcn_exp2f(p[0][r]); p[1][r] = __builtin_amdgcn_exp2f(p[1][r]); ls += p[0][r] + p[1][r]; }
            l_run += ls;
#pragma unroll
            for (int lb = 0; lb < 2; ++lb)
#pragma unroll
                for (int s2 = 0; s2 < 2; ++s2) { const s16x8 pa = pack_p(p[lb], s2); const int kb = 32 * lb + 16 * s2 + 4 * hi;
                    o0 = MFMA32(pa, frag_tr(Vc, LVA, kb, kb + 8, 0, lane), o0); o1 = MFMA32(pa, frag_tr(Vc, LVA, kb, kb + 8, 32, lane), o1); }
        }
    };
    A_LOADX(t0, kA, vA); A_STOREX(0, kA, vA);
    if (t0 + 1 < nsteps) A_LOADX(t0 + 1, kB, vB);
    if (t0 + 2 < nsteps) A_LOADX(t0 + 2, kC, vC);
    __syncthreads();
#define A_STEPX(i, KL, VL, KS, VS) do { const int t_ = t0 + (i); if (t_ + 3 < nsteps) A_LOADX(t_ + 3, KL, VL); step(t_, (i)); if (t_ + 1 < nsteps) A_STOREX(((i) + 1) & 1, KS, VS); __syncthreads(); } while (0)
    for (int base = 0; t0 + base < nsteps; base += 3) {
        A_STEPX(base, kA, vA, kB, vB);
        if (t0 + base + 1 >= nsteps) break;
        A_STEPX(base + 1, kB, vB, kC, vC);
        if (t0 + base + 2 >= nsteps) break;
        A_STEPX(base + 2, kC, vC, kA, vA);
    }
#undef A_STEPX
#undef A_LOADX
#undef A_STOREX
    if (wact) {
        l_run += __shfl_xor(l_run, 32);
        if (hi == 0) SC[l31] = 1.0f / l_run;
        asm volatile("s_waitcnt lgkmcnt(0)" ::: "memory");
#pragma unroll
        for (int r = 0; r < 16; ++r) { const int n = crow(r, hi); const float f = SC[n]; OS[n * LKA + l31] = (bf16)f2bf(o0[r] * f); OS[n * LKA + 32 + l31] = (bf16)f2bf(o1[r] * f); }
        asm volatile("s_waitcnt lgkmcnt(0)" ::: "memory");
        const int row = lane >> 1, half = lane & 1; bf16* dst = MIX + (size_t)(rowq + row) * DM + 512 + h * 64 + 32 * half;
#pragma unroll
        for (int c = 0; c < 4; ++c) *(v4u*)(dst + 8 * c) = *(const LAS v4u*)(OS + row * LKA + 32 * half + 8 * c);
    }
}

__device__ __forceinline__ void retU_item(Frame& F, const Ptrs& P, const bool samp, const int idx, const int h) {
    const bf16* Z = (const bf16*)(P.ws + WS_Z);
    const int tid = F.tid, lane = F.lane, wave = F.wave, hi = lane >> 5, l31 = lane & 31;
    LAS bf16* Vi = (LAS bf16*)F.lds; LAS bf16* Ki = Vi + 128 * LDT;
    const int T = samp ? 64 : 256, row0 = samp ? MP + 64 * idx : 256 * idx;
    const LAS bf16* X = samp ? Ki : Vi; const LAS bf16* Y = samp ? Vi : Ki;
    const int ib = wave >> 1, jb0 = 2 * (wave & 1);
    f32x16 a0 = {}, a1 = {};
    for (int p0 = 0; p0 < T; p0 += 128) {
        const int rows = (T - p0) < 128 ? (T - p0) : 128;
        __syncthreads();
        for (int c = tid; c < rows * 16; c += NTHR) { const int row = c >> 4, ch = c & 15;
            const bf16* src = Z + (size_t)(row0 + p0 + row) * NIN + h * 128 + ch * 8;
            *(LAS v4u*)(Vi + row * LDT + ch * 8) = *(const v4u*)(src + ZV); *(LAS v4u*)(Ki + row * LDT + ch * 8) = *(const v4u*)(src + ZK); }
        __syncthreads();
        for (int s = 0; s < rows / 16; ++s) { const int rA = 16 * s + 8 * hi;
            const s16x8 a = frag_tr(X, LDT, rA, rA + 4, 32 * ib, lane);
            a0 = MFMA32(a, frag_tr(Y, LDT, rA, rA + 4, 32 * jb0, lane), a0); a1 = MFMA32(a, frag_tr(Y, LDT, rA, rA + 4, 32 * jb0 + 32, lane), a1); }
    }
    const float lg2 = lg2_gamma(h), gT1 = exp2f((float)(T - 1) * lg2);
    if (!samp) {
        float* UF = (float*)(P.ws + WS_UF) + (size_t)(idx * 4 + h) * 16384;
#pragma unroll
        for (int r = 0; r < 16; ++r) { const int e = 32 * ib + crow(r, hi); UF[e * 128 + 32 * jb0 + l31] = gT1 * a0[r]; UF[e * 128 + 32 * jb0 + 32 + l31] = gT1 * a1[r]; }
    } else {
        const float g64 = exp2f(64.0f * lg2);
        const float* R0 = P.sr + (size_t)(idx * 4 + h) * 16384; float* RO = P.out + OFF_RS + (size_t)(idx * 4 + h) * 16384;
#pragma unroll
        for (int r = 0; r < 16; ++r) { const int d = 32 * ib + crow(r, hi); const int e0 = 32 * jb0 + l31;
            RO[d * 128 + e0] = g64 * R0[d * 128 + e0] + gT1 * a0[r]; RO[d * 128 + e0 + 32] = g64 * R0[d * 128 + e0 + 32] + gT1 * a1[r]; }
    }
}
__device__ __forceinline__ void ret_scan(Frame& F, const Ptrs& P) {
    const int gid = F.vcu * NTHR + F.tid;
    if (gid < 32768) {
        typedef float f32x2v __attribute__((ext_vector_type(2)));
        const f32x2v* uf = (const f32x2v*)(P.ws + WS_UF) + gid; unsigned* rb = (unsigned*)(P.ws + WS_RB) + gid; const int h = gid >> 13;
        const float g = exp2f(256.0f * lg2_gamma(h)); float R0 = 0.f, R1 = 0.f;
        f32x2v u[64];
#pragma unroll
        for (int c = 0; c < 64; ++c) u[c] = uf[(size_t)c * 32768];
#pragma unroll
        for (int c = 0; c < 64; ++c) { rb[(size_t)c * 32768] = pk2(R0, R1); R0 = g * R0 + u[c].x; R1 = g * R1 + u[c].y; }
        const int el = (2 * gid) & 16383, e = el >> 7, d = el & 127;
        float* o = P.out + OFF_RP + (size_t)h * 16384; o[d * 128 + e] = R0; o[(d + 1) * 128 + e] = R1;
    }
}
__device__ __forceinline__ void retO_item(Frame& F, const Ptrs& P, const bool samp, const int idx, const int h) {
    const bf16* Z = (const bf16*)(P.ws + WS_Z); bf16* MIX = (bf16*)P.out;
    const int tid = F.tid, lane = F.lane, wave = F.wave, hi = lane >> 5, l31 = lane & 31;
    LAS bf16* RT = (LAS bf16*)F.lds; LAS bf16* Kb = RT + 128 * LQ; LAS bf16* Vb = Kb + 2 * 64 * LQ; LAS bf16* OS = Kb + wave * (32 * LQ);
    const int T = samp ? 64 : 256, row0 = samp ? MP + 64 * idx : 256 * idx, nkb_all = T / 64;
    const int rb = wave < 4 ? wave : 11 - wave; const bool act = rb * 32 < T; const int nkb = act ? (rb >> 1) + 1 : 0;
    const float gam = exp2f(lg2_gamma(h));
    __syncthreads();
    if (!samp) { const bf16* rs = (const bf16*)(P.ws + WS_RB) + (size_t)(idx * 4 + h) * 16384;
#pragma unroll
        for (int i = 0; i < 4; ++i) { const int c = tid + NTHR * i, e = c >> 4, ch = c & 15; *(LAS v4u*)(RT + e * LQ + ch * 8) = *(const v4u*)(rs + e * 128 + ch * 8); }
    } else { const float* rs = P.sr + (size_t)(idx * 4 + h) * 16384;
#pragma unroll
        for (int i = 0; i < 8; ++i) { const int id = i * NTHR + tid, d = id >> 5, e0 = (id & 31) * 4; const f32x4 v = *(const f32x4*)(rs + d * 128 + e0);
            RT[(e0 + 0) * LQ + d] = (bf16)f2bf(v.x); RT[(e0 + 1) * LQ + d] = (bf16)f2bf(v.y); RT[(e0 + 2) * LQ + d] = (bf16)f2bf(v.z); RT[(e0 + 3) * LQ + d] = (bf16)f2bf(v.w); } }
    s16x8 qf[8];
    { const bf16* qs = Z + (size_t)(row0 + (act ? 32 * rb : 0) + l31) * NIN + ZQ + h * 128 + 8 * hi;
#pragma unroll
      for (int s = 0; s < 8; ++s) qf[s] = *(const s16x8*)(qs + 16 * s); }
    v4u kreg[2], vreg[2];
#define R_LOAD(kb) do { _Pragma("unroll") for (int i_ = 0; i_ < 2; ++i_) { const int c_ = tid + NTHR * i_; const bf16* s_ = Z + (size_t)(row0 + 64 * (kb) + (c_ >> 4)) * NIN + h * 128 + (c_ & 15) * 8; \
        kreg[i_] = *(const v4u*)(s_ + ZK); vreg[i_] = *(const v4u*)(s_ + ZV); } } while (0)
#define R_STORE(buf) do { _Pragma("unroll") for (int i_ = 0; i_ < 2; ++i_) { const int c_ = tid + NTHR * i_; \
        *(LAS v4u*)(Kb + (buf) * 64 * LQ + (c_ >> 4) * LQ + (c_ & 15) * 8) = kreg[i_]; *(LAS v4u*)(Vb + (buf) * 64 * LDT + (c_ >> 4) * LDT + (c_ & 15) * 8) = vreg[i_]; } } while (0)
    R_LOAD(0); R_STORE(0); __syncthreads();
    f32x16 acc[4];
#pragma unroll
    for (int eb = 0; eb < 4; ++eb) { f32x16 a = {};
        if (act) {
#pragma unroll
            for (int s = 0; s < 8; ++s) a = MFMA32(qf[s], frag(RT, LQ, 32 * eb, 16 * s, lane), a); }
        acc[eb] = a * gam; }
    for (int kb = 0; kb < nkb_all; ++kb) {
        if (kb + 1 < nkb_all) R_LOAD(kb + 1);
        if (kb < nkb) {
            const LAS bf16* Kc = Kb + (kb & 1) * 64 * LQ; const LAS bf16* Vc = Vb + (kb & 1) * 64 * LDT; const bool diag = (kb == nkb - 1);
#pragma unroll
            for (int lb = 0; lb < 2; ++lb) {
                if (diag && lb == 1 && !(rb & 1)) continue;
                f32x16 p = {};
#pragma unroll
                for (int s = 0; s < 8; ++s) p = MFMA32(frag(Kc, LQ, 32 * lb, 16 * s, lane), qf[s], p);
                if (diag) { const int nl = 32 * (rb & 1) + l31;
#pragma unroll
                    for (int r = 0; r < 16; ++r) if (32 * lb + crow(r, hi) > nl) p[r] = 0.f; }
#pragma unroll
                for (int s2 = 0; s2 < 2; ++s2) { const s16x8 pa = pack_p(p, s2); const int kr = 32 * lb + 16 * s2 + 4 * hi;
#pragma unroll
                    for (int eb = 0; eb < 4; ++eb) acc[eb] = MFMA32(pa, frag_tr(Vc, LDT, kr, kr + 8, 32 * eb, lane), acc[eb]); }
            }
        }
        if (kb + 1 < nkb_all) R_STORE((kb + 1) & 1);
        __syncthreads();
    }
#undef R_LOAD
#undef R_STORE
    if (act) {
#pragma unroll
        for (int eb = 0; eb < 4; ++eb)
#pragma unroll
            for (int r = 0; r < 16; ++r) OS[crow(r, hi) * LQ + 32 * eb + l31] = (bf16)f2bf(acc[eb][r]);
        asm volatile("s_waitcnt lgkmcnt(0)" ::: "memory");
        const int row = lane >> 1, half = lane & 1, grow = row0 + 32 * rb + row;
        v4u ow[8]; float ss = 0.f;
#pragma unroll
        for (int c = 0; c < 8; ++c) { ow[c] = *(const LAS v4u*)(OS + row * LQ + 64 * half + 8 * c); float f[8]; unpack8(ow[c], f);
#pragma unroll
            for (int i = 0; i < 8; ++i) ss += f[i] * f[i]; }
        ss += __shfl_xor(ss, 1);
        const float inv = rsqrtf(ss * (1.0f / 128.0f) + EPS);
        const bf16* gs = Z + (size_t)grow * NIN + ZG + h * 128 + 64 * half; const float* gro = P.g_ro + h * 128 + 64 * half; bf16* dst = MIX + (size_t)grow * DM + h * 128 + 64 * half;
#pragma unroll
        for (int c = 0; c < 8; ++c) { float f[8], g[8]; unpack8(ow[c], f); unpack8(*(const v4u*)(gs + 8 * c), g);
            const f32x4 r0 = *(const f32x4*)(gro + 8 * c), r1 = *(const f32x4*)(gro + 8 * c + 4); f32x4 x0, x1;
#pragma unroll
            for (int i = 0; i < 4; ++i) { x0[i] = g[i] * __builtin_amdgcn_rcpf(1.0f + __builtin_amdgcn_exp2f(-g[i] * LOG2E)) * f[i] * inv * r0[i];
                                          x1[i] = g[4 + i] * __builtin_amdgcn_rcpf(1.0f + __builtin_amdgcn_exp2f(-g[4 + i] * LOG2E)) * f[4 + i] * inv * r1[i]; }
            *(v4u*)(dst + 8 * c) = pack8(x0, x1); }
    }
}

#ifndef ST_AUX
#define ST_AUX 0
#endif
typedef __amdgpu_buffer_rsrc_t rsrc_t;
__device__ __forceinline__ rsrc_t mk_rsrc(const void* p, unsigned bytes) { return __builtin_amdgcn_make_buffer_rsrc((void*)p, 0, (int)bytes, 0x00020000); }
__device__ __forceinline__ f32x4 ld_sc1_f4(rsrc_t r, unsigned off) { return __builtin_bit_cast(f32x4, __builtin_amdgcn_raw_buffer_load_b128(r, (int)off, 0, 16)); }
__device__ __forceinline__ void st_sc1_f4(rsrc_t r, unsigned off, f32x4 v) { __builtin_amdgcn_raw_buffer_store_b128(__builtin_bit_cast(v4u, v), r, (int)off, 0, ST_AUX); }
__device__ __forceinline__ void st_sc1_u4(rsrc_t r, unsigned off, v4u v) { __builtin_amdgcn_raw_buffer_store_b128(v, r, (int)off, 0, ST_AUX); }
__device__ __forceinline__ float rstd16_sc1(rsrc_t r, int row) {
    const f32x4 a = ld_sc1_f4(r, (unsigned)row * 64u), b = ld_sc1_f4(r, (unsigned)row * 64u + 16u), c = ld_sc1_f4(r, (unsigned)row * 64u + 32u), d = ld_sc1_f4(r, (unsigned)row * 64u + 48u);
    return rsqrtf(((sum4(a) + sum4(b)) + (sum4(c) + sum4(d))) * (1.0f / DM) + EPS);
}
struct TailSched {
    const Ptrs& P; gu32* ctl; volatile LAS unsigned* LW;
    int tk_read, tk_fetched, par; unsigned tkv, myq;
    __device__ __forceinline__ gu32* dep(int stage, int pm) const { return ctl + CW_DEP + (stage * 72 + pm) * 64; }
    __device__ __forceinline__ static pg8::SUnit dec(unsigned e) { pg8::SUnit u; u.kind = (int)((e >> 12) & 7u); u.pm = (int)(((e >> 5) & 15u) * 8u + (e >> 16)); u.pn = (int)(e & 31u); return u; }
    __device__ __forceinline__ unsigned tab_entry(unsigned tk) const { const unsigned short* tab = (const unsigned short*)(P.ws + WS_TAB); return (unsigned)__builtin_amdgcn_readfirstlane((int)tab[tk & 511u]) | ((tk >> 9) << 16); }
    __device__ __forceinline__ unsigned fetch_ticket() const {
        const unsigned i = __hip_atomic_fetch_add(ctl + CW_TKT + 64 * myq, 1u, __ATOMIC_RELAXED, __HIP_MEMORY_SCOPE_AGENT);
        return i < (unsigned)NQ ? ((myq << 9) | i) : (unsigned)TK_NONE;
    }
    __device__ __forceinline__ void need_of(const pg8::SUnit& u, int& stage, unsigned& need) const {
        stage = -1; need = 0u;
        if (u.kind == 1) { stage = 0; need = 32u; } else if (u.kind == 2) { stage = 1; need = 176u; } else if (u.kind == 3) { stage = 2; need = 32u; }
    }
    __device__ __forceinline__ bool first(pg8::SUnit& cur, int wid, int lane) {
        tk_read = 1; tk_fetched = 2; par = 0; tkv = 0u; myq = xb_xcc_id() & 7u;
        if (wid == 0 && lane == 0) { const unsigned t0 = fetch_ticket(); const unsigned t1 = (t0 == (unsigned)TK_NONE) ? t0 : fetch_ticket(); LW[0] = t0; LW[1] = t1; }
        __syncthreads();
        const unsigned t0 = LW[0];
        if (t0 == (unsigned)TK_NONE) return false;
        cur = dec(tab_entry(t0)); return true;
    }
    __device__ __forceinline__ void spin_ge(gu32* p, unsigned need, int lane) const {
        unsigned spins = 0;
        while ((unsigned)__builtin_amdgcn_readfirstlane((int)__hip_atomic_load(p, __ATOMIC_RELAXED, __HIP_MEMORY_SCOPE_AGENT)) < need) {
            __builtin_amdgcn_s_sleep(8);
            if (++spins > (1u << 22)) { if (lane == 0) __hip_atomic_store(ctl + CW_TMO, 1u, __ATOMIC_RELAXED, __HIP_MEMORY_SCOPE_AGENT); break; }
        }
    }
    __device__ __forceinline__ void wait_ready(const pg8::SUnit& u, int lane) const {
        int stage; unsigned need; need_of(u, stage, need);
        if (stage < 0) return;
        spin_ge(dep(stage, u.pm), need, lane);
        if (u.kind == 3) spin_ge(ctl + CW_ADONE, 288u * 8u, lane);
    }
    __device__ __forceinline__ void probe(const pg8::SUnit& cur, int wid, int lane) {
        par ^= 1;
        if (cur.kind == 3) return;
        if (wid == 0) {
            const unsigned tk = LW[tk_read & 1]; unsigned e = TK_NONE, ok = 1u;
            if (tk != (unsigned)TK_NONE) { e = tab_entry(tk); const pg8::SUnit u = dec(e); int stage; unsigned need; need_of(u, stage, need);
                if (stage >= 0) ok = ((unsigned)__builtin_amdgcn_readfirstlane((int)__hip_atomic_load(dep(stage, u.pm), __ATOMIC_RELAXED, __HIP_MEMORY_SCOPE_AGENT)) >= need) ? 1u : 0u;
                if (u.kind == 3 && ok) ok = ((unsigned)__builtin_amdgcn_readfirstlane((int)__hip_atomic_load(ctl + CW_ADONE, __ATOMIC_RELAXED, __HIP_MEMORY_SCOPE_AGENT)) >= 288u * 8u) ? 1u : 0u; }
            if (lane == 0) { LW[2 + par] = e; LW[4 + par] = ok; }
        }
    }
    __device__ __forceinline__ bool peek(const pg8::SUnit& cur, pg8::SUnit& nxt, bool& ready) {
        if (cur.kind == 3) { nxt.kind = 4; nxt.pm = cur.pm; nxt.pn = cur.pn; ready = true; return true; }
        const unsigned e = LW[2 + par], ok = LW[4 + par]; ++tk_read;
        if ((e & 0xffffu) == (unsigned)TK_NONE) { ready = false; return false; }
        nxt = dec(e); ready = ok != 0u; return true;
    }
    __device__ __forceinline__ pg8::SGeo geo(const pg8::SUnit& u) const {
        pg8::SGeo g; const char* ws = (const char*)P.ws;
        if (u.kind == 0)      { g.ld = DM;  g.nt = 16; g.A = (const char*)P.out; g.B = ws + WS_WOUT; }
        else if (u.kind == 1) { g.ld = DM;  g.nt = 16; g.A = ws + WS_HB; g.B = ws + WS_WGU; }
        else if (u.kind == 2) { g.ld = FF;  g.nt = 44; g.A = ws + WS_T;  g.B = ws + WS_WDN; }
        else if (u.kind == 3) { g.ld = PLE; g.nt = 4;  g.A = ws + WS_PB; g.B = ws + WS_WPP; }
        else                  { g.ld = DM;  g.nt = 16; g.A = ws + WS_H2B; g.B = ws + WS_WPG; }
        g.hstep = 128u * g.ld * 2u; g.A += (size_t)u.pm * 2u * g.hstep; g.B += (size_t)u.pn * 2u * g.hstep; return g;
    }
    __device__ __forceinline__ void rstd_pair(rsrc_t rS, int base, int lane, float& ra, float& rb) const {
        const unsigned o0 = (unsigned)(base + lane) * 64u, o1 = o0 + 128u * 64u;
        const f32x4 a0 = ld_sc1_f4(rS, o0), a1 = ld_sc1_f4(rS, o0 + 16u), a2 = ld_sc1_f4(rS, o0 + 32u), a3 = ld_sc1_f4(rS, o0 + 48u);
        const f32x4 b0 = ld_sc1_f4(rS, o1), b1 = ld_sc1_f4(rS, o1 + 16u), b2 = ld_sc1_f4(rS, o1 + 32u), b3 = ld_sc1_f4(rS, o1 + 48u);
        ra = rsqrtf(((sum4(a0) + sum4(a1)) + (sum4(a2) + sum4(a3))) * (1.0f / DM) + EPS);
        rb = rsqrtf(((sum4(b0) + sum4(b1)) + (sum4(b2) + sum4(b3))) * (1.0f / DM) + EPS);
    }
    __device__ __forceinline__ void epilogue(const f32x4 (&acc)[2][2][4][2], const pg8::SUnit& u, bool has_next, const pg8::SUnit& nxt, int wr, int wc, int fr, int fq, int wid, int lane) {
        const bool fetch = has_next && nxt.kind != 3;
        if (fetch && wid == 0 && lane == 0) tkv = fetch_ticket();
        const int rbase = u.pm * 256 + wr * 64 + fr;
        if (u.kind == 0 || u.kind == 2) {
            const rsrc_t rR = mk_rsrc(P.ws + (u.kind == 0 ? WS_XB : WS_HB), (unsigned)M * DM * 2u), rH = mk_rsrc(P.ws + (u.kind == 0 ? WS_HB : WS_H2B), (unsigned)M * DM * 2u);
            const rsrc_t rS = mk_rsrc(P.ws + (u.kind == 0 ? WS_ST1 : WS_ST2), (unsigned)M * 64u);
            v4u rw[2][4][2];
#pragma unroll
            for (int ai = 0; ai < 2; ++ai)
#pragma unroll
                for (int m = 0; m < 4; ++m)
#pragma unroll
                    for (int bj = 0; bj < 2; ++bj) rw[ai][m][bj] = __builtin_amdgcn_raw_buffer_load_b128(rR, (int)(((unsigned)(rbase + ai * 128 + m * 16) * DM + (unsigned)(u.pn * 256 + bj * 128 + wc * 32 + fq * 8)) * 2u), 0, 16);
#pragma unroll
            for (int ai = 0; ai < 2; ++ai)
#pragma unroll
                for (int m = 0; m < 4; ++m) {
                    const int r = rbase + ai * 128 + m * 16; float ss = 0.f;
#pragma unroll
                    for (int bj = 0; bj < 2; ++bj) {
                        const unsigned eo = (unsigned)r * DM + (unsigned)(u.pn * 256 + bj * 128 + wc * 32 + fq * 8);
                        float f[8]; unpack8(rw[ai][m][bj], f);
                        const f32x4 h0 = (f32x4){f[0], f[1], f[2], f[3]} + acc[ai][bj][m][0], h1 = (f32x4){f[4], f[5], f[6], f[7]} + acc[ai][bj][m][1];
                        st_sc1_u4(rH, eo * 2u, pack8(h0, h1));
                        ss += sum4(h0 * h0) + sum4(h1 * h1);
                    }
                    ss += __shfl_xor(ss, 16); ss += __shfl_xor(ss, 32);
                    if (fq == 0) __builtin_amdgcn_raw_buffer_store_b32(__float_as_uint(ss), rS, (int)(((unsigned)r * 16u + (unsigned)(u.pn * 4 + wc)) * 4u), 0, ST_AUX);
                }
        } else if (u.kind == 1) {
            const rsrc_t rS = mk_rsrc(P.ws + WS_ST1, (unsigned)M * 64u), rT = mk_rsrc(P.ws + WS_T, (unsigned)M * FF * 2u);
            float ra, rb; rstd_pair(rS, u.pm * 256 + wr * 64, lane, ra, rb);
#pragma unroll
            for (int ai = 0; ai < 2; ++ai)
#pragma unroll
                for (int m = 0; m < 4; ++m) {
                    const int r = rbase + ai * 128 + m * 16; const float rs = __shfl(ai ? rb : ra, m * 16 + fr);
                    const f32x4 g0 = acc[ai][0][m][0] * rs, g1 = acc[ai][0][m][1] * rs, u0 = acc[ai][1][m][0] * rs, u1 = acc[ai][1][m][1] * rs;
                    const f32x4 t0 = g0 * sigmoid4(g0) * u0, t1 = g1 * sigmoid4(g1) * u1;
                    st_sc1_u4(rT, ((unsigned)r * FF + (unsigned)(u.pn * 128 + wc * 32 + fq * 8)) * 2u, pack8(t0, t1));
                }
        } else if (u.kind == 3) {
            const rsrc_t rT = mk_rsrc(P.ws + WS_T, (unsigned)M * FF * 2u);
#pragma unroll
            for (int ai = 0; ai < 2; ++ai)
#pragma unroll
                for (int m = 0; m < 4; ++m) { const int r = rbase + ai * 128 + m * 16;
#pragma unroll
                    for (int bj = 0; bj < 2; ++bj) st_sc1_u4(rT, ((unsigned)r * FF + (unsigned)(u.pn * 256 + bj * 128 + wc * 32 + fq * 8)) * 2u, pack8(acc[ai][bj][m][0], acc[ai][bj][m][1]));
                    asm volatile("" ::: "memory"); }
        } else {
            const rsrc_t rH = mk_rsrc(P.ws + WS_H2B, (unsigned)M * DM * 2u), rS = mk_rsrc(P.ws + WS_ST2, (unsigned)M * 64u), rT = mk_rsrc(P.ws + WS_T, (unsigned)M * FF * 2u);
            float ra, rb; rstd_pair(rS, u.pm * 256 + wr * 64, lane, ra, rb);
#pragma unroll
            for (int ai = 0; ai < 2; ++ai)
#pragma unroll
                for (int m = 0; m < 4; ++m) {
                    const int r = rbase + ai * 128 + m * 16; const float rs = __shfl(ai ? rb : ra, m * 16 + fr);
                    v4u pw[2], hw[2];
#pragma unroll
                    for (int bj = 0; bj < 2; ++bj) { const unsigned c0 = (unsigned)(u.pn * 256 + bj * 128 + wc * 32 + fq * 8);
                        pw[bj] = __builtin_amdgcn_raw_buffer_load_b128(rT, (int)(((unsigned)r * FF + c0) * 2u), 0, 16); hw[bj] = __builtin_amdgcn_raw_buffer_load_b128(rH, (int)(((unsigned)r * DM + c0) * 2u), 0, 16); }
#pragma unroll
                    for (int bj = 0; bj < 2; ++bj) {
                        const unsigned eo = (unsigned)r * DM + (unsigned)(u.pn * 256 + bj * 128 + wc * 32 + fq * 8);
                        float pf[8], hf[8]; unpack8(pw[bj], pf); unpack8(hw[bj], hf);
                        const f32x4 y0 = (f32x4){hf[0], hf[1], hf[2], hf[3]} + (f32x4){pf[0], pf[1], pf[2], pf[3]} * sigmoid4(acc[ai][bj][m][0] * rs);
                        const f32x4 y1 = (f32x4){hf[4], hf[5], hf[6], hf[7]} + (f32x4){pf[4], pf[5], pf[6], pf[7]} * sigmoid4(acc[ai][bj][m][1] * rs);
                        float* o = P.out + eo; *(f32x4*)o = y0; *(f32x4*)(o + 4) = y1;
                    }
                }
        }
        asm volatile("s_waitcnt vmcnt(0)" ::: "memory");
        if (u.kind <= 2 && lane == 0) __hip_atomic_fetch_add(dep(u.kind, u.pm), 1u, __ATOMIC_RELAXED, __HIP_MEMORY_SCOPE_AGENT);
        if (u.kind == 0 && lane == 0) __hip_atomic_fetch_add(ctl + CW_ADONE, 1u, __ATOMIC_RELAXED, __HIP_MEMORY_SCOPE_AGENT);
        if (fetch) { if (wid == 0 && lane == 0) LW[tk_fetched & 1] = tkv; ++tk_fetched; }
    }
};

__device__ __forceinline__ void wg_publish(Frame& F, gu32* cnt) {
    asm volatile("s_waitcnt vmcnt(0)" ::: "memory"); __syncthreads();
    if (F.tid == 0) { __builtin_amdgcn_fence(__ATOMIC_RELEASE, "agent"); asm volatile("s_waitcnt vmcnt(0)" ::: "memory"); __hip_atomic_fetch_add(cnt, 1u, __ATOMIC_RELAXED, __HIP_MEMORY_SCOPE_AGENT); }
}
__device__ __forceinline__ void wg_wait(Frame& F, gu32* cnt, unsigned need) {
    if (F.tid == 0) { unsigned spins = 0;
        while (__hip_atomic_load(cnt, __ATOMIC_RELAXED, __HIP_MEMORY_SCOPE_AGENT) < need) { __builtin_amdgcn_s_sleep(8);
            if (++spins > (1u << 22)) { __hip_atomic_store(F.ctl + CW_TMO, 1u, __ATOMIC_RELAXED, __HIP_MEMORY_SCOPE_AGENT); break; } }
        __builtin_amdgcn_fence(__ATOMIC_ACQUIRE, "agent"); asm volatile("s_waitcnt vmcnt(0)" ::: "memory"); }
    __syncthreads();
}

struct Args { const float* in[21]; float* out; unsigned char* ws; int ph_lo, ph_hi; };
template <int PHM> __global__ void __launch_bounds__(NTHR, 2) skel_fwd(Args args) {
    extern __shared__ __attribute__((aligned(16))) unsigned char lds[];
    Frame F;
    F.lds = (LAS unsigned char*)lds; F.MISC = (volatile LAS unsigned*)(F.lds + MISC_OFF);
    F.tid = threadIdx.x; F.lane = F.tid & 63; F.wave = __builtin_amdgcn_readfirstlane(F.tid >> 6);
    F.G = gridDim.x; { const int bx = blockIdx.x; F.vcu = (F.G % 8 == 0) ? (bx % 8) * (F.G / 8) + bx / 8 : bx; }
    unsigned char* ws = args.ws; F.ctl = (gu32*)(ws + WS_CTL);
    Ptrs P; P.xp = args.in[0]; P.xs = args.in[1]; P.ck = args.in[2]; P.cv = args.in[3]; P.sr = args.in[4]; P.pp = args.in[5]; P.ps = args.in[6]; P.g_mix = args.in[7]; P.w_in = args.in[8];
    P.g_ro = args.in[9]; P.g_q = args.in[10]; P.g_k = args.in[11]; P.rel_bias = args.in[12]; P.w_out = args.in[13]; P.g_ffn = args.in[14]; P.w_g = args.in[15]; P.w_u = args.in[16];
    P.w_d = args.in[17]; P.g_ple = args.in[18]; P.w_pg = args.in[19]; P.w_pp = args.in[20]; P.out = args.out; P.ws = ws;
    for (int u = F.tid; u < (LDS_BYTES - LDSCTL_OFF) / 4; u += NTHR) ((LAS unsigned*)(F.lds + LDSCTL_OFF))[u] = 0u;
    __syncthreads();
    XcdBarrier bar; bar.bar = (unsigned*)(F.ctl + CW_BAR); bar.x = 0; bar.st = nullptr;
    if (MK_ONE_LAUNCH) bar = xcd_barrier_post((unsigned*)(F.ctl + CW_BAR), F.MISC + 8);
#define GRID_BAR() do { if (MK_ONE_LAUNCH) xcd_barrier(bar); } while (0)
    const int lo = args.ph_lo, hi = args.ph_hi;
#define IN(k) (((PHM >> (k)) & 1) && lo <= (k) && (k) < hi)
#define BOTH(k) (IN(k) && IN((k) + 1))
    bf16* XB = (bf16*)(ws + WS_XB); bf16* ZB = (bf16*)(ws + WS_Z); bf16* HB = (bf16*)(ws + WS_HB); bf16* TB = (bf16*)(ws + WS_T);
    float* ST1 = (float*)(ws + WS_ST1); float* ST2 = (float*)(ws + WS_ST2);

    if (IN(0)) { p0_prologue<0>(F, P); if (BOTH(0)) GRID_BAR(); }
    if (IN(1)) {
        pg8::Gemm g{XB, (const bf16*)(ws + WS_WIN), M, NIN, DM}; pg8::StaticOrder S; S.init(M, NIN, F.G, (int)blockIdx.x);
        EpiIn E{ZB, (const float*)(ws + WS_RSTDX), (const float*)(ws + WS_COS), (const float*)(ws + WS_SIN), P.g_q, P.g_k, P.out};
        pg8::gemm_phase<EpiIn, pg8::StaticOrder, true, true>(F.lds + RING_OFF, g, S, E);
        if (BOTH(1)) GRID_BAR();
    }
    if (IN(2)) {
        const int c = F.vcu;
        retU_item(F, P, false, c >> 2, c & 3);
        wg_publish(F, F.ctl + CW_UDONE);
        { const float* m0p = (const float*)(P.ws + WS_M0); float m0mx = m0p[0];
#pragma unroll
          for (int i = 1; i < 8; ++i) m0mx = fmaxf(m0mx, m0p[i]);
          const bool fixok = m0mx <= 60.f;
          for (int it = c; it < 512; it += F.G) { if (fixok) attn_unit<true>(F, P, false, it & 63, it >> 6); else attn_unit<false>(F, P, false, it & 63, it >> 6); } }
        if (c < 64) { wg_wait(F, F.ctl + CW_UDONE, 256u); ret_scan(F, P); wg_publish(F, F.ctl + CW_SDONE); }
        attn_unit<false>(F, P, true, c >> 3, c & 7);
        if (c < 128) { retU_item(F, P, true, c >> 2, c & 3); retO_item(F, P, true, c >> 2, c & 3); }
        wg_wait(F, F.ctl + CW_SDONE, 64u);
        retO_item(F, P, false, c >> 2, c & 3);
        for (;;) {
            __syncthreads();
            if (F.tid == 0) F.MISC[12] = __hip_atomic_fetch_add(F.ctl + CW_CONV, 1u, __ATOMIC_RELAXED, __HIP_MEMORY_SCOPE_AGENT);
            __syncthreads();
            const unsigned ch = F.MISC[12];
            if (ch >= (unsigned)CONV_CHUNKS) break;
            p0_prologue<1>(F, P, (int)ch);
        }
        __syncthreads();
        if (BOTH(2)) GRID_BAR();
    }
    if (IN(3)) {
        TailSched S{P, F.ctl, F.MISC + 16, 0, 0, 0, 0u, 0u};
        pg8::gemm_stream<TailSched>(F.lds + RING_OFF, S);
    }
#undef IN
#undef BOTH
}

extern "C" void kernel_launch(void* const* d_in, const int* in_sizes, int n_in, void* d_out, int out_size, void* d_ws, size_t ws_size, hipStream_t stream) {
    static int grid = 0;
    if (grid == 0) {
        if (n_in != 21 || out_size != (int)OUT_TOTAL || ws_size < WS_END) { fprintf(stderr, "kernel_launch: unexpected shapes n_in %d out %d ws %zu\n", n_in, out_size, ws_size); grid = -1; return; }
#if MK_ONE_LAUNCH
        if (hipFuncSetAttribute((const void*)skel_fwd<0xf>, hipFuncAttributeMaxDynamicSharedMemorySize, LDS_BYTES) != hipSuccess) { fprintf(stderr, "kernel_launch: hipFuncSetAttribute failed\n"); grid = -1; return; }
#else
#define SETATTR(ph) (void)hipFuncSetAttribute((const void*)skel_fwd<(1 << (ph))>, hipFuncAttributeMaxDynamicSharedMemorySize, LDS_BYTES)
        SETATTR(0); SETATTR(1); SETATTR(2); SETATTR(3); SETATTR(4); SETATTR(5); SETATTR(6); SETATTR(7); SETATTR(8); SETATTR(9);
#endif
        int dev = 0, cus = 0;
        if (hipGetDevice(&dev) != hipSuccess || hipDeviceGetAttribute(&cus, hipDeviceAttributeMultiprocessorCount, dev) != hipSuccess) { grid = -1; return; }
        (void)hipGetLastError();
        grid = cus;
    }
    if (grid < 0) return;
    (void)hipMemsetAsync((char*)d_ws + WS_CTL, 0, CTL_ZERO_BYTES, stream);
    Args a{};
    for (int i = 0; i < 21; ++i) a.in[i] = (const float*)d_in[i];
    a.out = (float*)d_out; a.ws = (unsigned char*)d_ws;
#if MK_ONE_LAUNCH
    a.ph_lo = 0; a.ph_hi = NPH;
    hipLaunchKernelGGL(skel_fwd<0xf>, dim3(grid), dim3(NTHR), LDS_BYTES, stream, a);
#else
#define LAUNCH_PH(ph) do { a.ph_lo = (ph); a.ph_hi = (ph) + 1; hipLaunchKernelGGL(skel_fwd<(1 << (ph))>, dim3(grid), dim3(NTHR), LDS_BYTES, stream, a); } while (0)
    LAUNCH_PH(0); LAUNCH_PH(1); LAUNCH_PH(2); LAUNCH_PH(3); LAUNCH_PH(4); LAUNCH_PH(5); LAUNCH_PH(6); LAUNCH_PH(7); LAUNCH_PH(8); LAUNCH_PH(9);
#endif
}
```
